# Optimizing an MI355X kernel written in HIP

```python
import math
import jax, jax.numpy as jnp
from jax import lax
import numpy as np

D_MODEL = 1024
BATCH = 4
SEQ = 4096
DEPTH = 2
DEC_BATCH = 128
DEC_SEQ = 8
PAST_LEN = 2048
PAGE_SIZE = 128

N_MIXERS = 2
N_SSD_LAYERS = (DEPTH + 1) // 2
N_ATTN_LAYERS = DEPTH // 2
EPS = 1e-6
D_FF = 2816
D_INNER = 2 * D_MODEL
SSD_HEADDIM = 64
SSD_HEADS = D_INNER // SSD_HEADDIM
SSD_GROUPS = 8
SSD_HPG = SSD_HEADS // SSD_GROUPS
D_STATE = 128
CONV_W = 4
CONV_DIM = D_INNER + 2 * SSD_GROUPS * D_STATE
D_IN_PROJ = D_INNER + CONV_DIM + SSD_HEADS
SSD_CHUNK = 128
ATTN_PATTERNS = ((128, 1), (512, 4), (2048, 16))
N_ATTN_GROUPS = 3
ATTN_HPG = 8
ATTN_HEAD_DIM = 64
N_ATTN_HEADS = N_ATTN_GROUPS * ATTN_HPG
ATTN_WIDTH = ATTN_HPG * ATTN_HEAD_DIM
QKV_WIDTH = N_ATTN_GROUPS * 3 * ATTN_WIDTH
ATTN_QBLOCK = 128
NEG_INF = -1e30

kernel_name = 'hybrid_ssd_dilated_swa_macaron_step'


def rms_norm(x, g):
    xf = x.astype(jnp.float32)
    y = xf * lax.rsqrt(jnp.mean(xf * xf, axis=-1, keepdims=True) + EPS)
    return (y * g.astype(jnp.float32)).astype(x.dtype)


def half_swiglu(x, g, w_in, w_out):
    a, b = jnp.split(rms_norm(x, g) @ w_in, 2, axis=-1)
    return x + 0.5 * ((jax.nn.silu(a) * b) @ w_out)


def alibi_slopes():
    h = jnp.arange(1, N_ATTN_HEADS + 1, dtype=jnp.float32)
    return (2.0 ** (-8.0 * h / N_ATTN_HEADS)).reshape(N_ATTN_GROUPS, ATTN_HPG)


def ssd_chunked(x, dt, a, bm, cm, h0):
    b, l = x.shape[:2]
    q = SSD_CHUNK if l % SSD_CHUNK == 0 else l
    nc = l // q
    f32 = jnp.float32
    x = x.reshape(b, nc, q, SSD_GROUPS, SSD_HPG, SSD_HEADDIM).astype(f32)
    dt = dt.reshape(b, nc, q, SSD_GROUPS, SSD_HPG)
    bm = bm.reshape(b, nc, q, SSD_GROUPS, D_STATE).astype(f32)
    cm = cm.reshape(b, nc, q, SSD_GROUPS, D_STATE).astype(f32)
    a_cum = jnp.cumsum(dt * a, axis=2)
    causal = jnp.tril(jnp.ones((q, q), dtype=bool))[:, :, None, None]
    seg = a_cum[:, :, :, None] - a_cum[:, :, None, :]
    decay = jnp.exp(jnp.where(causal, seg, -jnp.inf))
    cb = jnp.einsum('bcqgn,bcsgn->bcqsg', cm, bm)
    wts = cb[..., None] * decay * dt[:, :, None]
    y_diag = jnp.einsum('bcqsgj,bcsgjp->bcqgjp', wts, x)
    xw = (jnp.exp(a_cum[:, :, -1:] - a_cum) * dt)[..., None] * x
    states = jnp.einsum('bcsgn,bcsgjp->bcgjpn', bm, xw)
    chunk_decay = jnp.exp(a_cum[:, :, -1])

    def step(h, inp):
        st, dec = inp
        return dec[..., None, None] * h + st, h

    h_last, h_prev = lax.scan(step, h0.astype(f32), (jnp.moveaxis(states, 1, 0), jnp.moveaxis(chunk_decay, 1, 0)))
    h_prev = jnp.moveaxis(h_prev, 0, 1)
    y_off = jnp.einsum('bcqgn,bcgjpn->bcqgjp', cm, h_prev) * jnp.exp(a_cum)[..., None]
    y = (y_diag + y_off).reshape(b, l, SSD_GROUPS, SSD_HPG, SSD_HEADDIM)
    return y, h_last


def ssd_mixer(u, conv_state, ssm_state, w_in, conv_w, conv_b, dt_bias, a_log, d_skip, norm_g, w_out):
    b, l, _ = u.shape
    f32 = jnp.float32
    proj = u @ w_in
    z = proj[..., :D_INNER]
    xbc = proj[..., D_INNER:D_INNER + CONV_DIM]
    dt_raw = proj[..., D_INNER + CONV_DIM:]
    xpad = jnp.concatenate([conv_state.astype(xbc.dtype), xbc], axis=1)
    xc = conv_b + sum(xpad[:, k:k + l] * conv_w[k] for k in range(CONV_W))
    xc = jax.nn.silu(xc)
    new_conv = xpad[:, l:]
    xs = xc[..., :D_INNER].reshape(b, l, SSD_GROUPS, SSD_HPG, SSD_HEADDIM)
    bm = xc[..., D_INNER:D_INNER + SSD_GROUPS * D_STATE].reshape(b, l, SSD_GROUPS, D_STATE)
    cm = xc[..., D_INNER + SSD_GROUPS * D_STATE:].reshape(b, l, SSD_GROUPS, D_STATE)
    dt = jax.nn.softplus(dt_raw.astype(f32) + dt_bias.astype(f32)).reshape(b, l, SSD_GROUPS, SSD_HPG)
    a = -jnp.exp(a_log.astype(f32)).reshape(SSD_GROUPS, SSD_HPG)
    h0 = ssm_state.reshape(b, SSD_GROUPS, SSD_HPG, SSD_HEADDIM, D_STATE)
    y, h_last = ssd_chunked(xs, dt, a, bm, cm, h0)
    y = y + d_skip.astype(f32).reshape(SSD_GROUPS, SSD_HPG)[:, :, None] * xs.astype(f32)
    gz = (y.reshape(b, l, D_INNER) * jax.nn.silu(z.astype(f32))).reshape(b, l, SSD_GROUPS, D_INNER // SSD_GROUPS)
    gz = gz * lax.rsqrt(jnp.mean(gz * gz, axis=-1, keepdims=True) + EPS)
    gz = (gz.reshape(b, l, D_INNER) * norm_g.astype(f32)).astype(u.dtype)
    new_ssm = h_last.reshape(b, SSD_HEADS, SSD_HEADDIM, D_STATE).astype(ssm_state.dtype)
    return gz @ w_out, new_conv, new_ssm


def dilated_group_attention(q, kvbuf, offset, win, dil, slopes):
    b, l, h, hd = q.shape
    nk = win // dil + 1
    qb = ATTN_QBLOCK if l % ATTN_QBLOCK == 0 else l
    starts = jnp.arange(l // qb) * qb
    j = jnp.arange(nk)
    bias = -(slopes.astype(jnp.float32) * dil)[:, None, None] * j.astype(jnp.float32)

    def block(start):
        qi = start + jnp.arange(qb)
        q_blk = lax.dynamic_slice_in_dim(q, start, qb, axis=1)
        idx = offset + qi[:, None] - dil * j[None, :]
        kv = jnp.take(kvbuf, jnp.maximum(idx, 0), axis=1)
        s = jnp.einsum('bqhd,bqkhd->bhqk', q_blk, kv[:, :, :, 0]).astype(jnp.float32) + bias
        s = jnp.where((idx >= 0)[None, None], s, NEG_INF)
        lse = jax.nn.logsumexp(s, axis=-1)
        p = jnp.exp(s - lse[..., None]).astype(kv.dtype)
        o = jnp.einsum('bhqk,bqkhd->bqhd', p, kv[:, :, :, 1])
        return o, lse

    o, lse = lax.map(block, starts)
    o = jnp.moveaxis(o, 0, 1).reshape(b, l, h, hd)
    lse = jnp.transpose(lse, (1, 0, 3, 2)).reshape(b, l, h)
    return o, lse


def dilated_mixer(u, past, w_qkv, w_o):
    b, l, _ = u.shape
    qkv = (u @ w_qkv).reshape(b, l, N_ATTN_GROUPS, 3, ATTN_HPG, ATTN_HEAD_DIM)
    slopes = alibi_slopes()
    outs, lses, new_rows = [], [], []
    for g, (win, dil) in enumerate(ATTN_PATTERNS):
        q = qkv[:, :, g, 0] * (ATTN_HEAD_DIM ** -0.5)
        kv_new = qkv[:, :, g, 1:]
        kvbuf = jnp.concatenate([past[g].astype(kv_new.dtype), kv_new], axis=1)
        o, lse = dilated_group_attention(q, kvbuf, past[g].shape[1], win, dil, slopes[g])
        outs.append(o)
        lses.append(lse)
        new_rows.append(kv_new)
    w = jax.nn.softmax(jnp.stack(lses), axis=0)
    o = jnp.sum(w[..., None] * jnp.stack(outs).astype(jnp.float32), axis=0).astype(u.dtype)
    return o.reshape(b, l, ATTN_WIDTH) @ w_o, new_rows


def setup_inputs(seed: int = 0) -> dict:
    key = jax.random.key(seed)
    ks = jax.random.split(key, 24)

    def nrm(k, shape, scale):
        return jax.random.normal(k, shape, jnp.float32) * scale

    dt0 = jnp.exp(jax.random.uniform(ks[13], (N_SSD_LAYERS, SSD_HEADS), jnp.float32, math.log(1e-3), math.log(1e-1)))
    return {
        'x_prompt': nrm(ks[0], (BATCH, SEQ, D_MODEL), 1.0),
        'x_sample': nrm(ks[1], (DEC_BATCH, DEC_SEQ, D_MODEL), 1.0),
        'state_conv': nrm(ks[2], (N_SSD_LAYERS, DEC_BATCH, CONV_W - 1, CONV_DIM), 1.0),
        'state_ssm': nrm(ks[3], (N_SSD_LAYERS, DEC_BATCH, SSD_HEADS, SSD_HEADDIM, D_STATE), 0.1),
        'cache_kv_g0': nrm(ks[4], (N_ATTN_LAYERS, DEC_BATCH, min(ATTN_PATTERNS[0][0], PAST_LEN), 2, ATTN_HPG, ATTN_HEAD_DIM), 1.0),
        'cache_kv_g1': nrm(ks[5], (N_ATTN_LAYERS, DEC_BATCH, min(ATTN_PATTERNS[1][0], PAST_LEN), 2, ATTN_HPG, ATTN_HEAD_DIM), 1.0),
        'cache_kv_g2': nrm(ks[6], (N_ATTN_LAYERS, DEC_BATCH, min(ATTN_PATTERNS[2][0], PAST_LEN), 2, ATTN_HPG, ATTN_HEAD_DIM), 1.0),
        'norm_w': 1.0 + nrm(ks[7], (DEPTH, 3, D_MODEL), 0.02),
        'w_ffn_in': nrm(ks[8], (DEPTH, 2, D_MODEL, 2 * D_FF), D_MODEL ** -0.5),
        'w_ffn_out': nrm(ks[9], (DEPTH, 2, D_FF, D_MODEL), D_FF ** -0.5),
        'ssm_w_in': nrm(ks[10], (N_SSD_LAYERS, D_MODEL, D_IN_PROJ), D_MODEL ** -0.5),
        'ssm_conv_w': nrm(ks[11], (N_SSD_LAYERS, CONV_W, CONV_DIM), CONV_W ** -0.5),
        'ssm_conv_b': nrm(ks[12], (N_SSD_LAYERS, CONV_DIM), 0.02),
        'ssm_dt_bias': dt0 + jnp.log(-jnp.expm1(-dt0)),
        'ssm_a_log': jnp.log(jax.random.uniform(ks[14], (N_SSD_LAYERS, SSD_HEADS), jnp.float32, 1.0, 16.0)),
        'ssm_d': 1.0 + nrm(ks[15], (N_SSD_LAYERS, SSD_HEADS), 0.1),
        'ssm_norm_w': 1.0 + nrm(ks[16], (N_SSD_LAYERS, D_INNER), 0.02),
        'ssm_w_out': nrm(ks[17], (N_SSD_LAYERS, D_INNER, D_MODEL), D_INNER ** -0.5),
        'attn_w_qkv': nrm(ks[18], (N_ATTN_LAYERS, D_MODEL, QKV_WIDTH), D_MODEL ** -0.5),
        'attn_w_o': nrm(ks[19], (N_ATTN_LAYERS, ATTN_WIDTH, D_MODEL), ATTN_WIDTH ** -0.5),
        'norm_f': 1.0 + nrm(ks[20], (D_MODEL,), 0.02),
    }


def reference(x_prompt, x_sample, state_conv, state_ssm, cache_kv_g0, cache_kv_g1, cache_kv_g2,
              norm_w, w_ffn_in, w_ffn_out, ssm_w_in, ssm_conv_w, ssm_conv_b, ssm_dt_bias, ssm_a_log,
              ssm_d, ssm_norm_w, ssm_w_out, attn_w_qkv, attn_w_o, norm_f):
    xp, xs = x_prompt, x_sample
    bp = xp.shape[0]
    caches = (cache_kv_g0, cache_kv_g1, cache_kv_g2)
    conv_p, conv_s, ssm_p, ssm_s = [], [], [], []
    kv_p = [[] for _ in range(N_ATTN_GROUPS)]
    kv_s = [[] for _ in range(N_ATTN_GROUPS)]
    for i in range(DEPTH):
        xp = half_swiglu(xp, norm_w[i, 0], w_ffn_in[i, 0], w_ffn_out[i, 0])
        xs = half_swiglu(xs, norm_w[i, 0], w_ffn_in[i, 0], w_ffn_out[i, 0])
        li = i // N_MIXERS
        up, us = rms_norm(xp, norm_w[i, 1]), rms_norm(xs, norm_w[i, 1])
        if i % N_MIXERS == 0:
            prm = (ssm_w_in[li], ssm_conv_w[li], ssm_conv_b[li], ssm_dt_bias[li], ssm_a_log[li],
                   ssm_d[li], ssm_norm_w[li], ssm_w_out[li])
            zc = jnp.zeros((bp, CONV_W - 1, CONV_DIM), xp.dtype)
            zh = jnp.zeros((bp, SSD_HEADS, SSD_HEADDIM, D_STATE), jnp.float32)
            yp, cp, hp = ssd_mixer(up, zc, zh, *prm)
            ys, cs, hs = ssd_mixer(us, state_conv[li], state_ssm[li], *prm)
            conv_p.append(cp)
            conv_s.append(cs)
            ssm_p.append(hp)
            ssm_s.append(hs)
        else:
            empty = [jnp.zeros((bp, 0, 2, ATTN_HPG, ATTN_HEAD_DIM), xp.dtype) for _ in range(N_ATTN_GROUPS)]
            yp, rows_p = dilated_mixer(up, empty, attn_w_qkv[li], attn_w_o[li])
            ys, rows_s = dilated_mixer(us, [c[li] for c in caches], attn_w_qkv[li], attn_w_o[li])
            for g, (win, _) in enumerate(ATTN_PATTERNS):
                lp = rows_p[g].shape[1]
                kv_p[g].append(rows_p[g][:, lp - min(win, lp):])
                kv_s[g].append(rows_s[g])
        xp = xp + yp
        xs = xs + ys
        xp = half_swiglu(xp, norm_w[i, 2], w_ffn_in[i, 1], w_ffn_out[i, 1])
        xs = half_swiglu(xs, norm_w[i, 2], w_ffn_in[i, 1], w_ffn_out[i, 1])
    y_prompt = rms_norm(xp, norm_f)
    y_sample = rms_norm(xs, norm_f)
    return (y_prompt, y_sample,
            jnp.stack(conv_p), jnp.stack(conv_s), jnp.stack(ssm_p), jnp.stack(ssm_s),
            jnp.stack(kv_p[0]), jnp.stack(kv_s[0]), jnp.stack(kv_p[1]), jnp.stack(kv_s[1]),
            jnp.stack(kv_p[2]), jnp.stack(kv_s[2]))
```

```cpp
#ifndef HOST_SIM
#include <hip/hip_runtime.h>
#define HD __host__ __device__ __forceinline__
#else
#include <cmath>
#define HD inline
#endif
#include <cstdio>
#include <cstdint>
#include <cstddef>
#include <cstring>

#ifdef SMALL
constexpr int D_MODEL = 128, BATCH = 1, SEQ = 4096, DEC_BATCH = 2, DEC_SEQ = 8, PAST_LEN = 2048, D_FF = 256, SSD_GROUPS = 2, D_STATE = 32, ATTN_HPG = 2;
#else
constexpr int D_MODEL = 1024, BATCH = 4, SEQ = 4096, DEC_BATCH = 128, DEC_SEQ = 8, PAST_LEN = 2048, D_FF = 2816, SSD_GROUPS = 8, D_STATE = 128, ATTN_HPG = 8;
#endif
constexpr float EPS = 1e-6f;
constexpr int D_INNER = 2 * D_MODEL, HEADDIM = 64, SSD_HEADS = D_INNER / HEADDIM, SSD_HPG = SSD_HEADS / SSD_GROUPS;
constexpr int CONV_W = 4, CONV_DIM = D_INNER + 2 * SSD_GROUPS * D_STATE, D_IN_PROJ = D_INNER + CONV_DIM + SSD_HEADS, CHUNK = 128, NCHUNK = SEQ / CHUNK;
constexpr int GW = D_INNER / SSD_GROUPS;
constexpr int AHD = 64, AW = ATTN_HPG * AHD, QKVW = 9 * AW, NAH = 3 * ATTN_HPG;
constexpr int MP = BATCH * SEQ, MS = DEC_BATCH * DEC_SEQ, M = MP + MS;
constexpr int ZXW = D_INNER + CONV_DIM;
constexpr int DT_COL0 = (ZXW + 255) / 256 * 256;
constexpr int NSI = DT_COL0 + 256;
constexpr int ZXP = DT_COL0;
constexpr int NSS = 16;
HD int a_win(int g) { return g == 0 ? 128 : (g == 1 ? 512 : 2048); }
HD int a_dil(int g) { return g == 0 ? 1 : (g == 1 ? 4 : 16); }
HD int a_past(int g) { return a_win(g) < PAST_LEN ? a_win(g) : PAST_LEN; }
HD int a_keep(int g) { return a_win(g) < SEQ ? a_win(g) : SEQ; }

typedef unsigned short bf16;
HD unsigned f2bf(float f) { unsigned u; memcpy(&u, &f, 4); return (u + 0x7fffu + ((u >> 16) & 1u)) >> 16; }
HD float bf2f(bf16 h) { unsigned u = (unsigned)h << 16; float f; memcpy(&f, &u, 4); return f; }
HD unsigned pk2bf(float lo, float hi) {
#if defined(__HIP_DEVICE_COMPILE__)
    typedef float f32x2_t __attribute__((ext_vector_type(2))); typedef __bf16 bf16x2_t __attribute__((ext_vector_type(2)));
    const f32x2_t v = {lo, hi}; const bf16x2_t b = __builtin_convertvector(v, bf16x2_t); return __builtin_bit_cast(unsigned, b);
#else
    return pk2bf(lo, hi);
#endif
}
HD float silu_f(float x) {
#if defined(__HIP_DEVICE_COMPILE__)
    return x * __builtin_amdgcn_rcpf(1.f + __expf(-x));
#else
    return x / (1.f + expf(-x));
#endif
}
HD float softplus_f(float x) { return x > 20.f ? x : log1pf(expf(x)); }

struct P {
    const float *x_prompt, *x_sample, *state_conv, *state_ssm, *cache0, *cache1, *cache2, *norm_w, *w_ffn_in, *w_ffn_out, *ssm_w_in, *ssm_conv_w, *ssm_conv_b,
        *ssm_dt_bias, *ssm_a_log, *ssm_d, *ssm_norm_w, *ssm_w_out, *attn_w_qkv, *attn_w_o, *norm_f;
    float *y_prompt, *y_sample, *conv_prompt, *conv_sample, *ssm_prompt, *ssm_sample, *kvp0, *kvs0, *kvp1, *kvs1, *kvp2, *kvs2;
    bf16 *WFI, *WFO, *WSI, *WSO, *WQKV, *WO, *XB, *H, *ZX, *HPREV, *GZ, *QKV, *O, *OG;
    float *X, *SS, *DT, *ACUM, *XC, *STATES, *Y, *CDEC, *LSE, *PART;
    bf16* XLO;
    unsigned* ctl;
    long cd1, cd2;
};
HD const float* cache_of(const P& p, int g) { return (const float*)((const char*)p.cache0 + (g == 0 ? 0 : (g == 1 ? p.cd1 : p.cd2))); }
HD float* kvp_of(const P& p, int g) { return p.kvp0 + (g == 0 ? 0 : (g == 1 ? (long)(p.kvp1 - p.kvp0) : (long)(p.kvp2 - p.kvp0))); }
HD float* kvs_of(const P& p, int g) { return p.kvs0 + (g == 0 ? 0 : (g == 1 ? (long)(p.kvs1 - p.kvs0) : (long)(p.kvs2 - p.kvs0))); }
HD float rstd_of(const P& p, int row) { float s = 0.f; for (int i = 0; i < NSS; ++i) s += p.SS[(size_t)row * NSS + i];
#if defined(__HIP_DEVICE_COMPILE__)
    return __builtin_amdgcn_rsqf(s * (1.f / D_MODEL) + EPS);
#else
    return 1.f / sqrtf(s * (1.f / D_MODEL) + EPS);
#endif
}
HD void row_bt(int row, bool& samp, int& b, int& t) { samp = row >= MP; if (!samp) { b = row / SEQ; t = row % SEQ; } else { const int r = row - MP; b = r / DEC_SEQ; t = r % DEC_SEQ; } }

constexpr long N_WFI = 4L * 2 * D_FF * D_MODEL, N_WFO = 4L * D_MODEL * D_FF, N_WSI = (long)NSI * D_MODEL, N_WSO = (long)D_MODEL * D_INNER, N_WQKV = (long)QKVW * D_MODEL, N_WO = (long)D_MODEL * AW;
HD void st_wfi(const P& p, long i) {
    const int k = (int)(i % D_MODEL); long r = i / D_MODEL; const int n = (int)(r % (2 * D_FF)); const int ls = (int)(r / (2 * D_FF));
    const int pn = n / 256, j = n % 256, oc = j < 128 ? 128 * pn + j : D_FF + 128 * pn + (j - 128);
    const float g = p.norm_w[((ls >> 1) * 3 + ((ls & 1) ? 2 : 0)) * D_MODEL + k];
    p.WFI[i] = (bf16)f2bf(p.w_ffn_in[((size_t)ls * D_MODEL + k) * (2 * D_FF) + oc] * g);
}
HD void st_wfo(const P& p, long i) {
    const int k = (int)(i % D_FF); long r = i / D_FF; const int n = (int)(r % D_MODEL); const int ls = (int)(r / D_MODEL);
    p.WFO[i] = (bf16)f2bf(0.5f * p.w_ffn_out[((size_t)ls * D_FF + k) * D_MODEL + n]);
}
HD void st_wsi(const P& p, long i) {
    const int k = (int)(i % D_MODEL), n = (int)(i / D_MODEL); int oc = -1;
    if (n < ZXW) oc = n; else if (n >= DT_COL0 && n < DT_COL0 + SSD_HEADS) oc = ZXW + (n - DT_COL0);
    p.WSI[i] = oc < 0 ? (bf16)0 : (bf16)f2bf(p.ssm_w_in[(size_t)k * D_IN_PROJ + oc] * p.norm_w[(0 * 3 + 1) * D_MODEL + k]);
}
HD void st_wso(const P& p, long i) { const int k = (int)(i % D_INNER), n = (int)(i / D_INNER); p.WSO[i] = (bf16)f2bf(p.ssm_w_out[(size_t)k * D_MODEL + n]); }
HD void st_wqkv(const P& p, long i) {
    const int k = (int)(i % D_MODEL), n = (int)(i / D_MODEL); const bool isq = (n / AW) % 3 == 0;
    p.WQKV[i] = (bf16)f2bf(p.attn_w_qkv[(size_t)k * QKVW + n] * p.norm_w[(1 * 3 + 1) * D_MODEL + k] * (isq ? 0.125f : 1.f));
}
HD void st_wo(const P& p, long i) { const int k = (int)(i % AW), n = (int)(i / AW); p.WO[i] = (bf16)f2bf(p.attn_w_o[(size_t)k * D_MODEL + n]); }
HD void st_xinit(const P& p, long i) {
    const int part = (int)(i % NSS), row = (int)(i / NSS); constexpr int W = D_MODEL / NSS;
    const float* src = row < MP ? p.x_prompt + (size_t)row * D_MODEL : p.x_sample + (size_t)(row - MP) * D_MODEL; float s = 0.f;
    for (int c = part * W; c < (part + 1) * W; ++c) { const float v = src[c]; p.X[(size_t)row * D_MODEL + c] = v; p.XB[(size_t)row * D_MODEL + c] = (bf16)f2bf(v); s += v * v; }
    p.SS[(size_t)row * NSS + part] = s;
}
HD float ssd_a(const P& p, int head) { return -expf(p.ssm_a_log[head]); }
HD void st_acum(const P& p, long i) {
    const int head = (int)(i % SSD_HEADS); const int sc = (int)(i / SSD_HEADS); int row0, len;
    if (sc < MP / CHUNK) { row0 = sc * CHUNK; len = CHUNK; } else { row0 = MP + (sc - MP / CHUNK) * DEC_SEQ; len = DEC_SEQ; }
    const float a = ssd_a(p, head); float c = 0.f;
    for (int t = 0; t < len; ++t) { c += p.DT[(size_t)(row0 + t) * SSD_HEADS + head] * a; p.ACUM[(size_t)(row0 + t) * SSD_HEADS + head] = c; }
}
constexpr long N_ACUM = (long)(MP / CHUNK + DEC_BATCH) * SSD_HEADS;
HD void st_conv(const P& p, long i) {
    const int ch = (int)(i % CONV_DIM), row = (int)(i / CONV_DIM); bool samp; int b, t; row_bt(row, samp, b, t);
    float acc = p.ssm_conv_b[ch];
    for (int k = 0; k < CONV_W; ++k) { const int tt = t - (CONV_W - 1) + k; float v;
        if (tt >= 0) v = bf2f(p.ZX[(size_t)(row - t + tt) * ZXP + D_INNER + ch]);
        else v = samp ? p.state_conv[((size_t)b * (CONV_W - 1) + (tt + CONV_W - 1)) * CONV_DIM + ch] : 0.f;
        acc += p.ssm_conv_w[k * CONV_DIM + ch] * v; }
    p.XC[(size_t)row * CONV_DIM + ch] = silu_f(acc);
}
HD void st_states(const P& p, long i) {
    const int n = (int)(i % D_STATE); long r = i / D_STATE; const int pp = (int)(r % HEADDIM); r /= HEADDIM; const int head = (int)(r % SSD_HEADS); const int bc = (int)(r / SSD_HEADS);
    const int row0 = bc * CHUNK, g = head / SSD_HPG; const float alast = p.ACUM[(size_t)(row0 + CHUNK - 1) * SSD_HEADS + head]; float s = 0.f;
    for (int t = 0; t < CHUNK; ++t) { const size_t rr = row0 + t;
        s += expf(alast - p.ACUM[rr * SSD_HEADS + head]) * p.DT[rr * SSD_HEADS + head] * p.XC[rr * CONV_DIM + head * HEADDIM + pp] * p.XC[rr * CONV_DIM + D_INNER + g * D_STATE + n]; }
    p.STATES[i] = s;
}
constexpr long N_STATES = (long)BATCH * NCHUNK * SSD_HEADS * HEADDIM * D_STATE;
HD void st_scan(const P& p, long i) {
    const long per = (long)HEADDIM * D_STATE; const long e = i % per; long r = i / per; const int head = (int)(r % SSD_HEADS), b = (int)(r / SSD_HEADS); float h = 0.f;
    for (int c = 0; c < NCHUNK; ++c) { const size_t idx = (((size_t)(b * NCHUNK + c)) * SSD_HEADS + head) * per + e;
        p.HPREV[idx] = (bf16)f2bf(h);
        h = expf(p.ACUM[(size_t)((b * NCHUNK + c) * CHUNK + CHUNK - 1) * SSD_HEADS + head]) * h + p.STATES[idx]; }
    p.ssm_prompt[i] = h;
}
constexpr long N_SCAN = (long)BATCH * SSD_HEADS * HEADDIM * D_STATE;
HD void st_y(const P& p, long i) {
    const int pp = (int)(i % HEADDIM); long r = i / HEADDIM; const int head = (int)(r % SSD_HEADS), row = (int)(r / SSD_HEADS); const int g = head / SSD_HPG;
    const int bc = row / CHUNK, row0 = bc * CHUNK; const float at = p.ACUM[(size_t)row * SSD_HEADS + head];
    const float* Ct = p.XC + (size_t)row * CONV_DIM + D_INNER + SSD_GROUPS * D_STATE + g * D_STATE; float y = 0.f;
    for (int rr = row0; rr <= row; ++rr) { const float* Bs = p.XC + (size_t)rr * CONV_DIM + D_INNER + g * D_STATE; float cb = 0.f;
        for (int n = 0; n < D_STATE; ++n) cb += Ct[n] * Bs[n];
        y += cb * expf(at - p.ACUM[(size_t)rr * SSD_HEADS + head]) * p.DT[(size_t)rr * SSD_HEADS + head] * p.XC[(size_t)rr * CONV_DIM + head * HEADDIM + pp]; }
    const bf16* hp = p.HPREV + (((size_t)bc * SSD_HEADS + head) * HEADDIM + pp) * D_STATE; float yo = 0.f;
    for (int n = 0; n < D_STATE; ++n) yo += Ct[n] * bf2f(hp[n]);
    p.Y[(size_t)row * D_INNER + head * HEADDIM + pp] = y + yo * expf(at) + p.ssm_d[head] * p.XC[(size_t)row * CONV_DIM + head * HEADDIM + pp];
}
constexpr long N_Y = (long)MP * SSD_HEADS * HEADDIM;
HD void st_ssd_sample(const P& p, long i) {
    const int pp = (int)(i % HEADDIM); long r = i / HEADDIM; const int head = (int)(r % SSD_HEADS), b = (int)(r / SSD_HEADS); const int g = head / SSD_HPG;
    const int row0 = MP + b * DEC_SEQ; const float a = ssd_a(p, head); float ya[DEC_SEQ];
    for (int t = 0; t < DEC_SEQ; ++t) ya[t] = 0.f;
    const size_t sb = (((size_t)b * SSD_HEADS + head) * HEADDIM + pp) * D_STATE;
    for (int n = 0; n < D_STATE; ++n) { float h = p.state_ssm[sb + n];
#pragma unroll
        for (int t = 0; t < DEC_SEQ; ++t) { const size_t rr = row0 + t; const float dt = p.DT[rr * SSD_HEADS + head];
            h = expf(dt * a) * h + dt * p.XC[rr * CONV_DIM + D_INNER + g * D_STATE + n] * p.XC[rr * CONV_DIM + head * HEADDIM + pp];
            ya[t] += p.XC[rr * CONV_DIM + D_INNER + SSD_GROUPS * D_STATE + g * D_STATE + n] * h; }
        p.ssm_sample[sb + n] = h; }
#pragma unroll
    for (int t = 0; t < DEC_SEQ; ++t) { const size_t rr = row0 + t; p.Y[rr * D_INNER + head * HEADDIM + pp] = ya[t] + p.ssm_d[head] * p.XC[rr * CONV_DIM + head * HEADDIM + pp]; }
}
constexpr long N_SSDS = (long)DEC_BATCH * SSD_HEADS * HEADDIM;
HD void st_gate(const P& p, long i) {
    const int g = (int)(i % SSD_GROUPS), row = (int)(i / SSD_GROUPS); float ms = 0.f;
    for (int c = 0; c < GW; ++c) { const int ch = g * GW + c; const float v = p.Y[(size_t)row * D_INNER + ch] * silu_f(bf2f(p.ZX[(size_t)row * ZXP + ch])); ms += v * v; }
    const float r = 1.f / sqrtf(ms * (1.f / GW) + EPS);
    for (int c = 0; c < GW; ++c) { const int ch = g * GW + c; const float v = p.Y[(size_t)row * D_INNER + ch] * silu_f(bf2f(p.ZX[(size_t)row * ZXP + ch]));
        p.GZ[(size_t)row * D_INNER + ch] = (bf16)f2bf(v * r * p.ssm_norm_w[ch]); }
}
constexpr int ADQ = 4, ADW = AHD / ADQ;
HD void st_attn(const P& p, long i) {
    const int dq = (int)(i % ADQ); long r = i / ADQ; const int h = (int)(r % ATTN_HPG), row = (int)(r / ATTN_HPG); bool samp; int b, t; row_bt(row, samp, b, t);
    float o[ADW];
#pragma unroll
    for (int d = 0; d < ADW; ++d) o[d] = 0.f;
    float mx = -1e30f, l = 0.f;
    for (int g = 0; g < 3; ++g) { const int dil = a_dil(g), nk = a_win(g) / dil + 1, past = samp ? a_past(g) : 0;
        const float slope = exp2f(-8.f * (float)(g * ATTN_HPG + h + 1) / (float)NAH);
        const bf16* q = p.QKV + (size_t)row * QKVW + g * 3 * AW + h * AHD;
        for (int j = 0; j < nk; ++j) { const int idx = past + t - j * dil; if (idx < 0) break;
            float s = 0.f, vv[ADW];
            if (idx >= past) { const bf16* kr = p.QKV + (size_t)(row - t + (idx - past)) * QKVW + g * 3 * AW + AW + h * AHD; const bf16* vr = kr + AW + dq * ADW;
                for (int d = 0; d < AHD; ++d) s += bf2f(q[d]) * bf2f(kr[d]);
#pragma unroll
                for (int d = 0; d < ADW; ++d) vv[d] = bf2f(vr[d]); }
            else { const float* kr = cache_of(p, g) + (((size_t)b * past + idx) * 2) * AW + h * AHD; const float* vr = kr + AW + dq * ADW;
                for (int d = 0; d < AHD; ++d) s += bf2f(q[d]) * kr[d];
#pragma unroll
                for (int d = 0; d < ADW; ++d) vv[d] = vr[d]; }
            s -= slope * (float)(dil * j);
            if (s > mx) { const float f = expf(mx - s); l *= f;
#pragma unroll
                for (int d = 0; d < ADW; ++d) o[d] *= f;
                mx = s; }
            const float e = expf(s - mx); l += e;
#pragma unroll
            for (int d = 0; d < ADW; ++d) o[d] += e * vv[d]; } }
    const float inv = 1.f / l;
#pragma unroll
    for (int d = 0; d < ADW; ++d) p.O[(size_t)row * AW + h * AHD + dq * ADW + d] = (bf16)f2bf(o[d] * inv);
}
HD void st_final(const P& p, long i) {
    const int part = (int)(i % NSS), row = (int)(i / NSS); constexpr int W = D_MODEL / NSS;
    const float r = rstd_of(p, row); float* out = row < MP ? p.y_prompt + (size_t)row * D_MODEL : p.y_sample + (size_t)(row - MP) * D_MODEL;
    for (int c = part * W; c < (part + 1) * W; ++c) out[c] = p.X[(size_t)row * D_MODEL + c] * r * p.norm_f[c];
}

struct EfSwiglu {
    HD void operator()(const P& p, int row, int hcol0, float rstd, const float* a, const float* b) const {
        unsigned w[4];
#pragma unroll
        for (int i = 0; i < 4; ++i) { const float v0 = silu_f(a[2 * i] * rstd) * (b[2 * i] * rstd), v1 = silu_f(a[2 * i + 1] * rstd) * (b[2 * i + 1] * rstd); w[i] = pk2bf(v0, v1); }
        unsigned* dst = (unsigned*)(p.H + (size_t)row * D_FF + hcol0); dst[0] = w[0]; dst[1] = w[1]; dst[2] = w[2]; dst[3] = w[3];
    }
};
struct EfResid {
    HD float operator()(const P& p, int row, int col0, const float* v) const {
        float* x = p.X + (size_t)row * D_MODEL + col0; unsigned* xb = (unsigned*)(p.XB + (size_t)row * D_MODEL + col0); float s = 0.f, nv[8];
#pragma unroll
        for (int i = 0; i < 8; ++i) { nv[i] = x[i] + v[i]; s += nv[i] * nv[i]; }
#pragma unroll
        for (int i = 0; i < 8; ++i) x[i] = nv[i];
#pragma unroll
        for (int i = 0; i < 4; ++i) xb[i] = pk2bf(nv[2 * i], nv[2 * i + 1]);
        return s;
    }
};
struct EfSsmIn {
    HD void operator()(const P& p, int row, int col0, float rstd, const float* v) const {
        if (col0 < DT_COL0) {
            unsigned* dst = (unsigned*)(p.ZX + (size_t)row * ZXP + col0);
#pragma unroll
            for (int i = 0; i < 4; ++i) dst[i] = pk2bf(v[2 * i] * rstd, v[2 * i + 1] * rstd);
            if (col0 >= D_INNER && col0 < ZXW) { bool samp; int b, t; row_bt(row, samp, b, t); const int L = samp ? DEC_SEQ : SEQ;
                if (t >= L - (CONV_W - 1)) { float* o = (samp ? p.conv_sample : p.conv_prompt) + ((size_t)b * (CONV_W - 1) + (t - (L - (CONV_W - 1)))) * CONV_DIM + (col0 - D_INNER);
#pragma unroll
                    for (int i = 0; i < 8; ++i) o[i] = v[i] * rstd; } }
        } else {
#pragma unroll
            for (int i = 0; i < 8; ++i) { const int hd = col0 - DT_COL0 + i; if (hd < SSD_HEADS) p.DT[(size_t)row * SSD_HEADS + hd] = softplus_f(v[i] * rstd + p.ssm_dt_bias[hd]); }
        }
    }
};
struct EfQkv {
    HD void operator()(const P& p, int row, int col0, float rstd, const float* v) const {
        unsigned* dst = (unsigned*)(p.QKV + (size_t)row * QKVW + col0);
#pragma unroll
        for (int i = 0; i < 4; ++i) dst[i] = pk2bf(v[2 * i] * rstd, v[2 * i + 1] * rstd);
        const int g = col0 / (3 * AW), off = col0 - g * 3 * AW - AW;
        if (off >= 0) { bool samp; int b, t; row_bt(row, samp, b, t); float* o = nullptr;
            if (samp) o = kvs_of(p, g) + ((size_t)b * DEC_SEQ + t) * 2 * AW + off;
            else { const int keep = a_keep(g); if (t >= SEQ - keep) o = kvp_of(p, g) + ((size_t)b * keep + (t - (SEQ - keep))) * 2 * AW + off; }
            if (o) {
#pragma unroll
                for (int i = 0; i < 8; ++i) o[i] = v[i] * rstd; } }
    }
};

#ifndef HOST_SIM
#define LAS __attribute__((address_space(3)))
#define GAS __attribute__((address_space(1)))
typedef GAS unsigned gu32;
#define RLX_AGENT __ATOMIC_RELAXED, __HIP_MEMORY_SCOPE_AGENT
__device__ __forceinline__ float lane_xor_f(float v, int lane, int m) { return __int_as_float(__builtin_amdgcn_ds_bpermute((lane ^ m) << 2, __float_as_int(v))); }
__device__ __forceinline__ float lane_up_f(float v, int lane, int d) { return __int_as_float(__builtin_amdgcn_ds_bpermute((lane - d) << 2, __float_as_int(v))); }

__device__ __forceinline__ float bf_lo(unsigned w) { return __uint_as_float(w << 16); }
__device__ __forceinline__ float bf_hi(unsigned w) { return __uint_as_float(w & 0xffff0000u); }
typedef float hl_f4 __attribute__((ext_vector_type(4)));
#define SPLIT2(a, b, H, L) do { const unsigned h_ = pk2bf((a), (b)); (H) = h_; (L) = pk2bf((a) - bf_lo(h_), (b) - bf_hi(h_)); } while (0)
__device__ __forceinline__ hl_f4 join4(unsigned h0, unsigned h1, unsigned l0, unsigned l1) { hl_f4 v; v[0] = bf_lo(h0) + bf_lo(l0); v[1] = bf_hi(h0) + bf_hi(l0); v[2] = bf_lo(h1) + bf_lo(l1); v[3] = bf_hi(h1) + bf_hi(l1); return v; }
namespace pg8 {
#define PG8_LAS __attribute__((address_space(3)))
typedef unsigned short bf16_t;
typedef short bf16x8 __attribute__((ext_vector_type(8)));
typedef float f32x4 __attribute__((ext_vector_type(4)));
typedef unsigned u32x4 __attribute__((ext_vector_type(4)));
constexpr int BM = 256, BK = 64, HALF = 128, HTB = HALF * BK * 2, STAGE_BYTES = 8 * HTB, NXCD = 8, WGM = 8;
__host__ __device__ __forceinline__ int lds_byte(int r, int c) { const int st = (r >> 4) * 2 + (c >> 5), rr = r & 15, cc = c & 31, ob = rr * 64 + cc * 2; return st * 1024 + (ob ^ (((ob >> 9) & 1) << 5)); }
__host__ __device__ __forceinline__ void stage_rc(int b, int& R, int& C) { const int st = b / 1024, sb = b % 1024, swz = sb ^ (((sb >> 9) & 1) << 5); R = (st >> 1) * 16 + swz / 64; C = (st & 1) * 32 + (swz % 64) / 2; }
__host__ __device__ __forceinline__ int perm32(int rho) { const int n = rho >> 4, i = rho & 15; return 8 * (i >> 2) + 4 * n + (i & 3); }
struct Unit { int pm, pn, ks; };
struct Gemm { const bf16_t* A; const bf16_t* Bt; int M, N, K, kp; };
struct StaticOrder {
    int nM, nN, nwg, G, c;
    __host__ __device__ void init(int M_, int N_, int G_, int c_) { nM = M_ / BM; nN = N_ / BM; nwg = nM * nN; G = G_; c = c_; }
    __host__ __device__ bool next(int i, Unit& u) const {
        const long L = (long)i * G + c; if (L >= nwg) return false;
        int wgid = (int)L; { const int q = nwg / NXCD, r = nwg % NXCD, xcd = wgid % NXCD, off = wgid / NXCD; wgid = (xcd < r ? xcd * (q + 1) : r * (q + 1) + (xcd - r) * q) + off; }
        const int nig = WGM * nN, gid = wgid / nig, fm = gid * WGM, gsz = (nM - fm) < WGM ? (nM - fm) : WGM;
        u.pm = fm + ((wgid % nig) % gsz); u.pn = (wgid % nig) / gsz; u.ks = 0; return true;
    }
    __device__ __forceinline__ void a_ready(const Unit&) const {}
    __device__ __forceinline__ void done(const Unit&) const {}
};

template <class Epi, class Sched, bool ALIGN_EPI = false, bool SP2 = false>
__device__ __forceinline__ void gemm_phase(PG8_LAS unsigned char* lds, const Gemm g, const Sched& S, const Epi& E) {
    int tid = threadIdx.x; asm volatile("" : "+v"(tid));
    const int wid = __builtin_amdgcn_readfirstlane(tid >> 6), lane = tid & 63, wr = wid >> 2, wc = wid & 3, fr = lane & 15, fq = lane >> 4;
    const int K = g.K, nt = K / BK, KPI = g.kp;
    unsigned voffA[2], voffB[2];
#pragma unroll
    for (int i = 0; i < 2; ++i) { int R, C; stage_rc(tid * 16 + i * 8192, R, C); const int Rb = Epi::PERM ? ((R & ~31) + perm32(R & 31)) : R;
        voffA[i] = (unsigned)(R * KPI + C) * 2u; voffB[i] = (unsigned)(Rb * KPI + C) * 2u; }
    const size_t kstep = (size_t)(BK * 2);
    const size_t hstep = (size_t)HALF * KPI * 2;
    const size_t sstep = (size_t)K * 2;
    const size_t tstep = 2 * hstep;
    const unsigned ldsw = (unsigned)wid * 1024u;
    const int aoff = lds_byte(wr * 64 + fr, fq * 8), boff = lds_byte(wc * 32 + fr, fq * 8);
#define PG8_SA(b, h) (((b) * 2 + (h)) * HTB)
#define PG8_SB(b, h) ((4 + (b) * 2 + (h)) * HTB)
#define PG8_STAGE(bufoff, gbase, voff) do { _Pragma("unroll") for (int _i = 0; _i < 2; ++_i) \
        __builtin_amdgcn_global_load_lds((const unsigned*)((const char*)(gbase) + (voff)[_i]), (PG8_LAS unsigned*)(lds + (bufoff) + ldsw + _i * 8192), 16, 0, 0); } while (0)
#define PG8_LDA(dst, b, h) do { _Pragma("unroll") for (int m = 0; m < 4; ++m) _Pragma("unroll") for (int k = 0; k < 2; ++k) dst[m][k] = *(const PG8_LAS bf16x8*)(lds + PG8_SA(b, h) + aoff + m * 2048 + k * 1024); } while (0)
#define PG8_LDB(dst, b, h) do { _Pragma("unroll") for (int n = 0; n < 2; ++n) _Pragma("unroll") for (int k = 0; k < 2; ++k) dst[n][k] = *(const PG8_LAS bf16x8*)(lds + PG8_SB(b, h) + boff + n * 2048 + k * 1024); } while (0)
#define PG8_MMA(ai, bj, At, Bt) do { __builtin_amdgcn_s_setprio(1); _Pragma("unroll") for (int m = 0; m < 4; ++m) _Pragma("unroll") for (int n = 0; n < 2; ++n) _Pragma("unroll") for (int k = 0; k < 2; ++k) \
        acc[ai][bj][m][n] = __builtin_amdgcn_mfma_f32_16x16x32_bf16(Bt[n][k], At[m][k], acc[ai][bj][m][n], 0, 0, 0); __builtin_amdgcn_s_setprio(0); } while (0)
#define PG8_WAIT_V(n) asm volatile("s_waitcnt vmcnt(" #n ")" ::: "memory")
#define PG8_WAIT_L(n) asm volatile("s_waitcnt lgkmcnt(" #n ")" ::: "memory")
#define PG8_BAR __builtin_amdgcn_s_barrier()
#define PG8_SCHED __builtin_amdgcn_sched_barrier(0)
    Unit cur, nxt; int ui = 0; typename Epi::Pre pre;
    if (!S.next(0, cur)) return;
    const bool single = Epi::STAGED && !S.next(1, nxt);
    f32x4 acc[2][2][4][2];
#pragma unroll
    for (int a = 0; a < 2; ++a)
#pragma unroll
        for (int b = 0; b < 2; ++b)
#pragma unroll
            for (int m = 0; m < 4; ++m)
#pragma unroll
                for (int n = 0; n < 2; ++n) acc[a][b][m][n] = (f32x4){0.f, 0.f, 0.f, 0.f};
    bf16x8 At[4][2], B0[2][2], B1[2][2];
    const char* cA = (const char*)g.A + (size_t)cur.pm * tstep + (size_t)cur.ks * sstep; const char* cB = (const char*)g.Bt + (size_t)cur.pn * tstep + (size_t)cur.ks * sstep;
    S.a_ready(cur);
    if constexpr (SP2) {
        PG8_STAGE(PG8_SB(0, 0), cB, voffB); PG8_STAGE(PG8_SB(0, 1), cB + hstep, voffB); PG8_STAGE(PG8_SA(0, 0), cA, voffA); PG8_STAGE(PG8_SA(0, 1), cA + hstep, voffA);
        if (wr == 1) PG8_BAR;
        PG8_WAIT_V(2); PG8_BAR;
        PG8_STAGE(PG8_SB(1, 0), cB + kstep, voffB); PG8_STAGE(PG8_SA(1, 0), cA + kstep, voffA); PG8_STAGE(PG8_SB(1, 1), cB + hstep + kstep, voffB);
        PG8_WAIT_V(6); PG8_BAR;
    } else {
        PG8_STAGE(PG8_SB(0, 0), cB, voffB); PG8_STAGE(PG8_SA(0, 0), cA, voffA); PG8_STAGE(PG8_SB(0, 1), cB + hstep, voffB); PG8_STAGE(PG8_SA(0, 1), cA + hstep, voffA);
        if (wr == 1) PG8_BAR;
        PG8_WAIT_V(4); PG8_BAR;
        PG8_STAGE(PG8_SB(1, 0), cB + kstep, voffB); PG8_STAGE(PG8_SA(1, 0), cA + kstep, voffA); PG8_STAGE(PG8_SB(1, 1), cB + hstep + kstep, voffB);
        PG8_WAIT_V(6); PG8_BAR;
    }
    for (;;) {
        const bool has_next = S.next(ui + 1, nxt);
        const char* nA = has_next ? (const char*)g.A + (size_t)nxt.pm * tstep + (size_t)nxt.ks * sstep : cA; const char* nB = has_next ? (const char*)g.Bt + (size_t)nxt.pn * tstep + (size_t)nxt.ks * sstep : cB;
        for (int t = 0; t < nt; t += 2) {
            const bool last = (t == nt - 2);
            const char* a1 = cA + (size_t)(t + 1) * kstep;
            const char* a2 = last ? nA : cA + (size_t)(t + 2) * kstep; const char* b2 = last ? nB : cB + (size_t)(t + 2) * kstep;
            const char* a3 = a2 + kstep; const char* b3 = b2 + kstep;
            if (last && has_next) S.a_ready(nxt);
            if (last) E.pre(cur, wr, fr, fq, pre);
            if constexpr (SP2) {
            PG8_LDB(B0, 0, 0); PG8_LDB(B1, 0, 1); PG8_SCHED; PG8_LDA(At, 0, 0); PG8_STAGE(PG8_SA(1, 1), a1 + hstep, voffA);
            PG8_WAIT_V(8); PG8_WAIT_L(0); PG8_BAR; PG8_MMA(0, 0, At, B0); PG8_MMA(0, 1, At, B1); PG8_BAR; PG8_SCHED;
            PG8_LDA(At, 0, 1); PG8_STAGE(PG8_SB(0, 0), b2, voffB); PG8_STAGE(PG8_SB(0, 1), b2 + hstep, voffB); PG8_STAGE(PG8_SA(0, 0), a2, voffA);
            PG8_WAIT_V(8); PG8_WAIT_L(0); PG8_BAR; PG8_MMA(1, 0, At, B0); PG8_MMA(1, 1, At, B1); PG8_BAR; PG8_SCHED;
            PG8_LDB(B0, 1, 0); PG8_LDB(B1, 1, 1); PG8_SCHED; PG8_LDA(At, 1, 0); PG8_STAGE(PG8_SA(0, 1), a2 + hstep, voffA);
            PG8_WAIT_V(8); PG8_WAIT_L(0); PG8_BAR; PG8_MMA(0, 0, At, B0); PG8_MMA(0, 1, At, B1); PG8_BAR; PG8_SCHED;
            PG8_LDA(At, 1, 1); PG8_STAGE(PG8_SB(1, 0), b3, voffB); PG8_STAGE(PG8_SB(1, 1), b3 + hstep, voffB); PG8_STAGE(PG8_SA(1, 0), a3, voffA);
            PG8_WAIT_V(8); PG8_WAIT_L(0); PG8_BAR; PG8_MMA(1, 0, At, B0); PG8_MMA(1, 1, At, B1); PG8_BAR; PG8_SCHED;
            } else {
            PG8_LDB(B0, 0, 0); PG8_SCHED; PG8_LDA(At, 0, 0); PG8_STAGE(PG8_SA(1, 1), a1 + hstep, voffA);
            PG8_WAIT_L(8); PG8_BAR; PG8_WAIT_L(0); PG8_MMA(0, 0, At, B0); PG8_BAR; PG8_SCHED;
            PG8_LDB(B1, 0, 1); PG8_STAGE(PG8_SB(0, 0), b2, voffB);
            PG8_BAR; PG8_WAIT_L(0); PG8_MMA(0, 1, At, B1); PG8_BAR;
            PG8_LDA(At, 0, 1); PG8_STAGE(PG8_SA(0, 0), a2, voffA);
            PG8_BAR; PG8_WAIT_L(0); PG8_MMA(1, 0, At, B0); PG8_BAR; PG8_SCHED;
            PG8_STAGE(PG8_SB(0, 1), b2 + hstep, voffB);
            PG8_WAIT_V(6); PG8_BAR; PG8_MMA(1, 1, At, B1); PG8_BAR;
            PG8_LDB(B0, 1, 0); PG8_SCHED; PG8_LDA(At, 1, 0); PG8_STAGE(PG8_SA(0, 1), a2 + hstep, voffA);
            PG8_WAIT_L(8); PG8_BAR; PG8_WAIT_L(0); PG8_MMA(0, 0, At, B0); PG8_BAR; PG8_SCHED;
            PG8_LDB(B1, 1, 1); PG8_STAGE(PG8_SB(1, 0), b3, voffB);
            PG8_BAR; PG8_WAIT_L(0); PG8_MMA(0, 1, At, B1); PG8_BAR;
            PG8_LDA(At, 1, 1); PG8_STAGE(PG8_SA(1, 0), a3, voffA);
            PG8_BAR; PG8_WAIT_L(0); PG8_MMA(1, 0, At, B0); PG8_BAR; PG8_SCHED;
            PG8_STAGE(PG8_SB(1, 1), b3 + hstep, voffB);
            PG8_WAIT_V(6); PG8_BAR; PG8_MMA(1, 1, At, B1); PG8_BAR;
            }
        }
        if constexpr (ALIGN_EPI) { if (wr == 0) PG8_BAR; }
        if (!(Epi::STAGED && single)) { E(acc, cur, wr, wc, fr, fq, pre); } S.done(cur);
        if (!has_next) break;
#pragma unroll
        for (int a = 0; a < 2; ++a)
#pragma unroll
            for (int b = 0; b < 2; ++b)
#pragma unroll
                for (int m = 0; m < 4; ++m)
#pragma unroll
                    for (int n = 0; n < 2; ++n) acc[a][b][m][n] = (f32x4){0.f, 0.f, 0.f, 0.f};
        cur = nxt; cA = nA; cB = nB; ++ui;
        if constexpr (ALIGN_EPI) { if (wr == 1) PG8_BAR; }
    }
    PG8_WAIT_V(0);
    if constexpr (!ALIGN_EPI) { if (wr == 0) PG8_BAR; }
    PG8_BAR;
    if constexpr (Epi::STAGED) { if (single) E.staged(acc, cur, wr, wc, fr, fq, lds); }
#undef PG8_SA
#undef PG8_SB
#undef PG8_STAGE
#undef PG8_LDA
#undef PG8_LDB
#undef PG8_MMA
#undef PG8_WAIT_V
#undef PG8_WAIT_L
#undef PG8_BAR
#undef PG8_SCHED
}

__device__ __forceinline__ float rstd_q(const P& p, int row, int fr, int fq) {
    const f32x4 t = *(const f32x4*)(p.SS + (size_t)row * NSS + 4 * fq); float s = (t[0] + t[1]) + (t[2] + t[3]); const int ln = fq * 16 + fr;
    s += lane_xor_f(s, ln, 16); s += lane_xor_f(s, ln, 32); return __builtin_amdgcn_rsqf(s * (1.f / D_MODEL) + EPS);
}
struct RowStats { f32x4 t[4]; };
__device__ __forceinline__ void rstd_issue(const P& p, int rowbase, int fq, f32x4 (&t)[4]) {
#pragma unroll
    for (int m = 0; m < 4; ++m) t[m] = *(const f32x4*)(p.SS + (size_t)(rowbase + m * 16) * NSS + 4 * fq);
}
__device__ __forceinline__ void rstd_finish(const f32x4 (&t)[4], int fr, int fq, float (&rs)[4]) {
    const int ln = fq * 16 + fr; float s[4], x[4];
#pragma unroll
    for (int m = 0; m < 4; ++m) s[m] = (t[m][0] + t[m][1]) + (t[m][2] + t[m][3]);
#pragma unroll
    for (int m = 0; m < 4; ++m) x[m] = lane_xor_f(s[m], ln, 16);
#pragma unroll
    for (int m = 0; m < 4; ++m) s[m] += x[m];
#pragma unroll
    for (int m = 0; m < 4; ++m) x[m] = lane_xor_f(s[m], ln, 32);
#pragma unroll
    for (int m = 0; m < 4; ++m) rs[m] = __builtin_amdgcn_rsqf((s[m] + x[m]) * (1.f / D_MODEL) + EPS);
}
struct NoPre { };
struct EpiSwiglu {
    static constexpr bool PERM = true, STAGED = false; P p; typedef RowStats Pre;
    __device__ __forceinline__ void pre(const Unit& u, int wr, int fr, int fq, Pre& r) const { asm volatile("" : "+v"(fr), "+v"(fq)); rstd_issue(p, u.pm * BM + wr * 64 + fr, fq, r.t); }
    __device__ __forceinline__ void operator()(const f32x4 (&acc)[2][2][4][2], const Unit& u, int wr, int wc, int fr, int fq, const Pre& pr) const {
        asm volatile("" : "+v"(fr), "+v"(fq));
        EfSwiglu F; float rs[2][4]; f32x4 t1[4]; rstd_issue(p, u.pm * BM + HALF + wr * 64 + fr, fq, t1); rstd_finish(pr.t, fr, fq, rs[0]);
#pragma unroll
        for (int ai = 0; ai < 2; ++ai) { if (ai == 1) rstd_finish(t1, fr, fq, rs[1]);
#pragma unroll
            for (int m = 0; m < 4; ++m) { const int row = u.pm * BM + ai * HALF + wr * 64 + m * 16 + fr; const float rstd = rs[ai][m];
                float a[8], b[8];
#pragma unroll
                for (int n = 0; n < 2; ++n)
#pragma unroll
                    for (int e = 0; e < 4; ++e) { a[n * 4 + e] = acc[ai][0][m][n][e]; b[n * 4 + e] = acc[ai][1][m][n][e]; }
                F(p, row, u.pn * HALF + wc * 32 + 8 * fq, rstd, a, b); } }
    }
};
template <class F> struct EpiRow {
    static constexpr bool PERM = true, STAGED = false; P p; typedef RowStats Pre;
    __device__ __forceinline__ void pre(const Unit& u, int wr, int fr, int fq, Pre& r) const { asm volatile("" : "+v"(fr), "+v"(fq)); rstd_issue(p, u.pm * BM + wr * 64 + fr, fq, r.t); }
    __device__ __forceinline__ void operator()(const f32x4 (&acc)[2][2][4][2], const Unit& u, int wr, int wc, int fr, int fq, const Pre& pr) const {
        asm volatile("" : "+v"(fr), "+v"(fq));
        F f; float rs[2][4]; f32x4 t1[4]; rstd_issue(p, u.pm * BM + HALF + wr * 64 + fr, fq, t1); rstd_finish(pr.t, fr, fq, rs[0]);
#pragma unroll
        for (int ai = 0; ai < 2; ++ai) { if (ai == 1) rstd_finish(t1, fr, fq, rs[1]);
#pragma unroll
            for (int m = 0; m < 4; ++m) { const int row = u.pm * BM + ai * HALF + wr * 64 + m * 16 + fr; const float rstd = rs[ai][m];
#pragma unroll
                for (int bj = 0; bj < 2; ++bj) { float v[8];
#pragma unroll
                    for (int n = 0; n < 2; ++n)
#pragma unroll
                        for (int e = 0; e < 4; ++e) v[n * 4 + e] = acc[ai][bj][m][n][e];
                    f(p, row, u.pn * BM + bj * HALF + wc * 32 + 8 * fq, rstd, v); } } }
    }
};
constexpr int STG_PX = 1056;
constexpr int STG_SS = 128 * STG_PX;
struct EpiResid {
    static constexpr bool PERM = true, STAGED = true; P p; int first; typedef NoPre Pre;
    __device__ __forceinline__ void pre(const Unit&, int, int, int, Pre&) const {}
    __device__ __forceinline__ void staged(const f32x4 (&acc)[2][2][4][2], const Unit& u, int wr, int wc, int fr, int fq, PG8_LAS unsigned char* lds) const {
        asm volatile("" : "+v"(fr), "+v"(fq));
        const int w8 = wr * 4 + wc, lane = fq * 16 + fr;
#pragma unroll 1
        for (int ai = 0; ai < 2; ++ai) {
            const size_t grow0 = (size_t)u.pm * BM + ai * HALF;
            f32x4 x[4][2][2];
            if (first) {
#pragma unroll
                for (int m = 0; m < 4; ++m)
#pragma unroll
                    for (int bj = 0; bj < 2; ++bj) { const float* xp = p.x_prompt + (grow0 + wr * 64 + m * 16 + fr) * D_MODEL + u.pn * BM + bj * HALF + wc * 32 + 8 * fq; x[m][bj][0] = *(const f32x4*)xp; x[m][bj][1] = *(const f32x4*)(xp + 4); }
            } else {
                u32x4 h[4][2], l[4][2];
#pragma unroll
                for (int m = 0; m < 4; ++m)
#pragma unroll
                    for (int bj = 0; bj < 2; ++bj) { const size_t go = (grow0 + wr * 64 + m * 16 + fr) * D_MODEL + u.pn * BM + bj * HALF + wc * 32 + 8 * fq; h[m][bj] = *(const u32x4*)(p.XB + go); l[m][bj] = *(const u32x4*)(p.XLO + go); }
#pragma unroll
                for (int m = 0; m < 4; ++m)
#pragma unroll
                    for (int bj = 0; bj < 2; ++bj) { x[m][bj][0] = join4(h[m][bj][0], h[m][bj][1], l[m][bj][0], l[m][bj][1]); x[m][bj][1] = join4(h[m][bj][2], h[m][bj][3], l[m][bj][2], l[m][bj][3]); }
            }
#pragma unroll
            for (int m = 0; m < 4; ++m) { const int rl = wr * 64 + m * 16 + fr; float sq = 0.f;
#pragma unroll
                for (int bj = 0; bj < 2; ++bj) { const int cf = bj * HALF + wc * 32 + 8 * fq;
#pragma unroll
                    for (int n = 0; n < 2; ++n) { const f32x4 a = ai == 0 ? acc[0][bj][m][n] : acc[1][bj][m][n]; const f32x4 v = x[m][bj][n] + a;
                        sq += (v[0] * v[0] + v[1] * v[1]) + (v[2] * v[2] + v[3] * v[3]); *(PG8_LAS f32x4*)(lds + rl * STG_PX + (cf + 4 * n) * 4) = v; } }
                sq += lane_xor_f(sq, lane, 16); sq += lane_xor_f(sq, lane, 32);
                if (fq == 0) *(PG8_LAS float*)(lds + STG_SS + (rl * 4 + wc) * 4) = sq; }
            asm volatile("s_waitcnt lgkmcnt(0)" ::: "memory"); __builtin_amdgcn_s_barrier(); asm volatile("" ::: "memory");
#pragma unroll
            for (int i = 0; i < 8; ++i) { const int rl = w8 * 16 + 2 * i + (lane >> 5), c8 = lane & 31;
                const f32x4 v0 = *(const PG8_LAS f32x4*)(lds + rl * STG_PX + c8 * 32), v1 = *(const PG8_LAS f32x4*)(lds + rl * STG_PX + c8 * 32 + 16);
                u32x4 oh, ol; SPLIT2(v0[0], v0[1], oh[0], ol[0]); SPLIT2(v0[2], v0[3], oh[1], ol[1]); SPLIT2(v1[0], v1[1], oh[2], ol[2]); SPLIT2(v1[2], v1[3], oh[3], ol[3]);
                const size_t go = (grow0 + rl) * D_MODEL + u.pn * BM + c8 * 8;
                *(u32x4*)(p.XB + go) = oh; *(u32x4*)(p.XLO + go) = ol; }
            if (w8 < 2) { const int rl = w8 * 64 + lane; const f32x4 q4 = *(const PG8_LAS f32x4*)(lds + STG_SS + rl * 16); *(f32x4*)(p.SS + (grow0 + rl) * NSS + u.pn * 4) = q4; }
            asm volatile("s_waitcnt lgkmcnt(0)" ::: "memory"); __builtin_amdgcn_s_barrier(); asm volatile("" ::: "memory");
        }
    }
    __device__ __forceinline__ void operator()(const f32x4 (&acc)[2][2][4][2], const Unit& u, int wr, int wc, int fr, int fq, const Pre&) const {
        asm volatile("" : "+v"(fr), "+v"(fq));
#pragma unroll
        for (int ai = 0; ai < 2; ++ai)
#pragma unroll
            for (int m = 0; m < 4; ++m) { const int row = u.pm * BM + ai * HALF + wr * 64 + m * 16 + fr; float s = 0.f;
#pragma unroll
                for (int bj = 0; bj < 2; ++bj) { const size_t go = (size_t)row * D_MODEL + u.pn * BM + bj * HALF + wc * 32 + 8 * fq; f32x4 x0, x1;
                    if (first) { x0 = *(const f32x4*)(p.x_prompt + go); x1 = *(const f32x4*)(p.x_prompt + go + 4); }
                    else { const u32x4 h = *(const u32x4*)(p.XB + go), l = *(const u32x4*)(p.XLO + go); x0 = join4(h[0], h[1], l[0], l[1]); x1 = join4(h[2], h[3], l[2], l[3]); }
                    x0 += acc[ai][bj][m][0]; x1 += acc[ai][bj][m][1];
                    s += ((x0[0] * x0[0] + x0[1] * x0[1]) + (x0[2] * x0[2] + x0[3] * x0[3])) + ((x1[0] * x1[0] + x1[1] * x1[1]) + (x1[2] * x1[2] + x1[3] * x1[3]));
                    u32x4 oh, ol; SPLIT2(x0[0], x0[1], oh[0], ol[0]); SPLIT2(x0[2], x0[3], oh[1], ol[1]); SPLIT2(x1[0], x1[1], oh[2], ol[2]); SPLIT2(x1[2], x1[3], oh[3], ol[3]);
                    *(u32x4*)(p.XB + go) = oh; *(u32x4*)(p.XLO + go) = ol; }
                { const int ln = fq * 16 + fr; s += lane_xor_f(s, ln, 16); s += lane_xor_f(s, ln, 32); }
                if (fq == 0) p.SS[(size_t)row * NSS + u.pn * 4 + wc] = s; }
    }
};
struct SplitOrder {
    int pm0, nN, S, n, G, c;
    __host__ __device__ void init(int pm0_, int nM_, int nN_, int S_, int G_, int c_) { pm0 = pm0_; nN = nN_; S = S_; n = nM_ * nN_ * S_; G = G_; c = c_; }
    __host__ __device__ bool next(int i, Unit& u) const { const long L = (long)i * G + c; if (L >= n) return false; const int t = (int)L / S; u.ks = (int)L % S; u.pn = t % nN; u.pm = pm0 + t / nN; return true; }
    __device__ __forceinline__ void a_ready(const Unit&) const {}
    __device__ __forceinline__ void done(const Unit&) const {}
};
struct EpiNull {
    static constexpr bool PERM = true, STAGED = false; typedef NoPre Pre;
    __device__ __forceinline__ void pre(const Unit&, int, int, int, Pre&) const {}
    __device__ __forceinline__ void operator()(const f32x4 (&acc)[2][2][4][2], const Unit&, int, int, int, int, const Pre&) const {
#pragma unroll
        for (int a = 0; a < 2; ++a)
#pragma unroll
            for (int b = 0; b < 2; ++b)
#pragma unroll
                for (int m = 0; m < 4; ++m) { asm volatile("" :: "v"(acc[a][b][m][0]), "v"(acc[a][b][m][1])); }
    }
};
struct EpiPart {
    static constexpr bool PERM = true, STAGED = true; P p; typedef NoPre Pre;
    __device__ __forceinline__ void pre(const Unit&, int, int, int, Pre&) const {}
    __device__ __forceinline__ void staged(const f32x4 (&acc)[2][2][4][2], const Unit& u, int wr, int wc, int fr, int fq, PG8_LAS unsigned char* lds) const {
        asm volatile("" : "+v"(fr), "+v"(fq));
        const int w8 = wr * 4 + wc, lane = fq * 16 + fr;
#pragma unroll 1
        for (int ai = 0; ai < 2; ++ai) {
#pragma unroll
            for (int m = 0; m < 4; ++m) { const int rl = wr * 64 + m * 16 + fr;
#pragma unroll
                for (int bj = 0; bj < 2; ++bj) { const int cf = bj * HALF + wc * 32 + 8 * fq;
#pragma unroll
                    for (int n = 0; n < 2; ++n) *(PG8_LAS f32x4*)(lds + rl * STG_PX + (cf + 4 * n) * 4) = ai == 0 ? acc[0][bj][m][n] : acc[1][bj][m][n]; } }
            asm volatile("s_waitcnt lgkmcnt(0)" ::: "memory"); __builtin_amdgcn_s_barrier(); asm volatile("" ::: "memory");
            float* base = p.PART + ((size_t)u.ks * MS + (size_t)(u.pm * BM - MP) + ai * HALF) * D_MODEL + u.pn * BM + lane * 4;
#pragma unroll
            for (int i = 0; i < 16; ++i) { const int rl = w8 * 16 + i; *(f32x4*)(base + (size_t)rl * D_MODEL) = *(const PG8_LAS f32x4*)(lds + rl * STG_PX + lane * 16); }
            asm volatile("s_waitcnt lgkmcnt(0)" ::: "memory"); __builtin_amdgcn_s_barrier(); asm volatile("" ::: "memory");
        }
    }
    __device__ __forceinline__ void operator()(const f32x4 (&acc)[2][2][4][2], const Unit& u, int wr, int wc, int fr, int fq, const Pre&) const {
        asm volatile("" : "+v"(fr), "+v"(fq));
        float* base = p.PART + ((size_t)u.ks * MS + (size_t)(u.pm * BM - MP)) * D_MODEL + u.pn * BM + wc * 32 + 8 * fq;
#pragma unroll
        for (int ai = 0; ai < 2; ++ai)
#pragma unroll
            for (int m = 0; m < 4; ++m) { float* rp = base + (size_t)(ai * HALF + wr * 64 + m * 16 + fr) * D_MODEL;
#pragma unroll
                for (int bj = 0; bj < 2; ++bj) { *(f32x4*)(rp + bj * HALF) = acc[ai][bj][m][0]; *(f32x4*)(rp + bj * HALF + 4) = acc[ai][bj][m][1]; } }
    }
};
}

#define XB_TMO      128
#define XB_XCNT(j)  (256  + 64 * (j))
#define XB_XSUB(j)  (1280 + 64 * (j))
#define XB_XGEN(j)  (2304 + 64 * (j))
#define XB_TOP      3328
#define XB_TOPGEN   3392
#define XCD_BAR_WORDS 3456
#ifndef XB_SPIN_CAP
#define XB_SPIN_CAP (1u << 26)
#endif
__device__ __forceinline__ unsigned xb_ld(unsigned* p)              { return __hip_atomic_load(p, __ATOMIC_RELAXED, __HIP_MEMORY_SCOPE_AGENT); }
__device__ __forceinline__ unsigned xb_add(unsigned* p, unsigned v) { return __hip_atomic_fetch_add(p, v, __ATOMIC_RELAXED, __HIP_MEMORY_SCOPE_AGENT); }
__device__ __forceinline__ unsigned xb_xcc_id() { return (unsigned)__builtin_amdgcn_s_getreg((3 << 11) | 20) & 0xFu; }
#define XB_SPIN(cond, bar) do { unsigned _sp = 0; while (cond) { __builtin_amdgcn_s_sleep(1); \
    if ((++_sp & 255u) == 0u) { if (xb_ld(&(bar)[XB_TMO])) break; if (_sp > XB_SPIN_CAP) { atomicAdd(&(bar)[XB_TMO], 1u); break; } } } } while (0)
struct XcdBarrier { unsigned* bar; unsigned x; volatile LAS unsigned* st; };
__device__ __forceinline__ XcdBarrier xcd_barrier_post(unsigned* bar, volatile LAS unsigned* st) {
    XcdBarrier b; b.bar = bar; b.x = xb_xcc_id(); b.st = st;
    if (threadIdx.x == 0) (void)xb_add(&bar[XB_XCNT(b.x)], 1u);
    return b;
}
__device__ __forceinline__ void xcd_barrier_complete(unsigned* bar, unsigned x, unsigned& nloc, unsigned& nx) {
    const unsigned G = gridDim.x * gridDim.y * gridDim.z;
    unsigned sum, cnt, mine, sp = 0u;
    for (;;) {
        sum = 0u; cnt = 0u; mine = 0u;
#pragma unroll
        for (unsigned j = 0; j < 16; ++j) { const unsigned c = xb_ld(&bar[XB_XCNT(j)]); sum += c; cnt += (c > 0u) ? 1u : 0u; mine = (j == x) ? c : mine; }
        if (sum == G) break;
        __builtin_amdgcn_s_sleep(1);
        if ((++sp & 255u) == 0u) { if (xb_ld(&bar[XB_TMO])) break; if (sp > XB_SPIN_CAP) { atomicAdd(&bar[XB_TMO], 1u); break; } }
    }
    nloc = mine > 0u ? mine : 1u; nx = cnt > 0u ? cnt : 1u;
}
__device__ __attribute__((noinline)) void xcd_barrier(const XcdBarrier b) {
    asm volatile("s_waitcnt vmcnt(0)" ::: "memory");
    __syncthreads();
    if (threadIdx.x == 0) {
        unsigned* bar = b.bar;
        __builtin_amdgcn_s_waitcnt(0);
        unsigned nloc = b.st[0], nx = b.st[1];
        if (nloc == 0u) { xcd_barrier_complete(bar, b.x, nloc, nx); b.st[0] = nloc; b.st[1] = nx; }
        const unsigned old = xb_add(&bar[XB_XSUB(b.x)], 1u);
        const unsigned gen = old / nloc;
        if (old + 1u == (gen + 1u) * nloc) {
            __builtin_amdgcn_fence(__ATOMIC_RELEASE, "agent");
            asm volatile("s_waitcnt vmcnt(0)" ::: "memory");
            const unsigned og = xb_add(&bar[XB_TOP], 1u);
            const unsigned tg = og / nx;
            if (og + 1u == (tg + 1u) * nx) xb_add(&bar[XB_TOPGEN], 1u);
            else XB_SPIN(xb_ld(&bar[XB_TOPGEN]) == tg, bar);
            __builtin_amdgcn_fence(__ATOMIC_ACQUIRE, "agent");
            xb_add(&bar[XB_XGEN(b.x)], 1u);
            asm volatile("s_waitcnt vmcnt(0)" ::: "memory");
        } else {
            XB_SPIN(xb_ld(&bar[XB_XGEN(b.x)]) == gen, bar);
            __builtin_amdgcn_fence(__ATOMIC_ACQUIRE, "agent");
            asm volatile("s_waitcnt vmcnt(0)" ::: "memory");
        }
    }
    __syncthreads();
}


constexpr int MISC_OFF_ = 163840 - 1024, NTHR_ = 512, NWAVES_ = 8;
#ifndef PROBE_MASK
#define PROBE_MASK 0
#endif
#define REP(k) for (int rep_ = 0; rep_ < (((PROBE_MASK) >> (k)) & 1 ? 2 : 1); ++rep_)
namespace ssd {
typedef short bf16x8 __attribute__((ext_vector_type(8)));
typedef float f32x4 __attribute__((ext_vector_type(4)));
typedef unsigned u32x4 __attribute__((ext_vector_type(4)));
typedef unsigned u32x2 __attribute__((ext_vector_type(2)));
constexpr int PT = 136;
constexpr int L_C = 0, L_B = L_C + 128 * PT * 2, L_X = L_B + 128 * PT * 2, L_TA = L_X + 256 * PT * 2, L_TD = L_TA + 2048, L_END = L_TD + 2048;
static_assert(L_END <= MISC_OFF_ && SSD_HPG == 4 && D_STATE == 128 && GW == 256 && CHUNK == 128, "ssd fast path geometry");
__device__ __forceinline__ unsigned pk_bf16(float lo, float hi) { return pk2bf(lo, hi); }
__device__ __forceinline__ void unpack8(const u32x4 v, float* o) {
#pragma unroll
    for (int i = 0; i < 4; ++i) { o[2 * i] = __uint_as_float(v[i] << 16); o[2 * i + 1] = __uint_as_float(v[i] & 0xffff0000u); }
}
__device__ __forceinline__ float fast_silu(float x) { return silu_f(x); }

__device__ __forceinline__ void tables_issue(const P& p, int row0, int g, int w, int lane, float (&tin)[3]) {
    if (w < 4) { const int head = g * 4 + w;
        tin[0] = p.DT[(size_t)(row0 + 2 * lane) * SSD_HEADS + head]; tin[1] = p.DT[(size_t)(row0 + 2 * lane + 1) * SSD_HEADS + head]; tin[2] = p.ssm_a_log[head]; }
}
__device__ __forceinline__ void tables_finish(const float (&tin)[3], LAS float* tA, LAS float* tD, int w, int lane) {
    if (w < 4) {
        const float a = -expf(tin[2]); const float d0 = tin[0], d1 = tin[1];
        const float v0 = d0 * a, v1 = d1 * a; float s = v0 + v1;
#pragma unroll
        for (int o = 1; o < 64; o <<= 1) { const float t = lane_up_f(s, lane, o); if (lane >= o) s += t; }
        tA[w * 128 + 2 * lane] = s - v1; tA[w * 128 + 2 * lane + 1] = s; tD[w * 128 + 2 * lane] = d0; tD[w * 128 + 2 * lane + 1] = d1;
    }
}
struct ConvIn { u32x4 raw[16], wn[3]; f32x4 wt[10]; };
template <int MODE> __device__ __forceinline__ void conv_issue(const P& p, int row0, bool first_chunk, int g, int w, int lane, ConvIn& ci) {
    const int cls = lane < 32 ? 0 : (lane < 48 ? 1 : 2);
    if (MODE == 0 && cls == 2) return;
    const int chb = cls == 0 ? g * GW + 8 * lane : (cls == 1 ? D_INNER + g * D_STATE + 8 * (lane - 32) : D_INNER + SSD_GROUPS * D_STATE + g * D_STATE + 8 * (lane - 48));
#pragma unroll
    for (int k = 0; k < 4; ++k) { ci.wt[2 * k] = *(const f32x4*)(p.ssm_conv_w + k * CONV_DIM + chb); ci.wt[2 * k + 1] = *(const f32x4*)(p.ssm_conv_w + k * CONV_DIM + chb + 4); }
    ci.wt[8] = *(const f32x4*)(p.ssm_conv_b + chb); ci.wt[9] = *(const f32x4*)(p.ssm_conv_b + chb + 4);
    const bf16* src = p.ZX + (size_t)row0 * ZXP + D_INNER + chb;
    const int r0 = 16 * w;
#pragma unroll
    for (int i = 0; i < 3; ++i) { const int rr = r0 - 3 + i;
        if (rr < 0 && first_chunk) ci.wn[i] = (u32x4){0u, 0u, 0u, 0u}; else ci.wn[i] = *(const u32x4*)(src + (long)rr * ZXP); }
#pragma unroll
    for (int i = 0; i < 16; ++i) ci.raw[i] = *(const u32x4*)(src + (long)(r0 + i) * ZXP);
}
template <int MODE> __device__ __forceinline__ void conv_compute(LAS unsigned char* lds, int w, int lane, const ConvIn& ci) {
    const int cls = lane < 32 ? 0 : (lane < 48 ? 1 : 2);
    if (MODE == 0 && cls == 2) return;
    float cw[4][8], cb[8];
#pragma unroll
    for (int k = 0; k < 4; ++k)
#pragma unroll
        for (int e = 0; e < 4; ++e) { cw[k][e] = ci.wt[2 * k][e]; cw[k][4 + e] = ci.wt[2 * k + 1][e]; }
#pragma unroll
    for (int e = 0; e < 4; ++e) { cb[e] = ci.wt[8][e]; cb[4 + e] = ci.wt[9][e]; }
    const int r0 = 16 * w; float win[3][8];
#pragma unroll
    for (int i = 0; i < 3; ++i) unpack8(ci.wn[i], win[i]);
    const LAS float* tA = (const LAS float*)(lds + L_TA); const LAS float* tD = (const LAS float*)(lds + L_TD);
    const int j = lane >> 3;
    float alast = 0.f; if (MODE == 0 && cls == 0) alast = tA[j * 128 + 127];
    const bool transposed = (cls == 0) || (MODE == 0);
    const int tbase = cls == 0 ? L_X + (8 * lane) * PT * 2 : L_B + (8 * (lane - 32)) * PT * 2;
    const int nbase = cls == 1 ? L_B + 8 * (lane - 32) * 2 : L_C + 8 * (lane - 48) * 2;
    const u32x4 (&raw)[16] = ci.raw;
#pragma unroll
    for (int half = 0; half < 2; ++half) {
        unsigned tp[4][8];
#pragma unroll
        for (int rp = 0; rp < 4; ++rp) {
            const int sr = r0 + half * 8 + rp * 2;
            float c0[8], c1[8], o0[8], o1[8]; unpack8(raw[half * 8 + 2 * rp], c0); unpack8(raw[half * 8 + 2 * rp + 1], c1);
#pragma unroll
            for (int e = 0; e < 8; ++e) {
                o0[e] = fast_silu(cb[e] + cw[0][e] * win[0][e] + cw[1][e] * win[1][e] + cw[2][e] * win[2][e] + cw[3][e] * c0[e]);
                o1[e] = fast_silu(cb[e] + cw[0][e] * win[1][e] + cw[1][e] * win[2][e] + cw[2][e] * c0[e] + cw[3][e] * c1[e]);
                win[0][e] = win[2][e]; win[1][e] = c0[e]; win[2][e] = c1[e]; }
            if (MODE == 0 && cls == 0) { const float f0 = tD[j * 128 + sr] * __expf(alast - tA[j * 128 + sr]), f1 = tD[j * 128 + sr + 1] * __expf(alast - tA[j * 128 + sr + 1]);
#pragma unroll
                for (int e = 0; e < 8; ++e) { o0[e] *= f0; o1[e] *= f1; } }
            if (transposed) {
#pragma unroll
                for (int e = 0; e < 8; ++e) tp[rp][e] = pk_bf16(o0[e], o1[e]);
            } else {
                u32x4 v0, v1;
#pragma unroll
                for (int e = 0; e < 4; ++e) { v0[e] = pk_bf16(o0[2 * e], o0[2 * e + 1]); v1[e] = pk_bf16(o1[2 * e], o1[2 * e + 1]); }
                *(LAS u32x4*)(lds + nbase + sr * PT * 2) = v0; *(LAS u32x4*)(lds + nbase + (sr + 1) * PT * 2) = v1;
            }
        }
        if (transposed) {
#pragma unroll
            for (int e = 0; e < 8; ++e) *(LAS u32x4*)(lds + tbase + e * PT * 2 + (r0 + half * 8) * 2) = (u32x4){tp[0][e], tp[1][e], tp[2][e], tp[3][e]};
        }
    }
}
__device__ __forceinline__ void states_phase(const P& p, int G, int bx, LAS unsigned char* lds) {
    LAS float* tA = (LAS float*)(lds + L_TA); LAS float* tD = (LAS float*)(lds + L_TD);
    constexpr int NU = BATCH * NCHUNK * SSD_GROUPS;
    ConvIn ci; float tin[3];
    int u = bx;
    if (u < NU) { int t0 = threadIdx.x; asm volatile("" : "+v"(t0)); const int w0 = __builtin_amdgcn_readfirstlane(t0 >> 6), l0 = t0 & 63;
        const int bc = u / SSD_GROUPS, g = u % SSD_GROUPS; tables_issue(p, bc * CHUNK, g, w0, l0, tin); conv_issue<0>(p, bc * CHUNK, (bc % NCHUNK) == 0, g, w0, l0, ci); }
    for (; u < NU; u += G) {
    int tid = threadIdx.x; asm volatile("" : "+v"(tid));
    const int w = __builtin_amdgcn_readfirstlane(tid >> 6), lane = tid & 63, fr = lane & 15, fq = lane >> 4;
    const int bc = u / SSD_GROUPS, g = u % SSD_GROUPS;
    tables_finish(tin, tA, tD, w, lane);
    __syncthreads();
    if (tid < 4) p.CDEC[bc * SSD_HEADS + g * 4 + tid] = __expf(tA[tid * 128 + 127]);
    conv_compute<0>(lds, w, lane, ci);
    { const int un = u + G;
      if (un < NU) { int t1 = threadIdx.x; asm volatile("" : "+v"(t1)); const int w1 = __builtin_amdgcn_readfirstlane(t1 >> 6), l1 = t1 & 63;
          const int bcn = un / SSD_GROUPS, gn = un % SSD_GROUPS; tables_issue(p, bcn * CHUNK, gn, w1, l1, tin); conv_issue<0>(p, bcn * CHUNK, (bcn % NCHUNK) == 0, gn, w1, l1, ci); } }
    __syncthreads();
    bf16x8 af[4];
#pragma unroll
    for (int kk = 0; kk < 4; ++kk) af[kk] = *(const LAS bf16x8*)(lds + L_B + ((16 * w + fr) * PT + 32 * kk + 8 * fq) * 2);
#pragma unroll
    for (int j = 0; j < 4; ++j)
#pragma unroll
        for (int pt = 0; pt < 4; ++pt) { f32x4 acc = {0.f, 0.f, 0.f, 0.f};
#pragma unroll
            for (int kk = 0; kk < 4; ++kk) { const bf16x8 b = *(const LAS bf16x8*)(lds + L_X + ((j * 64 + 16 * pt + fr) * PT + 32 * kk + 8 * fq) * 2);
                acc = __builtin_amdgcn_mfma_f32_16x16x32_bf16(af[kk], b, acc, 0, 0, 0); }
            *(f32x4*)(p.STATES + (((size_t)bc * SSD_HEADS + g * 4 + j) * HEADDIM + 16 * pt + fr) * D_STATE + 16 * w + 4 * fq) = acc; }
    __syncthreads();
    }
}
constexpr long N_SCAN4 = (long)BATCH * SSD_HEADS * HEADDIM * D_STATE / 4;
__device__ __forceinline__ void scan4(const P& p, long i) {
    const int e4 = (int)(i % (HEADDIM * D_STATE / 4)); long r = i / (HEADDIM * D_STATE / 4); const int head = (int)(r % SSD_HEADS), b = (int)(r / SSD_HEADS);
    f32x4 h = {0.f, 0.f, 0.f, 0.f};
    for (int c = 0; c < NCHUNK; ++c) { const size_t idx = (((size_t)(b * NCHUNK + c)) * SSD_HEADS + head) * (HEADDIM * D_STATE) + e4 * 4;
        const f32x4 st = *(const f32x4*)(p.STATES + idx); const float dec = p.CDEC[(b * NCHUNK + c) * SSD_HEADS + head];
        u32x2 o; o[0] = pk_bf16(h[0], h[1]); o[1] = pk_bf16(h[2], h[3]); *(u32x2*)(p.HPREV + idx) = o;
        h = h * dec + st; }
    *(f32x4*)(p.ssm_prompt + (size_t)i * 4) = h;
}
__device__ __forceinline__ void y_unit(const P& p, int bc, int g, LAS unsigned char* lds) {
    int tid = threadIdx.x; asm volatile("" : "+v"(tid));
    const int w = __builtin_amdgcn_readfirstlane(tid >> 6), lane = tid & 63, fr = lane & 15, fq = lane >> 4;
    const int row0 = bc * CHUNK; LAS float* tA = (LAS float*)(lds + L_TA); LAS float* tD = (LAS float*)(lds + L_TD);
    { ConvIn ci; float tin[3];
      tables_issue(p, row0, g, w, lane, tin); conv_issue<1>(p, row0, (bc % NCHUNK) == 0, g, w, lane, ci);
      tables_finish(tin, tA, tD, w, lane);
      conv_compute<1>(lds, w, lane, ci); }
    __syncthreads();
    const int wq = (w & 1) ? 7 - (w >> 1) : (w >> 1);
    const int q = 16 * wq + fr;
    bf16x8 cf[4];
#pragma unroll
    for (int kk = 0; kk < 4; ++kk) cf[kk] = *(const LAS bf16x8*)(lds + L_C + (q * PT + 32 * kk + 8 * fq) * 2);
    unsigned cbt[8][2];
#pragma unroll
    for (int st = 0; st < 8; ++st) { f32x4 t = {0.f, 0.f, 0.f, 0.f};
        if (st <= wq) {
#pragma unroll
            for (int kk = 0; kk < 4; ++kk) { const bf16x8 a = *(const LAS bf16x8*)(lds + L_B + ((16 * st + fr) * PT + 32 * kk + 8 * fq) * 2);
                t = __builtin_amdgcn_mfma_f32_16x16x32_bf16(a, cf[kk], t, 0, 0, 0); } }
        cbt[st][0] = pk_bf16(t[0], t[1]); cbt[st][1] = pk_bf16(t[2], t[3]); }
    float ss = 0.f;
    bf16* gzrow = p.GZ + (size_t)(row0 + q) * D_INNER + g * GW + 4 * fq;
#pragma unroll 1
    for (int j = 0; j < 4; ++j) {
        const int head = g * 4 + j; const float aq = tA[j * 128 + q], dskip = p.ssm_d[head];
        const bf16* hp = p.HPREV + ((size_t)bc * SSD_HEADS + head) * (HEADDIM * D_STATE);
        bf16x8 hfa[4][4]; u32x2 zra[4];
#pragma unroll
        for (int pt = 0; pt < 4; ++pt) {
#pragma unroll
            for (int kk = 0; kk < 4; ++kk) hfa[pt][kk] = *(const bf16x8*)(hp + (16 * pt + fr) * D_STATE + 32 * kk + 8 * fq);
            zra[pt] = *(const u32x2*)(p.ZX + (size_t)(row0 + q) * ZXP + head * HEADDIM + 16 * pt + 4 * fq); }
        bf16x8 wf[4]; unsigned gvh[4][2];
#pragma unroll
        for (int kk = 0; kk < 4; ++kk) { unsigned pk[4];
            if (2 * kk <= wq) {
                float v[8];
#pragma unroll
                for (int hh = 0; hh < 2; ++hh) { const int st = 2 * kk + hh; const int s0 = 16 * st + 4 * fq;
                    const f32x4 as = *(const LAS f32x4*)(tA + j * 128 + s0), ds = *(const LAS f32x4*)(tD + j * 128 + s0);
#pragma unroll
                    for (int i = 0; i < 4; ++i) { const int sidx = s0 + i; float x = 0.f; const unsigned cw2 = cbt[st][i >> 1]; const float cbv = __uint_as_float((i & 1) ? (cw2 & 0xffff0000u) : (cw2 << 16));
                        if (sidx <= q) x = cbv * __expf(aq - as[i]) * ds[i];
                        if (sidx == q) x += dskip;
                        v[hh * 4 + i] = x; } }
#pragma unroll
                for (int e = 0; e < 4; ++e) pk[e] = pk_bf16(v[2 * e], v[2 * e + 1]);
            } else { pk[0] = pk[1] = pk[2] = pk[3] = 0u; }
            wf[kk] = __builtin_bit_cast(bf16x8, (u32x4){pk[0], pk[1], pk[2], pk[3]}); }
        const float eaq = __expf(aq);
#pragma unroll
        for (int pt = 0; pt < 4; ++pt) {
            f32x4 yd = {0.f, 0.f, 0.f, 0.f}, yo = {0.f, 0.f, 0.f, 0.f};
#pragma unroll
            for (int kk = 0; kk < 4; ++kk) if (2 * kk <= wq) {
                const LAS unsigned char* xr = lds + L_X + ((j * 64 + 16 * pt + fr) * PT + 32 * kk + 4 * fq) * 2;
                const u32x2 lo = *(const LAS u32x2*)xr, hi = *(const LAS u32x2*)(xr + 32);
                const bf16x8 a = __builtin_bit_cast(bf16x8, (u32x4){lo[0], lo[1], hi[0], hi[1]});
                yd = __builtin_amdgcn_mfma_f32_16x16x32_bf16(a, wf[kk], yd, 0, 0, 0); }
#pragma unroll
            for (int kk = 0; kk < 4; ++kk) { const bf16x8 c = *(const LAS bf16x8*)(lds + L_C + (q * PT + 32 * kk + 8 * fq) * 2); yo = __builtin_amdgcn_mfma_f32_16x16x32_bf16(hfa[pt][kk], c, yo, 0, 0, 0); }
            const u32x2 zr = zra[pt];
            const float z[4] = {__uint_as_float(zr[0] << 16), __uint_as_float(zr[0] & 0xffff0000u), __uint_as_float(zr[1] << 16), __uint_as_float(zr[1] & 0xffff0000u)};
            float vv[4];
#pragma unroll
            for (int i = 0; i < 4; ++i) { const float y = yd[i] + eaq * yo[i]; vv[i] = y * fast_silu(z[i]); ss += vv[i] * vv[i]; }
            gvh[pt][0] = pk_bf16(vv[0], vv[1]); gvh[pt][1] = pk_bf16(vv[2], vv[3]);
        }
        __syncthreads();
#pragma unroll
        for (int pt = 0; pt < 4; ++pt) *(LAS u32x2*)(lds + L_X + j * (HEADDIM * PT * 2) + w * 2048 + (pt * 64 + lane) * 8) = (u32x2){gvh[pt][0], gvh[pt][1]};
    }
    ss += lane_xor_f(ss, lane, 16); ss += lane_xor_f(ss, lane, 32);
    const float rn = 1.f / sqrtf(ss * (1.f / GW) + EPS);
#pragma unroll
    for (int j = 0; j < 4; ++j)
#pragma unroll
        for (int pt = 0; pt < 4; ++pt) { const f32x4 nw = *(const f32x4*)(p.ssm_norm_w + g * GW + 4 * fq + j * HEADDIM + 16 * pt);
            const u32x2 t = *(const LAS u32x2*)(lds + L_X + j * (HEADDIM * PT * 2) + w * 2048 + (pt * 64 + lane) * 8);
            const float v0 = __uint_as_float(t[0] << 16), v1 = __uint_as_float(t[0] & 0xffff0000u), v2 = __uint_as_float(t[1] << 16), v3 = __uint_as_float(t[1] & 0xffff0000u);
            u32x2 o; o[0] = pk_bf16(v0 * rn * nw[0], v1 * rn * nw[1]); o[1] = pk_bf16(v2 * rn * nw[2], v3 * rn * nw[3]);
            *(u32x2*)(gzrow + j * HEADDIM + 16 * pt) = o; }
    __syncthreads();
}
}

namespace att {
typedef short bf16x8 __attribute__((ext_vector_type(8)));
typedef short v4i16_t __attribute__((ext_vector_type(4)));
typedef float f32x4 __attribute__((ext_vector_type(4)));
typedef unsigned u32x4 __attribute__((ext_vector_type(4)));
typedef unsigned u32x2 __attribute__((ext_vector_type(2)));
constexpr int KP = 72;
constexpr int L_K = 0, L_V = 256 * KP * 2, L_END = 2 * 256 * KP * 2;
constexpr float LOG2E = 1.4426950408889634f;
constexpr int N_PUNITS = BATCH * 3 * ATTN_HPG * (SEQ / 128);
constexpr int N_SUNITS = DEC_BATCH * 13;
static_assert(L_END <= MISC_OFF_ && ATTN_HPG == 8 && AHD == 64 && DEC_SEQ == 8 && PAST_LEN >= 2048, "attention fast path geometry");
__device__ __forceinline__ unsigned pk_bf16(float lo, float hi) { return pk2bf(lo, hi); }
__device__ __forceinline__ v4i16_t tr_read(const LAS unsigned char* p) { return __builtin_amdgcn_ds_read_tr16_b64_v4i16((LAS v4i16_t*)p); }

struct PromptIn { u32x4 kv[4], vv[4]; bf16x8 qf[2]; };
__device__ __forceinline__ void prompt_issue(const P& p, int u, PromptIn& pi) {
    int tid = threadIdx.x; asm volatile("" : "+v"(tid));
    const int w = __builtin_amdgcn_readfirstlane(tid >> 6), lane = tid & 63, fr = lane & 15, fq = lane >> 4;
    const int blk = u & 31, h = (u >> 5) & 7, bg = u >> 8, g = bg % 3, b = bg / 3;
    const int dil = a_dil(g), nb = (SEQ / dil) / 128, r = blk / nb, m0 = 128 * (blk % nb);
    const size_t seqrow0 = (size_t)b * SEQ + r;
    const bf16* kbase = p.QKV + g * 3 * AW + AW + h * AHD;
#pragma unroll
    for (int i = 0; i < 4; ++i) { const int id = tid + NTHR_ * i, kr = id >> 3, ch = id & 7; int m = m0 - 128 + kr; m = m < 0 ? 0 : m;
        const bf16* src = kbase + (seqrow0 + (size_t)dil * m) * QKVW + ch * 8;
        pi.kv[i] = *(const u32x4*)src; pi.vv[i] = *(const u32x4*)(src + AW); }
    const size_t qrow = seqrow0 + (size_t)dil * (m0 + 16 * w + fr);
#pragma unroll
    for (int ks = 0; ks < 2; ++ks) pi.qf[ks] = *(const bf16x8*)(p.QKV + qrow * QKVW + g * 3 * AW + h * AHD + 32 * ks + 8 * fq);
}
__device__ __forceinline__ void prompt_phase(const P& p, int G, int bx, LAS unsigned char* lds) {
    PromptIn pi;
    int u = bx;
    if (u < N_PUNITS) prompt_issue(p, u, pi);
    for (; u < N_PUNITS; u += G) {
    int tid = threadIdx.x; asm volatile("" : "+v"(tid));
    const int w = __builtin_amdgcn_readfirstlane(tid >> 6), lane = tid & 63, fr = lane & 15, fq = lane >> 4;
    const int blk = u & 31, h = (u >> 5) & 7, bg = u >> 8, g = bg % 3, b = bg / 3;
    const int dil = a_dil(g), nb = (SEQ / dil) / 128, r = blk / nb, m0 = 128 * (blk % nb);
    const size_t seqrow0 = (size_t)b * SEQ + r;
#pragma unroll
    for (int i = 0; i < 4; ++i) { const int id = tid + NTHR_ * i, kr = id >> 3, ch = id & 7;
        *(LAS u32x4*)(lds + L_K + (kr * KP + ch * 8) * 2) = pi.kv[i]; *(LAS u32x4*)(lds + L_V + (kr * KP + ch * 8) * 2) = pi.vv[i]; }
    const size_t qrow = seqrow0 + (size_t)dil * (m0 + 16 * w + fr);
    bf16x8 qf[2]; qf[0] = pi.qf[0]; qf[1] = pi.qf[1];
    __syncthreads();
    if (u + G < N_PUNITS) prompt_issue(p, u + G, pi);
    f32x4 st[9];
#pragma unroll
    for (int kt = 0; kt < 9; ++kt) { st[kt] = (f32x4){0.f, 0.f, 0.f, 0.f};
#pragma unroll
        for (int ks = 0; ks < 2; ++ks) { const bf16x8 a = *(const LAS bf16x8*)(lds + L_K + ((16 * w + 16 * kt + fr) * KP + 32 * ks + 8 * fq) * 2);
            st[kt] = __builtin_amdgcn_mfma_f32_16x16x32_bf16(a, qf[ks], st[kt], 0, 0, 0); } }
    const float sl = exp2f(-8.f * (float)(g * ATTN_HPG + h + 1) / (float)NAH) * (float)dil * LOG2E;
    float mx = -1e30f;
#pragma unroll
    for (int kt = 0; kt < 9; ++kt)
#pragma unroll
        for (int i = 0; i < 4; ++i) { const int kr = 16 * w + 16 * kt + 4 * fq + i, j = 128 + 16 * w + fr - kr;
            const bool ok = j >= 0 && j <= 128 && (m0 - 128 + kr) >= 0;
            const float v = ok ? st[kt][i] * LOG2E - sl * (float)j : -1e30f; st[kt][i] = v; mx = fmaxf(mx, v); }
    mx = fmaxf(mx, lane_xor_f(mx, lane, 16)); mx = fmaxf(mx, lane_xor_f(mx, lane, 32));
    float l = 0.f;
#pragma unroll
    for (int kt = 0; kt < 9; ++kt)
#pragma unroll
        for (int i = 0; i < 4; ++i) { const float e = exp2f(st[kt][i] - mx); st[kt][i] = e; l += e; }
    l += lane_xor_f(l, lane, 16); l += lane_xor_f(l, lane, 32);
    bf16x8 pf[5];
#pragma unroll
    for (int kk = 0; kk < 5; ++kk) { u32x4 t; t[0] = pk_bf16(st[2 * kk][0], st[2 * kk][1]); t[1] = pk_bf16(st[2 * kk][2], st[2 * kk][3]);
        if (kk < 4) { t[2] = pk_bf16(st[2 * kk + 1][0], st[2 * kk + 1][1]); t[3] = pk_bf16(st[2 * kk + 1][2], st[2 * kk + 1][3]); } else { t[2] = 0u; t[3] = 0u; }
        pf[kk] = __builtin_bit_cast(bf16x8, t); }
    const float inv = 1.f / l;
    bf16* og = p.OG + ((size_t)g * M + qrow) * AW + h * AHD;
#pragma unroll
    for (int dt = 0; dt < 4; ++dt) { f32x4 acc = {0.f, 0.f, 0.f, 0.f};
#pragma unroll
        for (int kk = 0; kk < 5; ++kk) { const LAS unsigned char* vp = lds + L_V + ((16 * w + 32 * kk + 4 * fq + (fr >> 2)) * KP + 16 * dt + 4 * (fr & 3)) * 2;
            const v4i16_t lo = tr_read(vp); v4i16_t hi = {0, 0, 0, 0}; if (kk < 4) hi = tr_read(vp + 16 * KP * 2);
            const bf16x8 a = {lo[0], lo[1], lo[2], lo[3], hi[0], hi[1], hi[2], hi[3]};
            acc = __builtin_amdgcn_mfma_f32_16x16x32_bf16(a, pf[kk], acc, 0, 0, 0); }
        u32x2 o; o[0] = pk_bf16(acc[0] * inv, acc[1] * inv); o[1] = pk_bf16(acc[2] * inv, acc[3] * inv);
        *(u32x2*)(og + 16 * dt + 4 * fq) = o; }
    if (fq == 0) p.LSE[((size_t)g * M + qrow) * ATTN_HPG + h] = mx + log2f(l);
    __syncthreads();
    }
}
constexpr int L_P = 0;
__device__ __forceinline__ void sample_unit(const P& p, int u, LAS unsigned char* lds) {
    int tid = threadIdx.x; asm volatile("" : "+v"(tid));
    const int h = __builtin_amdgcn_readfirstlane(tid >> 6), lane = tid & 63, fr = lane & 15, fq = lane >> 4;
    const int b = u / 13, kind = u % 13;
    int g, NN, tok0, tstep, c0;
    if (kind == 0) { g = 0; NN = 8; tok0 = 0; tstep = 1; c0 = 0; } else if (kind < 5) { g = 1; NN = 2; tok0 = kind - 1; tstep = 4; c0 = kind - 1; } else { g = 2; NN = 1; tok0 = kind - 5; tstep = 1; c0 = kind - 5; }
    const int dil = a_dil(g), past = a_past(g);
    const float* cbase = cache_of(p, g) + ((size_t)b * past + c0) * 2 * AW + h * AHD;
    const bf16* nbase = p.QKV + ((size_t)MP + b * DEC_SEQ + tok0) * QKVW + g * 3 * AW + h * AHD;
    bf16x8 qf[2];
#pragma unroll
    for (int ks = 0; ks < 2; ++ks) { qf[ks] = (bf16x8){0, 0, 0, 0, 0, 0, 0, 0}; if (fr < NN) qf[ks] = *(const bf16x8*)(nbase + (size_t)tstep * fr * QKVW + 32 * ks + 8 * fq); }
    f32x4 st[9];
#pragma unroll
    for (int kt = 0; kt < 8; ++kt) { st[kt] = (f32x4){0.f, 0.f, 0.f, 0.f}; const float* kr = cbase + (size_t)dil * (16 * kt + fr) * 2 * AW + 8 * fq;
#pragma unroll
        for (int ks = 0; ks < 2; ++ks) { const f32x4 x0 = *(const f32x4*)(kr + 32 * ks), x1 = *(const f32x4*)(kr + 32 * ks + 4);
            u32x4 t; t[0] = pk_bf16(x0[0], x0[1]); t[1] = pk_bf16(x0[2], x0[3]); t[2] = pk_bf16(x1[0], x1[1]); t[3] = pk_bf16(x1[2], x1[3]);
            st[kt] = __builtin_amdgcn_mfma_f32_16x16x32_bf16(__builtin_bit_cast(bf16x8, t), qf[ks], st[kt], 0, 0, 0); } }
    { st[8] = (f32x4){0.f, 0.f, 0.f, 0.f};
#pragma unroll
      for (int ks = 0; ks < 2; ++ks) { bf16x8 a = {0, 0, 0, 0, 0, 0, 0, 0}; if (fr < NN) a = *(const bf16x8*)(nbase + (size_t)tstep * fr * QKVW + AW + 32 * ks + 8 * fq);
          st[8] = __builtin_amdgcn_mfma_f32_16x16x32_bf16(a, qf[ks], st[8], 0, 0, 0); } }
    const float sl = exp2f(-8.f * (float)(g * ATTN_HPG + h + 1) / (float)NAH) * (float)dil * LOG2E;
    float mx = -1e30f;
#pragma unroll
    for (int kt = 0; kt < 9; ++kt)
#pragma unroll
        for (int i = 0; i < 4; ++i) { const int n = 16 * kt + 4 * fq + i, j = 128 + fr - n; const bool ok = j >= 0 && j <= 128 && fr < NN;
            const float v = ok ? st[kt][i] * LOG2E - sl * (float)j : -1e30f; st[kt][i] = v; mx = fmaxf(mx, v); }
    mx = fmaxf(mx, lane_xor_f(mx, lane, 16)); mx = fmaxf(mx, lane_xor_f(mx, lane, 32));
    float l = 0.f;
#pragma unroll
    for (int kt = 0; kt < 9; ++kt)
#pragma unroll
        for (int i = 0; i < 4; ++i) { const float e = (fr < NN) ? exp2f(st[kt][i] - mx) : 0.f; st[kt][i] = e; l += e; }
    l += lane_xor_f(l, lane, 16); l += lane_xor_f(l, lane, 32);
    const float inv = (fr < NN) ? 1.f / l : 0.f;
    LAS float* Pl = (LAS float*)(lds + L_P) + h * (8 * 144);
    if (fr < 8) {
#pragma unroll
        for (int kt = 0; kt < 9; ++kt) *(LAS f32x4*)(Pl + fr * 144 + 16 * kt + 4 * fq) = st[kt] * inv; }
    if (fq == 0 && fr < NN) p.LSE[((size_t)g * M + MP + b * DEC_SEQ + tok0 + tstep * fr) * ATTN_HPG + h] = mx + log2f(l);
    asm volatile("s_waitcnt lgkmcnt(0)" ::: "memory");
    const int ks4 = lane >> 4, dq = lane & 15;
    f32x4 o[8];
#pragma unroll
    for (int iq = 0; iq < 8; ++iq) o[iq] = (f32x4){0.f, 0.f, 0.f, 0.f};
    const float* vb = cbase + AW + 4 * dq;
#pragma unroll 1
    for (int kb0 = 0; kb0 < 32; kb0 += 8) {
        f32x4 v[8];
#pragma unroll
        for (int x = 0; x < 8; ++x) v[x] = *(const f32x4*)(vb + (size_t)dil * (4 * (kb0 + x) + ks4) * 2 * AW);
#pragma unroll
        for (int x = 0; x < 8; ++x) { const int n = 4 * (kb0 + x) + ks4;
#pragma unroll
            for (int iq = 0; iq < 8; ++iq) if (iq < NN) o[iq] += v[x] * Pl[iq * 144 + n]; } }
#pragma unroll
    for (int kb = 32; kb < 34; ++kb) { const int n = 4 * kb + ks4, x = n - 128;
        if (x < NN) { const u32x2 r2 = *(const u32x2*)(nbase + (size_t)tstep * x * QKVW + 2 * AW + 4 * dq);
            const f32x4 v = {__uint_as_float(r2[0] << 16), __uint_as_float(r2[0] & 0xffff0000u), __uint_as_float(r2[1] << 16), __uint_as_float(r2[1] & 0xffff0000u)};
#pragma unroll
            for (int iq = 0; iq < 8; ++iq) if (iq < NN) o[iq] += v * Pl[iq * 144 + n]; } }
#pragma unroll
    for (int iq = 0; iq < 8; ++iq) if (iq < NN) {
#pragma unroll
        for (int e = 0; e < 4; ++e) { float t = o[iq][e]; t += lane_xor_f(t, lane, 16); t += lane_xor_f(t, lane, 32); o[iq][e] = t; }
        if (ks4 == 0) { u32x2 w2; w2[0] = pk_bf16(o[iq][0], o[iq][1]); w2[1] = pk_bf16(o[iq][2], o[iq][3]);
            *(u32x2*)(p.OG + ((size_t)g * M + MP + b * DEC_SEQ + tok0 + tstep * iq) * AW + h * AHD + 4 * dq) = w2; } }
    __syncthreads();
}
constexpr long N_MERGE = (long)M * ATTN_HPG * 8;
__device__ __forceinline__ void merge(const P& p, long i) {
    const int dc = (int)(i & 7), h = (int)((i >> 3) & 7); const size_t row = (size_t)(i >> 6);
    const float l0 = p.LSE[(0 * (size_t)M + row) * 8 + h], l1 = p.LSE[(1 * (size_t)M + row) * 8 + h], l2 = p.LSE[(2 * (size_t)M + row) * 8 + h];
    const float mx = fmaxf(l0, fmaxf(l1, l2)); float w0 = exp2f(l0 - mx), w1 = exp2f(l1 - mx), w2 = exp2f(l2 - mx); const float inv = 1.f / (w0 + w1 + w2); w0 *= inv; w1 *= inv; w2 *= inv;
    const size_t off = row * AW + h * AHD + dc * 8;
    const u32x4 a = *(const u32x4*)(p.OG + off), bq = *(const u32x4*)(p.OG + (size_t)M * AW + off), c = *(const u32x4*)(p.OG + 2 * (size_t)M * AW + off); u32x4 o;
#pragma unroll
    for (int e = 0; e < 4; ++e) { const float lo = w0 * __uint_as_float(a[e] << 16) + w1 * __uint_as_float(bq[e] << 16) + w2 * __uint_as_float(c[e] << 16);
        const float hi = w0 * __uint_as_float(a[e] & 0xffff0000u) + w1 * __uint_as_float(bq[e] & 0xffff0000u) + w2 * __uint_as_float(c[e] & 0xffff0000u); o[e] = pk_bf16(lo, hi); }
    *(u32x4*)(p.O + off) = o;
}
}

namespace misc {
typedef float f32x4 __attribute__((ext_vector_type(4)));
typedef unsigned u32x4 __attribute__((ext_vector_type(4)));
typedef unsigned u32x2 __attribute__((ext_vector_type(2)));
__device__ __forceinline__ unsigned pk_bf16(float lo, float hi) { return pk2bf(lo, hi); }
template <int KIND> __device__ __forceinline__ void convert_w(const P& p, LAS unsigned char* lds, int ls, int wi, int nw) {
    constexpr int K = KIND == 1 ? D_FF : KIND == 3 ? D_INNER : KIND == 5 ? AW : D_MODEL;
    constexpr int N = KIND == 0 ? 2 * D_FF : KIND == 2 ? D_IN_PROJ : KIND == 4 ? QKVW : D_MODEL;
    constexpr int NBLK = N / 32, NIT = (K / 64) * NBLK; constexpr bool HAS_GAIN = KIND == 0 || KIND == 2 || KIND == 4;
    static_assert(N % 32 == 0 && K % 64 == 0, "item geometry");
    const float* W; bf16* WT; const float* gain = p.norm_w;
    if constexpr (KIND == 0) { W = p.w_ffn_in + (size_t)ls * D_MODEL * 2 * D_FF; WT = p.WFI + (size_t)ls * 2 * D_FF * D_MODEL; gain = p.norm_w + ((ls >> 1) * 3 + ((ls & 1) ? 2 : 0)) * D_MODEL; }
    else if constexpr (KIND == 1) { W = p.w_ffn_out + (size_t)ls * D_FF * D_MODEL; WT = p.WFO + (size_t)ls * D_MODEL * D_FF; }
    else if constexpr (KIND == 2) { W = p.ssm_w_in; WT = p.WSI; gain = p.norm_w + (0 * 3 + 1) * D_MODEL; }
    else if constexpr (KIND == 3) { W = p.ssm_w_out; WT = p.WSO; }
    else if constexpr (KIND == 4) { W = p.attn_w_qkv; WT = p.WQKV; gain = p.norm_w + (1 * 3 + 1) * D_MODEL; }
    else { W = p.attn_w_o; WT = p.WO; }
    int tid = threadIdx.x; asm volatile("" : "+v"(tid));
    const int w = __builtin_amdgcn_readfirstlane(tid >> 6), lane = tid & 63; LAS float* scr = (LAS float*)(lds + w * 16384);
    const int lh = lane >> 5, ln = lane & 31, c = lane & 7;
    float t[32];
    int it = wi;
    if (it < NIT) { const int kb = it / NBLK, nb = it % NBLK;
#pragma unroll
        for (int i = 0; i < 32; ++i) t[i] = W[(size_t)(64 * kb + 2 * i + lh) * N + 32 * nb + ln]; }
    while (it < NIT) {
        const int nx = it + nw; float tn[32];
        if (nx < NIT) { const int kb = nx / NBLK, nb = nx % NBLK;
#pragma unroll
            for (int i = 0; i < 32; ++i) tn[i] = W[(size_t)(64 * kb + 2 * i + lh) * N + 32 * nb + ln]; }
        const int kb = it / NBLK, nb = it % NBLK, k0 = 64 * kb, n0 = 32 * nb;
        int orow = n0; float cs = 1.f;
        if constexpr (KIND == 0) orow = n0 < D_FF ? 256 * (n0 / 128) + n0 % 128 : 256 * ((n0 - D_FF) / 128) + 128 + (n0 - D_FF) % 128;
        if constexpr (KIND == 1) cs = 0.5f;
        if constexpr (KIND == 4) cs = (n0 / AW) % 3 == 0 ? 0.125f : 1.f;
#pragma unroll
        for (int i = 0; i < 32; ++i) scr[(2 * i + lh) * 33 + ln] = t[i];
        asm volatile("s_waitcnt lgkmcnt(0)" ::: "memory");
        float gk[8];
#pragma unroll
        for (int e = 0; e < 8; ++e) gk[e] = (HAS_GAIN ? gain[k0 + 8 * c + e] : 1.f) * cs;
#pragma unroll
        for (int j = 0; j < 4; ++j) { const int n = (lane >> 3) + 8 * j; const LAS float* sp = scr + (8 * c) * 33 + n;
            u32x4 o; o[0] = pk_bf16(sp[0 * 33] * gk[0], sp[1 * 33] * gk[1]); o[1] = pk_bf16(sp[2 * 33] * gk[2], sp[3 * 33] * gk[3]); o[2] = pk_bf16(sp[4 * 33] * gk[4], sp[5 * 33] * gk[5]); o[3] = pk_bf16(sp[6 * 33] * gk[6], sp[7 * 33] * gk[7]);
            *(u32x4*)(WT + (size_t)(orow + n) * K + k0 + 8 * c) = o; }
        asm volatile("s_waitcnt lgkmcnt(0)" ::: "memory");
#pragma unroll
        for (int i = 0; i < 32; ++i) t[i] = tn[i];
        it = nx;
    }
}
template <int KIND> __device__ __forceinline__ void convert_in_tail(const P& p, LAS unsigned char* lds, int ls, int n_units, int G, int bx) {
    int tid = threadIdx.x; asm volatile("" : "+v"(tid)); const int w = __builtin_amdgcn_readfirstlane(tid >> 6);
    const int nb = n_units % G; if (nb && bx < nb) return;
    const int idx = nb ? bx - nb : bx, cnt = nb ? G - nb : G;
    convert_w<KIND>(p, lds, ls, idx * NWAVES_ + w, cnt * NWAVES_);
}
__device__ __forceinline__ void prologue(const P& p, LAS unsigned char* lds, int G, int bx) {
    int tid = threadIdx.x; asm volatile("" : "+v"(tid));
    const int w = __builtin_amdgcn_readfirstlane(tid >> 6), lane = tid & 63;
    const int gw = bx * NWAVES_ + w, NGW = G * NWAVES_;
    convert_w<0>(p, lds, 0, gw, NGW); convert_w<2>(p, lds, 0, gw, NGW);
    { const long nz = (long)(NSI - D_IN_PROJ) * D_MODEL / 8; u32x4* z = (u32x4*)(p.WSI + (size_t)D_IN_PROJ * D_MODEL);
        for (long i = (long)bx * NTHR_ + tid; i < nz; i += (long)G * NTHR_) z[i] = (u32x4){0u, 0u, 0u, 0u}; }
    for (int row = gw; row < M; row += NGW) {
        const float* src = row < MP ? p.x_prompt + (size_t)row * D_MODEL : p.x_sample + (size_t)(row - MP) * D_MODEL; float s = 0.f;
#pragma unroll
        for (int j = 0; j < 4; ++j) { const f32x4 v = *(const f32x4*)(src + 256 * j + 4 * lane); s += (v[0] * v[0] + v[1] * v[1]) + (v[2] * v[2] + v[3] * v[3]);
            u32x2 o; o[0] = pk_bf16(v[0], v[1]); o[1] = pk_bf16(v[2], v[3]); *(u32x2*)(p.XB + (size_t)row * D_MODEL + 256 * j + 4 * lane) = o; }
        s += lane_xor_f(s, lane, 1); s += lane_xor_f(s, lane, 2);
        if ((lane & 3) == 0) p.SS[(size_t)row * NSS + (lane >> 2)] = s; }
}
constexpr int S_LAST = 11;
__device__ __forceinline__ void final_norm(const P& p, LAS unsigned char* lds, int G, int bx) {
    int tid = threadIdx.x; asm volatile("" : "+v"(tid));
    const int w = __builtin_amdgcn_readfirstlane(tid >> 6), lane = tid & 63; const int gw = bx * NWAVES_ + w, NGW = G * NWAVES_;
    f32x4 nf[4];
#pragma unroll
    for (int j = 0; j < 4; ++j) nf[j] = *(const f32x4*)(p.norm_f + 256 * j + 4 * lane);
    LAS float* hs = (LAS float*)lds;
    for (int r4 = bx * 4; r4 < MS; r4 += G * 4) { const int r = r4 + (w >> 1), hf = w & 1; const size_t go = ((size_t)MP + r) * D_MODEL; f32x4 v[2]; float s = 0.f;
        u32x2 h[2], l[2]; f32x4 pv[2][S_LAST];
#pragma unroll
        for (int jj = 0; jj < 2; ++jj) { const size_t o = 256 * (2 * hf + jj) + 4 * lane; h[jj] = *(const u32x2*)(p.XB + go + o); l[jj] = *(const u32x2*)(p.XLO + go + o);
#pragma unroll
            for (int k = 0; k < S_LAST; ++k) pv[jj][k] = *(const f32x4*)(p.PART + ((size_t)k * MS + r) * D_MODEL + o); }
#pragma unroll
        for (int jj = 0; jj < 2; ++jj) { v[jj] = join4(h[jj][0], h[jj][1], l[jj][0], l[jj][1]);
#pragma unroll
            for (int k = 0; k < S_LAST; ++k) v[jj] += pv[jj][k];
            s += (v[jj][0] * v[jj][0] + v[jj][1] * v[jj][1]) + (v[jj][2] * v[jj][2] + v[jj][3] * v[jj][3]); }
#pragma unroll
        for (int o = 1; o < 64; o <<= 1) s += lane_xor_f(s, lane, o);
        if (lane == 0) hs[w] = s;
        __syncthreads();
        const float rr = 1.f / sqrtf((hs[w & ~1] + hs[w | 1]) * (1.f / D_MODEL) + EPS);
        __syncthreads();
#pragma unroll
        for (int jj = 0; jj < 2; ++jj) *(f32x4*)(p.y_sample + (size_t)r * D_MODEL + 256 * (2 * hf + jj) + 4 * lane) = v[jj] * rr * nf[2 * hf + jj]; }
    for (int row0 = gw; row0 < MP; row0 += 2 * NGW) {
        const bool two = row0 + NGW < MP; const int row1 = two ? row0 + NGW : row0;
        f32x4 q0[4], q1[4]; u32x2 h0[4], l0[4], h1[4], l1[4];
#pragma unroll
        for (int j = 0; j < 4; ++j) { q0[j] = *(const f32x4*)(p.SS + (size_t)row0 * NSS + 4 * j); q1[j] = *(const f32x4*)(p.SS + (size_t)row1 * NSS + 4 * j); }
#pragma unroll
        for (int j = 0; j < 4; ++j) { const size_t g0 = (size_t)row0 * D_MODEL + 256 * j + 4 * lane, g1 = (size_t)row1 * D_MODEL + 256 * j + 4 * lane;
            h0[j] = *(const u32x2*)(p.XB + g0); l0[j] = *(const u32x2*)(p.XLO + g0); h1[j] = *(const u32x2*)(p.XB + g1); l1[j] = *(const u32x2*)(p.XLO + g1); }
        float s0 = 0.f, s1 = 0.f;
#pragma unroll
        for (int j = 0; j < 4; ++j) { s0 += (q0[j][0] + q0[j][1]) + (q0[j][2] + q0[j][3]); s1 += (q1[j][0] + q1[j][1]) + (q1[j][2] + q1[j][3]); }
        const float r0 = 1.f / sqrtf(s0 * (1.f / D_MODEL) + EPS), r1 = 1.f / sqrtf(s1 * (1.f / D_MODEL) + EPS);
        float* out0 = p.y_prompt + (size_t)row0 * D_MODEL; float* out1 = p.y_prompt + (size_t)row1 * D_MODEL;
#pragma unroll
        for (int j = 0; j < 4; ++j) *(f32x4*)(out0 + 256 * j + 4 * lane) = join4(h0[j][0], h0[j][1], l0[j][0], l0[j][1]) * r0 * nf[j];
        if (two) {
#pragma unroll
            for (int j = 0; j < 4; ++j) *(f32x4*)(out1 + 256 * j + 4 * lane) = join4(h1[j][0], h1[j][1], l1[j][0], l1[j][1]) * r1 * nf[j]; } }
}
constexpr int LS_XS = 0, LS_Y = 16384, LS_DT = 24576, LS_DA = LS_DT + 128;
struct SampIn { float cw[4], bias, hs[3], dt, al; bf16 zx[8]; };
__device__ __forceinline__ void samp_issue(const P& p, int u, SampIn& si) {
    int tid = threadIdx.x; asm volatile("" : "+v"(tid));
    const int b = u / SSD_GROUPS, g = u % SSD_GROUPS; const int row0 = MP + b * DEC_SEQ;
    const int c = tid; const int chb = c < 256 ? g * GW + c : (c < 384 ? D_INNER + g * D_STATE + (c - 256) : D_INNER + SSD_GROUPS * D_STATE + g * D_STATE + (c - 384));
#pragma unroll
    for (int k = 0; k < 4; ++k) si.cw[k] = p.ssm_conv_w[k * CONV_DIM + chb];
    si.bias = p.ssm_conv_b[chb];
#pragma unroll
    for (int k = 0; k < 3; ++k) si.hs[k] = p.state_conv[((size_t)b * 3 + k) * CONV_DIM + chb];
#pragma unroll
    for (int t = 0; t < DEC_SEQ; ++t) si.zx[t] = p.ZX[(size_t)(row0 + t) * ZXP + D_INNER + chb];
    si.dt = 0.f; si.al = 0.f;
    if (tid < 32) { const int t = tid >> 2, j = tid & 3, head = g * 4 + j; si.dt = p.DT[(size_t)(row0 + t) * SSD_HEADS + head]; si.al = p.ssm_a_log[head]; }
}
__device__ __forceinline__ const float* samp_sbase(const P& p, int u) {
    int tid = threadIdx.x; asm volatile("" : "+v"(tid));
    const int w = __builtin_amdgcn_readfirstlane(tid >> 6), lane = tid & 63, nq = lane & 31, psel = lane >> 5; const int b = u / SSD_GROUPS, g = u % SSD_GROUPS;
    return p.state_ssm + (((size_t)b * SSD_HEADS + g * 4) * HEADDIM + 2 * w + psel) * D_STATE + 4 * nq;
}
__device__ __forceinline__ void ssd_sample_phase(const P& p, int G, int bx, LAS unsigned char* lds) {
    constexpr int NU = DEC_BATCH * SSD_GROUPS;
    LAS float* xs = (LAS float*)(lds + LS_XS); LAS float* Yl = (LAS float*)(lds + LS_Y); LAS float* tdt = (LAS float*)(lds + LS_DT); LAS float* tda = (LAS float*)(lds + LS_DA);
    SampIn si; f32x4 hn[4];
    int u = bx;
    if (u < NU) { samp_issue(p, u, si); const float* sb0 = samp_sbase(p, u);
#pragma unroll
        for (int ps = 0; ps < 4; ++ps) hn[ps] = *(const f32x4*)(sb0 + (size_t)(16 * ps) * D_STATE); }
    for (; u < NU; u += G) {
    int tid = threadIdx.x; asm volatile("" : "+v"(tid));
    const int w = __builtin_amdgcn_readfirstlane(tid >> 6), lane = tid & 63; const int b = u / SSD_GROUPS, g = u % SSD_GROUPS; const int row0 = MP + b * DEC_SEQ;
    const int un = u + G;
    { const int c = tid; float h0 = si.hs[0], h1 = si.hs[1], h2 = si.hs[2];
#pragma unroll
        for (int t = 0; t < DEC_SEQ; ++t) { const float cur = bf2f(si.zx[t]); const float a = si.bias + si.cw[0] * h0 + si.cw[1] * h1 + si.cw[2] * h2 + si.cw[3] * cur;
            xs[t * 512 + c] = a / (1.f + __expf(-a)); h0 = h1; h1 = h2; h2 = cur; } }
    if (tid < 32) { const int t = tid >> 2, j = tid & 3; tdt[t * 4 + j] = si.dt; tda[t * 4 + j] = __expf(-si.dt * expf(si.al)); }
    if (un < NU) samp_issue(p, un, si);
    __syncthreads();
    const int nq = lane & 31, psel = lane >> 5;
    f32x4 Bv[8], Cv[8];
#pragma unroll
    for (int t = 0; t < 8; ++t) { Bv[t] = *(const LAS f32x4*)(xs + t * 512 + 256 + 4 * nq); Cv[t] = *(const LAS f32x4*)(xs + t * 512 + 384 + 4 * nq); }
    const float* sbase = samp_sbase(p, u);
    f32x4 hv[4];
#pragma unroll 1
    for (int j = 0; j < 4; ++j) { const int head = g * 4 + j; const float dsk = p.ssm_d[head];
#pragma unroll
        for (int ps = 0; ps < 4; ++ps) hv[ps] = hn[ps];
        if (j < 3) {
#pragma unroll
            for (int ps = 0; ps < 4; ++ps) hn[ps] = *(const f32x4*)(sbase + (size_t)((j + 1) * HEADDIM + 16 * ps) * D_STATE);
        } else if (un < NU) { const float* sbn = samp_sbase(p, un);
#pragma unroll
            for (int ps = 0; ps < 4; ++ps) hn[ps] = *(const f32x4*)(sbn + (size_t)(16 * ps) * D_STATE); }
#pragma unroll
        for (int ps = 0; ps < 4; ++ps) { const int pidx = 16 * ps + 2 * w + psel; f32x4 h = hv[ps]; float y[8];
#pragma unroll
            for (int t = 0; t < 8; ++t) { const float coef = tdt[t * 4 + j] * xs[t * 512 + j * 64 + pidx]; h = h * tda[t * 4 + j] + Bv[t] * coef;
                y[t] = (Cv[t][0] * h[0] + Cv[t][1] * h[1]) + (Cv[t][2] * h[2] + Cv[t][3] * h[3]); }
            *(f32x4*)(p.ssm_sample + (((size_t)b * SSD_HEADS + head) * HEADDIM + pidx) * D_STATE + 4 * nq) = h;
            float r4[4], r2[2], r1;
            { const bool up = (lane & 16) != 0;
#pragma unroll
              for (int k = 0; k < 4; ++k) { const float keep = up ? y[4 + k] : y[k], give = up ? y[k] : y[4 + k]; r4[k] = keep + lane_xor_f(give, lane, 16); } }
            { const bool up = (lane & 8) != 0;
#pragma unroll
              for (int k = 0; k < 2; ++k) { const float keep = up ? r4[2 + k] : r4[k], give = up ? r4[k] : r4[2 + k]; r2[k] = keep + lane_xor_f(give, lane, 8); } }
            { const bool up = (lane & 4) != 0; const float keep = up ? r2[1] : r2[0], give = up ? r2[0] : r2[1]; r1 = keep + lane_xor_f(give, lane, 4); }
            r1 += lane_xor_f(r1, lane, 2); r1 += lane_xor_f(r1, lane, 1);
            if ((lane & 3) == 0) { const int t = ((lane >> 4) & 1) * 4 + ((lane >> 3) & 1) * 2 + ((lane >> 2) & 1); Yl[t * 256 + j * 64 + pidx] = r1 + dsk * xs[t * 512 + j * 64 + pidx]; } } }
    __syncthreads();
    { const int t = w, c = 4 * lane; const size_t row = (size_t)(row0 + t);
        const u32x2 zr = *(const u32x2*)(p.ZX + row * ZXP + g * GW + c);
        const float z[4] = {__uint_as_float(zr[0] << 16), __uint_as_float(zr[0] & 0xffff0000u), __uint_as_float(zr[1] << 16), __uint_as_float(zr[1] & 0xffff0000u)};
        const f32x4 yv = *(const LAS f32x4*)(Yl + t * 256 + c); float v[4], ss = 0.f;
#pragma unroll
        for (int e = 0; e < 4; ++e) { v[e] = yv[e] * (z[e] / (1.f + __expf(-z[e]))); ss += v[e] * v[e]; }
#pragma unroll
        for (int o = 1; o < 64; o <<= 1) ss += lane_xor_f(ss, lane, o);
        const float rn = 1.f / sqrtf(ss * (1.f / GW) + EPS); const f32x4 nw = *(const f32x4*)(p.ssm_norm_w + g * GW + c);
        u32x2 o2; o2[0] = pk_bf16(v[0] * rn * nw[0], v[1] * rn * nw[1]); o2[1] = pk_bf16(v[2] * rn * nw[2], v[3] * rn * nw[3]);
        *(u32x2*)(p.GZ + row * D_INNER + g * GW + c) = o2; }
    __syncthreads();
    }
}

template <int S> __device__ __forceinline__ void splitk_fixup_s(const P& p, int G, int bx, int first) {
    int tid = threadIdx.x; asm volatile("" : "+v"(tid));
    const int w = __builtin_amdgcn_readfirstlane(tid >> 6), lane = tid & 63; const int gw = bx * NWAVES_ + w, NGW = G * NWAVES_;
    for (int it0 = gw; it0 < MS * 4; it0 += 2 * NGW) {
        const bool two = it0 + NGW < MS * 4; const int it1 = two ? it0 + NGW : it0;
        const int r0 = it0 >> 2, j0 = it0 & 3, r1 = it1 >> 2, j1 = it1 & 3;
        const size_t go0 = ((size_t)MP + r0) * D_MODEL + 256 * j0 + 4 * lane, go1 = ((size_t)MP + r1) * D_MODEL + 256 * j1 + 4 * lane;
        f32x4 pa[S], pb[S], va, vb;
#pragma unroll
        for (int k = 0; k < S; ++k) { pa[k] = *(const f32x4*)(p.PART + ((size_t)k * MS + r0) * D_MODEL + 256 * j0 + 4 * lane); pb[k] = *(const f32x4*)(p.PART + ((size_t)k * MS + r1) * D_MODEL + 256 * j1 + 4 * lane); }
        if (first) { va = *(const f32x4*)(p.x_sample + (size_t)r0 * D_MODEL + 256 * j0 + 4 * lane); vb = *(const f32x4*)(p.x_sample + (size_t)r1 * D_MODEL + 256 * j1 + 4 * lane); }
        else { const u32x2 h0 = *(const u32x2*)(p.XB + go0), l0 = *(const u32x2*)(p.XLO + go0), h1 = *(const u32x2*)(p.XB + go1), l1 = *(const u32x2*)(p.XLO + go1);
               va = join4(h0[0], h0[1], l0[0], l0[1]); vb = join4(h1[0], h1[1], l1[0], l1[1]); }
#pragma unroll
        for (int k = 0; k < S; ++k) { va += pa[k]; vb += pb[k]; }
        float sa = (va[0] * va[0] + va[1] * va[1]) + (va[2] * va[2] + va[3] * va[3]), sb = (vb[0] * vb[0] + vb[1] * vb[1]) + (vb[2] * vb[2] + vb[3] * vb[3]);
        u32x2 oh, ol; SPLIT2(va[0], va[1], oh[0], ol[0]); SPLIT2(va[2], va[3], oh[1], ol[1]); *(u32x2*)(p.XB + go0) = oh; *(u32x2*)(p.XLO + go0) = ol;
        if (two) { SPLIT2(vb[0], vb[1], oh[0], ol[0]); SPLIT2(vb[2], vb[3], oh[1], ol[1]); *(u32x2*)(p.XB + go1) = oh; *(u32x2*)(p.XLO + go1) = ol; }
        sa += lane_xor_f(sa, lane, 1); sb += lane_xor_f(sb, lane, 1); sa += lane_xor_f(sa, lane, 2); sb += lane_xor_f(sb, lane, 2);
        sa += lane_xor_f(sa, lane, 4); sb += lane_xor_f(sb, lane, 4); sa += lane_xor_f(sa, lane, 8); sb += lane_xor_f(sb, lane, 8);
        if ((lane & 15) == 0) { p.SS[((size_t)MP + r0) * NSS + 4 * j0 + (lane >> 4)] = sa; if (two) p.SS[((size_t)MP + r1) * NSS + 4 * j1 + (lane >> 4)] = sb; } }
}
__device__ __forceinline__ void splitk_fixup(const P& p, int S, int G, int bx, int first) {
    if (S == 11) splitk_fixup_s<11>(p, G, bx, first); else if (S == 8) splitk_fixup_s<8>(p, G, bx, first); else splitk_fixup_s<4>(p, G, bx, first);
}
}

constexpr int NWAVES = 8, NTHR = NWAVES * 64;
constexpr int RING_BYTES = 131072, LDS_BYTES = 163840, MISC_OFF = MISC_OFF_;
#ifndef FAST_SSD
#define FAST_SSD 1
#endif
#ifndef FAST_ATTN
#define FAST_ATTN 1
#endif
#ifndef FAST_MISC
#define FAST_MISC 1
#endif
#ifndef MK_PER_PHASE
#define MK_PER_PHASE 0
#endif
constexpr int CW_BAR = 4096;

constexpr size_t al4k(size_t x) { return (x + 4095) & ~(size_t)4095; }
constexpr size_t CTL_BYTES = 1u << 15;
constexpr size_t OO_y_prompt = 0;
constexpr size_t OO_y_sample = OO_y_prompt + (size_t)MP * D_MODEL;
constexpr size_t OO_conv_prompt = OO_y_sample + (size_t)MS * D_MODEL;
constexpr size_t OO_conv_sample = OO_conv_prompt + (size_t)BATCH * (CONV_W - 1) * CONV_DIM;
constexpr size_t OO_ssm_prompt = OO_conv_sample + (size_t)DEC_BATCH * (CONV_W - 1) * CONV_DIM;
constexpr size_t OO_ssm_sample = OO_ssm_prompt + (size_t)BATCH * SSD_HEADS * HEADDIM * D_STATE;
constexpr size_t OO_kvp0 = OO_ssm_sample + (size_t)DEC_BATCH * SSD_HEADS * HEADDIM * D_STATE;
constexpr size_t OO_kvs0 = OO_kvp0 + (size_t)BATCH * 128 * 2 * AW;
constexpr size_t OO_kvp1 = OO_kvs0 + (size_t)MS * 2 * AW;
constexpr size_t OO_kvs1 = OO_kvp1 + (size_t)BATCH * 512 * 2 * AW;
constexpr size_t OO_kvp2 = OO_kvs1 + (size_t)MS * 2 * AW;
constexpr size_t OO_kvs2 = OO_kvp2 + (size_t)BATCH * 2048 * 2 * AW;
constexpr size_t OUT_ELEMS = OO_kvs2 + (size_t)MS * 2 * AW;
constexpr size_t WO_ctl = 0;
constexpr size_t WO_WFI = WO_ctl + al4k(CTL_BYTES);
constexpr size_t WO_WFO = WO_WFI + al4k((size_t)N_WFI * 2);
constexpr size_t WO_WSI = WO_WFO + al4k((size_t)N_WFO * 2);
constexpr size_t WO_WSO = WO_WSI + al4k((size_t)N_WSI * 2);
constexpr size_t WO_WQKV = WO_WSO + al4k((size_t)N_WSO * 2);
constexpr size_t WO_WO = WO_WQKV + al4k((size_t)N_WQKV * 2);
constexpr size_t WO_X = WO_WO + al4k((size_t)N_WO * 2);
constexpr size_t WO_XB = WO_X + al4k((size_t)M * D_MODEL * 4);
constexpr size_t WO_SS = WO_XB + al4k((size_t)M * D_MODEL * 2);
constexpr size_t WO_H = WO_SS + al4k((size_t)M * NSS * 4);
constexpr size_t WO_ZX = WO_H + al4k((size_t)M * D_FF * 2);
constexpr size_t WO_DT = WO_ZX + al4k((size_t)M * ZXP * 2);
constexpr size_t WO_STATES = WO_DT + al4k((size_t)M * SSD_HEADS * 4);
constexpr size_t WO_HPREV = WO_STATES + al4k((size_t)N_STATES * 4);
constexpr size_t WO_CDEC = WO_HPREV + al4k((size_t)N_STATES * 2);
constexpr size_t WO_GZ = WO_CDEC + al4k((size_t)BATCH * NCHUNK * SSD_HEADS * 4);
constexpr size_t WO_QKV = WO_GZ + al4k((size_t)M * D_INNER * 2);
constexpr size_t WO_O = WO_QKV + al4k((size_t)M * QKVW * 2);
constexpr size_t WO_OG = WO_O + al4k((size_t)M * AW * 2);
constexpr size_t WO_LSE = WO_OG + al4k((size_t)3 * M * AW * 2);
constexpr size_t WO_PART = WO_LSE + al4k((size_t)3 * M * ATTN_HPG * 4);
constexpr size_t WS_NEED = WO_PART + al4k((size_t)16 * MS * D_MODEL * 4);
struct KArgs { const float* x_prompt; const float* x_sample; const float* state_conv; const float* state_ssm; const float* cache0; const float* cache1; const float* cache2; const float* norm_w; const float* w_ffn_in; const float* w_ffn_out; const float* ssm_w_in; const float* ssm_conv_w; const float* ssm_conv_b; const float* ssm_dt_bias; const float* ssm_a_log; const float* ssm_d; const float* ssm_norm_w; const float* ssm_w_out; const float* attn_w_qkv; const float* attn_w_o; const float* norm_f; float* out; unsigned char* ws; int ph_lo, ph_hi; };
__device__ __forceinline__ P make_p(const KArgs& a) { P p;
    size_t z = 0; asm volatile("" : "+s"(z));
    p.x_prompt = a.x_prompt + z;
    p.x_sample = a.x_sample + z;
    p.state_conv = a.state_conv + z;
    p.state_ssm = a.state_ssm + z;
    p.cache0 = a.cache0 + z;
    p.cache1 = a.cache1 + z;
    p.cache2 = a.cache2 + z;
    p.norm_w = a.norm_w + z;
    p.w_ffn_in = a.w_ffn_in + z;
    p.w_ffn_out = a.w_ffn_out + z;
    p.ssm_w_in = a.ssm_w_in + z;
    p.ssm_conv_w = a.ssm_conv_w + z;
    p.ssm_conv_b = a.ssm_conv_b + z;
    p.ssm_dt_bias = a.ssm_dt_bias + z;
    p.ssm_a_log = a.ssm_a_log + z;
    p.ssm_d = a.ssm_d + z;
    p.ssm_norm_w = a.ssm_norm_w + z;
    p.ssm_w_out = a.ssm_w_out + z;
    p.attn_w_qkv = a.attn_w_qkv + z;
    p.attn_w_o = a.attn_w_o + z;
    p.norm_f = a.norm_f + z;
    float* out = a.out + z; unsigned char* ws = a.ws + z;
    p.y_prompt = out + OO_y_prompt;
    p.y_sample = out + OO_y_sample;
    p.conv_prompt = out + OO_conv_prompt;
    p.conv_sample = out + OO_conv_sample;
    p.ssm_prompt = out + OO_ssm_prompt;
    p.ssm_sample = out + OO_ssm_sample;
    p.kvp0 = out + OO_kvp0;
    p.kvs0 = out + OO_kvs0;
    p.kvp1 = out + OO_kvp1;
    p.kvs1 = out + OO_kvs1;
    p.kvp2 = out + OO_kvp2;
    p.kvs2 = out + OO_kvs2;
    p.ctl = (unsigned*)(ws + WO_ctl);
    p.WFI = (bf16*)(ws + WO_WFI);
    p.WFO = (bf16*)(ws + WO_WFO);
    p.WSI = (bf16*)(ws + WO_WSI);
    p.WSO = (bf16*)(ws + WO_WSO);
    p.WQKV = (bf16*)(ws + WO_WQKV);
    p.WO = (bf16*)(ws + WO_WO);
    p.X = nullptr; p.XLO = (bf16*)(ws + WO_X);
    p.XB = (bf16*)(ws + WO_XB);
    p.SS = (float*)(ws + WO_SS);
    p.H = (bf16*)(ws + WO_H);
    p.ZX = (bf16*)(ws + WO_ZX);
    p.DT = (float*)(ws + WO_DT);
    p.STATES = (float*)(ws + WO_STATES);
    p.HPREV = (bf16*)(ws + WO_HPREV);
    p.CDEC = (float*)(ws + WO_CDEC);
    p.GZ = (bf16*)(ws + WO_GZ);
    p.QKV = (bf16*)(ws + WO_QKV);
    p.O = (bf16*)(ws + WO_O);
    p.OG = (bf16*)(ws + WO_OG);
    p.LSE = (float*)(ws + WO_LSE);
    p.PART = (float*)(ws + WO_PART);
    p.ACUM = nullptr; p.XC = nullptr; p.Y = nullptr;
    p.cd1 = (const char*)a.cache1 - (const char*)a.cache0; p.cd2 = (const char*)a.cache2 - (const char*)a.cache0;
    return p; }

#define GRID_STRIDE(N, CALL) do { const long _n = (long)(N); int _t0 = threadIdx.x; asm volatile("" : "+v"(_t0));     \
    for (long i = (long)blockIdx.x * NTHR + _t0; i < _n; i += (long)gridDim.x * NTHR) { CALL; } } while (0)

__global__ void __launch_bounds__(NTHR, 2) mega_fwd(KArgs args) {
    extern __shared__ __attribute__((aligned(16))) unsigned char lds[];
    LAS unsigned char* ldsp = (LAS unsigned char*)lds;
    volatile LAS unsigned* MISC = (volatile LAS unsigned*)(ldsp + MISC_OFF + 512);
    { const int tid = threadIdx.x;
      for (int u = tid; u < (LDS_BYTES - MISC_OFF) / 4; u += NTHR) ((LAS unsigned*)(ldsp + MISC_OFF))[u] = 0u;
      __syncthreads();
      __syncthreads(); }
    XcdBarrier bar; bar.bar = (unsigned*)(args.ws + WO_ctl) + CW_BAR; bar.x = 0; bar.st = nullptr;
    if (!MK_PER_PHASE) bar = xcd_barrier_post((unsigned*)(args.ws + WO_ctl) + CW_BAR, MISC + 8);
    const int lo = args.ph_lo, hi = args.ph_hi;
    int ph = 0;
#define RUN() (lo <= ph && ph < hi)
#define SEAM() do { if (!MK_PER_PHASE && ph + 1 < hi) { xcd_barrier(bar); if ((PROBE_MASK >> 12) & 1) xcd_barrier(bar); } ++ph; } while (0)
#define PHASE_BEGIN() const P p = make_p(args); int bx = blockIdx.x, G = gridDim.x; asm volatile("" : "+s"(bx), "+s"(G))

    if (RUN()) { PHASE_BEGIN(); REP(0) misc::prologue(p, ldsp, G, bx); }
    SEAM();
    for (int slot = 0; slot < 4; ++slot) {
        if (RUN()) { PHASE_BEGIN();
            pg8::Gemm g{p.XB, p.WFI + (size_t)slot * 2 * D_FF * D_MODEL, M, 2 * D_FF, D_MODEL, D_MODEL}; pg8::StaticOrder S; S.init(M, 2 * D_FF, G, bx);
            if ((PROBE_MASK >> 17) & 1) { pg8::EpiNull E0; pg8::gemm_phase<pg8::EpiNull, pg8::StaticOrder, true, true>(ldsp, g, S, E0); }
            pg8::EpiSwiglu E{p}; REP(1) pg8::gemm_phase<pg8::EpiSwiglu, pg8::StaticOrder, true, true>(ldsp, g, S, E);
            __syncthreads(); misc::convert_in_tail<1>(p, ldsp, slot, (M / 256) * (2 * D_FF / 256), G, bx);
            if (slot == 1) misc::convert_in_tail<4>(p, ldsp, 0, (M / 256) * (2 * D_FF / 256), G, bx);
        }
        SEAM();
        for (int job = 0; job < 2; ++job) {
            if (job == 1) {
                if (slot == 0) {
                    if (RUN()) { PHASE_BEGIN();
                        pg8::Gemm g{p.XB, p.WSI, M, NSI, D_MODEL, D_MODEL}; pg8::StaticOrder S; S.init(M, NSI, G, bx);
                        pg8::EpiRow<EfSsmIn> E{p}; REP(2) pg8::gemm_phase<pg8::EpiRow<EfSsmIn>, pg8::StaticOrder, true, true>(ldsp, g, S, E);
                        __syncthreads(); misc::convert_in_tail<3>(p, ldsp, 0, (M / 256) * (NSI / 256), G, bx);
                        misc::convert_in_tail<0>(p, ldsp, 1, (M / 256) * (NSI / 256), G, bx);
                        misc::convert_in_tail<0>(p, ldsp, 2, (M / 256) * (NSI / 256), G, bx);
                    }
                    SEAM();
                    if (RUN()) { PHASE_BEGIN();
#pragma unroll 1
                        for (int part = 0; part < 2; ++part) {
                            if (((part ^ (bx >> 3)) & 1) == 0) { REP(3) ssd::states_phase(p, G, bx, ldsp); }
                            else { REP(14) misc::ssd_sample_phase(p, G, bx, ldsp); } } }
                    SEAM();
                    if (RUN()) { PHASE_BEGIN(); REP(4) GRID_STRIDE(ssd::N_SCAN4, ssd::scan4(p, i)); }
                    SEAM();
                    if (RUN()) { PHASE_BEGIN(); REP(5) for (int u = bx; u < BATCH * NCHUNK * SSD_GROUPS; u += G) ssd::y_unit(p, u / SSD_GROUPS, u % SSD_GROUPS, ldsp); }
                    SEAM();
                } else if (slot == 2) {
                    if (RUN()) { PHASE_BEGIN();
                        pg8::Gemm g{p.XB, p.WQKV, M, QKVW, D_MODEL, D_MODEL}; pg8::StaticOrder S; S.init(M, QKVW, G, bx);
                        pg8::EpiRow<EfQkv> E{p}; REP(6) pg8::gemm_phase<pg8::EpiRow<EfQkv>, pg8::StaticOrder, true, true>(ldsp, g, S, E);
                        __syncthreads(); misc::convert_in_tail<5>(p, ldsp, 0, (M / 256) * (QKVW / 256), G, bx);
                        misc::convert_in_tail<0>(p, ldsp, 3, (M / 256) * (QKVW / 256), G, bx);
                    }
                    SEAM();
                    if (RUN()) { PHASE_BEGIN();
#pragma unroll 1
                        for (int part = 0; part < 2; ++part) {
                            if (((part ^ (bx >> 3)) & 1) == 0) { REP(7) att::prompt_phase(p, G, bx, ldsp); }
                            else { REP(10) for (int u = bx; u < att::N_SUNITS; u += G) att::sample_unit(p, u, ldsp); } } }
                    SEAM();
                    if (RUN()) { PHASE_BEGIN(); REP(8) GRID_STRIDE(att::N_MERGE, att::merge(p, i)); }
                    SEAM();
                } else break;
            }
            const int rk = job == 0 ? D_FF : (slot == 0 ? D_INNER : AW), rs = job == 0 ? 11 : (slot == 0 ? 8 : 4);
            if (RUN()) { PHASE_BEGIN();
                const bf16* A = job == 0 ? p.H : (slot == 0 ? p.GZ : p.O); const bf16* Bt = job == 0 ? p.WFO + (size_t)slot * D_MODEL * D_FF : (slot == 0 ? p.WSO : p.WO);
                { pg8::Gemm g{A, Bt, MP, D_MODEL, rk, rk}; pg8::StaticOrder S; S.init(MP, D_MODEL, G, bx);
                  if ((PROBE_MASK >> 13) & 1) { pg8::EpiNull E0; pg8::gemm_phase<pg8::EpiNull, pg8::StaticOrder, true, true>(ldsp, g, S, E0); }
                  pg8::EpiResid E{p, slot + job == 0}; pg8::gemm_phase<pg8::EpiResid, pg8::StaticOrder, true, true>(ldsp, g, S, E); }
                { pg8::Gemm g{A, Bt, M, D_MODEL, rk / rs, rk}; pg8::SplitOrder S; S.init(MP / 256, MS / 256, D_MODEL / 256, rs, G, bx);
                  pg8::EpiPart E{p}; REP(11) pg8::gemm_phase<pg8::EpiPart, pg8::SplitOrder, true, true>(ldsp, g, S, E); }
            }
            SEAM();
            if (slot == 3 && job == 0) { static_assert(misc::S_LAST == 11, "the final norm sums the last GEMM's partials itself"); break; }
            if (RUN()) { PHASE_BEGIN(); misc::splitk_fixup(p, rs, G, bx, slot + job == 0); }
            SEAM();
        }
    }
    if (RUN()) { PHASE_BEGIN(); REP(9) misc::final_norm(p, ldsp, G, bx); }
#undef RUN
#undef SEAM
}
constexpr int N_PHASES = 1 + 4 * 3 + 6 + 5 + 1 - 1;

extern "C" void kernel_launch(void* const* d_in, const int* in_sizes, int n_in, void* d_out, int out_size, void* d_ws, size_t ws_size, hipStream_t stream) {
    static int grid = 0;
    if (grid == 0) {
        int dev = 0, cus = 0, per_cu = 0;
        if (hipGetDevice(&dev) != hipSuccess || hipDeviceGetAttribute(&cus, hipDeviceAttributeMultiprocessorCount, dev) != hipSuccess) { fprintf(stderr, "kernel_launch: device query failed\n"); grid = -1; return; }
        if (hipFuncSetAttribute((const void*)mega_fwd, hipFuncAttributeMaxDynamicSharedMemorySize, LDS_BYTES) != hipSuccess) { fprintf(stderr, "kernel_launch: hipFuncSetAttribute failed\n"); grid = -1; return; }
        if (hipOccupancyMaxActiveBlocksPerMultiprocessor(&per_cu, (const void*)mega_fwd, NTHR, LDS_BYTES) != hipSuccess || per_cu < 1) fprintf(stderr, "kernel_launch: occupancy query says %d\n", per_cu);
        (void)hipGetLastError();
        grid = cus;
    }
    if (grid < 0) return;
    KArgs a; memset(&a, 0, sizeof(a));
    const float* const* in = (const float* const*)d_in;
    a.x_prompt = in[0]; a.x_sample = in[1]; a.state_conv = in[2]; a.state_ssm = in[3]; a.cache0 = in[4]; a.cache1 = in[5]; a.cache2 = in[6]; a.norm_w = in[7]; a.w_ffn_in = in[8]; a.w_ffn_out = in[9]; a.ssm_w_in = in[10]; a.ssm_conv_w = in[11]; a.ssm_conv_b = in[12]; a.ssm_dt_bias = in[13]; a.ssm_a_log = in[14]; a.ssm_d = in[15]; a.ssm_norm_w = in[16]; a.ssm_w_out = in[17]; a.attn_w_qkv = in[18]; a.attn_w_o = in[19]; a.norm_f = in[20];
    a.out = (float*)d_out; a.ws = (unsigned char*)d_ws;
    if (OUT_ELEMS != (size_t)out_size) fprintf(stderr, "kernel_launch: output size mismatch: %zu vs %d\n", (size_t)OUT_ELEMS, out_size);
    if (WS_NEED > ws_size) { fprintf(stderr, "kernel_launch: workspace too small: need %zu have %zu\n", (size_t)WS_NEED, ws_size); return; }
    if (hipMemsetAsync((unsigned char*)d_ws + WO_ctl, 0, CTL_BYTES, stream) != hipSuccess) { fprintf(stderr, "kernel_launch: memset failed\n"); return; }
#if MK_PER_PHASE
    for (int k = 0; k < N_PHASES; ++k) { a.ph_lo = k; a.ph_hi = k + 1; hipLaunchKernelGGL(mega_fwd, dim3(grid), dim3(NTHR), LDS_BYTES, stream, a); }
#else
    a.ph_lo = 0; a.ph_hi = N_PHASES; hipLaunchKernelGGL(mega_fwd, dim3(grid), dim3(NTHR), LDS_BYTES, stream, a);
#endif
    const hipError_t le = hipPeekAtLastError();
    if (le != hipSuccess) fprintf(stderr, "kernel_launch: launch failed: %s\n", hipGetErrorName(le));
}
#endif
```

```cpp
#ifndef HOST_SIM
#include <hip/hip_runtime.h>
#define HD __host__ __device__ __forceinline__
#else
#include <cmath>
#define HD inline
#endif
#include <cstdio>
#include <cstdint>
#include <cstddef>
#include <cstring>

#ifdef SMALL
constexpr int D_MODEL = 128, BATCH = 1, SEQ = 4096, DEC_BATCH = 2, DEC_SEQ = 8, PAST_LEN = 2048, D_FF = 256, SSD_GROUPS = 2, D_STATE = 32, ATTN_HPG = 2;
#else
constexpr int D_MODEL = 1024, BATCH = 4, SEQ = 4096, DEC_BATCH = 128, DEC_SEQ = 8, PAST_LEN = 2048, D_FF = 2816, SSD_GROUPS = 8, D_STATE = 128, ATTN_HPG = 8;
#endif
constexpr float EPS = 1e-6f;
constexpr int D_INNER = 2 * D_MODEL, HEADDIM = 64, SSD_HEADS = D_INNER / HEADDIM, SSD_HPG = SSD_HEADS / SSD_GROUPS;
constexpr int CONV_W = 4, CONV_DIM = D_INNER + 2 * SSD_GROUPS * D_STATE, D_IN_PROJ = D_INNER + CONV_DIM + SSD_HEADS, CHUNK = 128, NCHUNK = SEQ / CHUNK;
constexpr int GW = D_INNER / SSD_GROUPS;
constexpr int AHD = 64, AW = ATTN_HPG * AHD, QKVW = 9 * AW, NAH = 3 * ATTN_HPG;
constexpr int MP = BATCH * SEQ, MS = DEC_BATCH * DEC_SEQ, M = MP + MS;
constexpr int ZXW = D_INNER + CONV_DIM;
constexpr int DT_COL0 = (ZXW + 255) / 256 * 256;
constexpr int NSI = DT_COL0 + 256;
constexpr int ZXP = DT_COL0;
constexpr int NSS = 16;
HD int a_win(int g) { return g == 0 ? 128 : (g == 1 ? 512 : 2048); }
HD int a_dil(int g) { return g == 0 ? 1 : (g == 1 ? 4 : 16); }
HD int a_past(int g) { return a_win(g) < PAST_LEN ? a_win(g) : PAST_LEN; }
HD int a_keep(int g) { return a_win(g) < SEQ ? a_win(g) : SEQ; }

typedef unsigned short bf16;
HD unsigned f2bf(float f) { unsigned u; memcpy(&u, &f, 4); return (u + 0x7fffu + ((u >> 16) & 1u)) >> 16; }
HD float bf2f(bf16 h) { unsigned u = (unsigned)h << 16; float f; memcpy(&f, &u, 4); return f; }
HD unsigned pk2bf(float lo, float hi) {
#if defined(__HIP_DEVICE_COMPILE__)
    typedef float f32x2_t __attribute__((ext_vector_type(2))); typedef __bf16 bf16x2_t __attribute__((ext_vector_type(2)));
    const f32x2_t v = {lo, hi}; const bf16x2_t b = __builtin_convertvector(v, bf16x2_t); return __builtin_bit_cast(unsigned, b);
#else
    return pk2bf(lo, hi);
#endif
}
HD float silu_f(float x) {
#if defined(__HIP_DEVICE_COMPILE__)
    return x * __builtin_amdgcn_rcpf(1.f + __expf(-x));
#else
    return x / (1.f + expf(-x));
#endif
}
HD float softplus_f(float x) { return x > 20.f ? x : log1pf(expf(x)); }

struct P {
    const float *x_prompt, *x_sample, *state_conv, *state_ssm, *cache0, *cache1, *cache2, *norm_w, *w_ffn_in, *w_ffn_out, *ssm_w_in, *ssm_conv_w, *ssm_conv_b,
        *ssm_dt_bias, *ssm_a_log, *ssm_d, *ssm_norm_w, *ssm_w_out, *attn_w_qkv, *attn_w_o, *norm_f;
    float *y_prompt, *y_sample, *conv_prompt, *conv_sample, *ssm_prompt, *ssm_sample, *kvp0, *kvs0, *kvp1, *kvs1, *kvp2, *kvs2;
    bf16 *WFI, *WFO, *WSI, *WSO, *WQKV, *WO, *XB, *H, *ZX, *HPREV, *GZ, *QKV, *O, *OG;
    float *X, *SS, *DT, *ACUM, *XC, *STATES, *Y, *CDEC, *LSE, *PART;
    bf16* XLO;
    unsigned* ctl;
    long cd1, cd2;
};
HD const float* cache_of(const P& p, int g) { return (const float*)((const char*)p.cache0 + (g == 0 ? 0 : (g == 1 ? p.cd1 : p.cd2))); }
HD float* kvp_of(const P& p, int g) { return p.kvp0 + (g == 0 ? 0 : (g == 1 ? (long)(p.kvp1 - p.kvp0) : (long)(p.kvp2 - p.kvp0))); }
HD float* kvs_of(const P& p, int g) { return p.kvs0 + (g == 0 ? 0 : (g == 1 ? (long)(p.kvs1 - p.kvs0) : (long)(p.kvs2 - p.kvs0))); }
HD float rstd_of(const P& p, int row) { float s = 0.f; for (int i = 0; i < NSS; ++i) s += p.SS[(size_t)row * NSS + i];
#if defined(__HIP_DEVICE_COMPILE__)
    return __builtin_amdgcn_rsqf(s * (1.f / D_MODEL) + EPS);
#else
    return 1.f / sqrtf(s * (1.f / D_MODEL) + EPS);
#endif
}
HD void row_bt(int row, bool& samp, int& b, int& t) { samp = row >= MP; if (!samp) { b = row / SEQ; t = row % SEQ; } else { const int r = row - MP; b = r / DEC_SEQ; t = r % DEC_SEQ; } }

constexpr long N_WFI = 4L * 2 * D_FF * D_MODEL, N_WFO = 4L * D_MODEL * D_FF, N_WSI = (long)NSI * D_MODEL, N_WSO = (long)D_MODEL * D_INNER, N_WQKV = (long)QKVW * D_MODEL, N_WO = (long)D_MODEL * AW;
HD void st_wfi(const P& p, long i) {
    const int k = (int)(i % D_MODEL); long r = i / D_MODEL; const int n = (int)(r % (2 * D_FF)); const int ls = (int)(r / (2 * D_FF));
    const int pn = n / 256, j = n % 256, oc = j < 128 ? 128 * pn + j : D_FF + 128 * pn + (j - 128);
    const float g = p.norm_w[((ls >> 1) * 3 + ((ls & 1) ? 2 : 0)) * D_MODEL + k];
    p.WFI[i] = (bf16)f2bf(p.w_ffn_in[((size_t)ls * D_MODEL + k) * (2 * D_FF) + oc] * g);
}
HD void st_wfo(const P& p, long i) {
    const int k = (int)(i % D_FF); long r = i / D_FF; const int n = (int)(r % D_MODEL); const int ls = (int)(r / D_MODEL);
    p.WFO[i] = (bf16)f2bf(0.5f * p.w_ffn_out[((size_t)ls * D_FF + k) * D_MODEL + n]);
}
HD void st_wsi(const P& p, long i) {
    const int k = (int)(i % D_MODEL), n = (int)(i / D_MODEL); int oc = -1;
    if (n < ZXW) oc = n; else if (n >= DT_COL0 && n < DT_COL0 + SSD_HEADS) oc = ZXW + (n - DT_COL0);
    p.WSI[i] = oc < 0 ? (bf16)0 : (bf16)f2bf(p.ssm_w_in[(size_t)k * D_IN_PROJ + oc] * p.norm_w[(0 * 3 + 1) * D_MODEL + k]);
}
HD void st_wso(const P& p, long i) { const int k = (int)(i % D_INNER), n = (int)(i / D_INNER); p.WSO[i] = (bf16)f2bf(p.ssm_w_out[(size_t)k * D_MODEL + n]); }
HD void st_wqkv(const P& p, long i) {
    const int k = (int)(i % D_MODEL), n = (int)(i / D_MODEL); const bool isq = (n / AW) % 3 == 0;
    p.WQKV[i] = (bf16)f2bf(p.attn_w_qkv[(size_t)k * QKVW + n] * p.norm_w[(1 * 3 + 1) * D_MODEL + k] * (isq ? 0.125f : 1.f));
}
HD void st_wo(const P& p, long i) { const int k = (int)(i % AW), n = (int)(i / AW); p.WO[i] = (bf16)f2bf(p.attn_w_o[(size_t)k * D_MODEL + n]); }
HD void st_xinit(const P& p, long i) {
    const int part = (int)(i % NSS), row = (int)(i / NSS); constexpr int W = D_MODEL / NSS;
    const float* src = row < MP ? p.x_prompt + (size_t)row * D_MODEL : p.x_sample + (size_t)(row - MP) * D_MODEL; float s = 0.f;
    for (int c = part * W; c < (part + 1) * W; ++c) { const float v = src[c]; p.X[(size_t)row * D_MODEL + c] = v; p.XB[(size_t)row * D_MODEL + c] = (bf16)f2bf(v); s += v * v; }
    p.SS[(size_t)row * NSS + part] = s;
}
HD float ssd_a(const P& p, int head) { return -expf(p.ssm_a_log[head]); }
HD void st_acum(const P& p, long i) {
    const int head = (int)(i % SSD_HEADS); const int sc = (int)(i / SSD_HEADS); int row0, len;
    if (sc < MP / CHUNK) { row0 = sc * CHUNK; len = CHUNK; } else { row0 = MP + (sc - MP / CHUNK) * DEC_SEQ; len = DEC_SEQ; }
    const float a = ssd_a(p, head); float c = 0.f;
    for (int t = 0; t < len; ++t) { c += p.DT[(size_t)(row0 + t) * SSD_HEADS + head] * a; p.ACUM[(size_t)(row0 + t) * SSD_HEADS + head] = c; }
}
constexpr long N_ACUM = (long)(MP / CHUNK + DEC_BATCH) * SSD_HEADS;
HD void st_conv(const P& p, long i) {
    const int ch = (int)(i % CONV_DIM), row = (int)(i / CONV_DIM); bool samp; int b, t; row_bt(row, samp, b, t);
    float acc = p.ssm_conv_b[ch];
    for (int k = 0; k < CONV_W; ++k) { const int tt = t - (CONV_W - 1) + k; float v;
        if (tt >= 0) v = bf2f(p.ZX[(size_t)(row - t + tt) * ZXP + D_INNER + ch]);
        else v = samp ? p.state_conv[((size_t)b * (CONV_W - 1) + (tt + CONV_W - 1)) * CONV_DIM + ch] : 0.f;
        acc += p.ssm_conv_w[k * CONV_DIM + ch] * v; }
    p.XC[(size_t)row * CONV_DIM + ch] = silu_f(acc);
}
HD void st_states(const P& p, long i) {
    const int n = (int)(i % D_STATE); long r = i / D_STATE; const int pp = (int)(r % HEADDIM); r /= HEADDIM; const int head = (int)(r % SSD_HEADS); const int bc = (int)(r / SSD_HEADS);
    const int row0 = bc * CHUNK, g = head / SSD_HPG; const float alast = p.ACUM[(size_t)(row0 + CHUNK - 1) * SSD_HEADS + head]; float s = 0.f;
    for (int t = 0; t < CHUNK; ++t) { const size_t rr = row0 + t;
        s += expf(alast - p.ACUM[rr * SSD_HEADS + head]) * p.DT[rr * SSD_HEADS + head] * p.XC[rr * CONV_DIM + head * HEADDIM + pp] * p.XC[rr * CONV_DIM + D_INNER + g * D_STATE + n]; }
    p.STATES[i] = s;
}
constexpr long N_STATES = (long)BATCH * NCHUNK * SSD_HEADS * HEADDIM * D_STATE;
HD void st_scan(const P& p, long i) {
    const long per = (long)HEADDIM * D_STATE; const long e = i % per; long r = i / per; const int head = (int)(r % SSD_HEADS), b = (int)(r / SSD_HEADS); float h = 0.f;
    for (int c = 0; c < NCHUNK; ++c) { const size_t idx = (((size_t)(b * NCHUNK + c)) * SSD_HEADS + head) * per + e;
        p.HPREV[idx] = (bf16)f2bf(h);
        h = expf(p.ACUM[(size_t)((b * NCHUNK + c) * CHUNK + CHUNK - 1) * SSD_HEADS + head]) * h + p.STATES[idx]; }
    p.ssm_prompt[i] = h;
}
constexpr long N_SCAN = (long)BATCH * SSD_HEADS * HEADDIM * D_STATE;
HD void st_y(const P& p, long i) {
    const int pp = (int)(i % HEADDIM); long r = i / HEADDIM; const int head = (int)(r % SSD_HEADS), row = (int)(r / SSD_HEADS); const int g = head / SSD_HPG;
    const int bc = row / CHUNK, row0 = bc * CHUNK; const float at = p.ACUM[(size_t)row * SSD_HEADS + head];
    const float* Ct = p.XC + (size_t)row * CONV_DIM + D_INNER + SSD_GROUPS * D_STATE + g * D_STATE; float y = 0.f;
    for (int rr = row0; rr <= row; ++rr) { const float* Bs = p.XC + (size_t)rr * CONV_DIM + D_INNER + g * D_STATE; float cb = 0.f;
        for (int n = 0; n < D_STATE; ++n) cb += Ct[n] * Bs[n];
        y += cb * expf(at - p.ACUM[(size_t)rr * SSD_HEADS + head]) * p.DT[(size_t)rr * SSD_HEADS + head] * p.XC[(size_t)rr * CONV_DIM + head * HEADDIM + pp]; }
    const bf16* hp = p.HPREV + (((size_t)bc * SSD_HEADS + head) * HEADDIM + pp) * D_STATE; float yo = 0.f;
    for (int n = 0; n < D_STATE; ++n) yo += Ct[n] * bf2f(hp[n]);
    p.Y[(size_t)row * D_INNER + head * HEADDIM + pp] = y + yo * expf(at) + p.ssm_d[head] * p.XC[(size_t)row * CONV_DIM + head * HEADDIM + pp];
}
constexpr long N_Y = (long)MP * SSD_HEADS * HEADDIM;
HD void st_ssd_sample(const P& p, long i) {
    const int pp = (int)(i % HEADDIM); long r = i / HEADDIM; const int head = (int)(r % SSD_HEADS), b = (int)(r / SSD_HEADS); const int g = head / SSD_HPG;
    const int row0 = MP + b * DEC_SEQ; const float a = ssd_a(p, head); float ya[DEC_SEQ];
    for (int t = 0; t < DEC_SEQ; ++t) ya[t] = 0.f;
    const size_t sb = (((size_t)b * SSD_HEADS + head) * HEADDIM + pp) * D_STATE;
    for (int n = 0; n < D_STATE; ++n) { float h = p.state_ssm[sb + n];
#pragma unroll
        for (int t = 0; t < DEC_SEQ; ++t) { const size_t rr = row0 + t; const float dt = p.DT[rr * SSD_HEADS + head];
            h = expf(dt * a) * h + dt * p.XC[rr * CONV_DIM + D_INNER + g * D_STATE + n] * p.XC[rr * CONV_DIM + head * HEADDIM + pp];
            ya[t] += p.XC[rr * CONV_DIM + D_INNER + SSD_GROUPS * D_STATE + g * D_STATE + n] * h; }
        p.ssm_sample[sb + n] = h; }
#pragma unroll
    for (int t = 0; t < DEC_SEQ; ++t) { const size_t rr = row0 + t; p.Y[rr * D_INNER + head * HEADDIM + pp] = ya[t] + p.ssm_d[head] * p.XC[rr * CONV_DIM + head * HEADDIM + pp]; }
}
constexpr long N_SSDS = (long)DEC_BATCH * SSD_HEADS * HEADDIM;
HD void st_gate(const P& p, long i) {
    const int g = (int)(i % SSD_GROUPS), row = (int)(i / SSD_GROUPS); float ms = 0.f;
    for (int c = 0; c < GW; ++c) { const int ch = g * GW + c; const float v = p.Y[(size_t)row * D_INNER + ch] * silu_f(bf2f(p.ZX[(size_t)row * ZXP + ch])); ms += v * v; }
    const float r = 1.f / sqrtf(ms * (1.f / GW) + EPS);
    for (int c = 0; c < GW; ++c) { const int ch = g * GW + c; const float v = p.Y[(size_t)row * D_INNER + ch] * silu_f(bf2f(p.ZX[(size_t)row * ZXP + ch]));
        p.GZ[(size_t)row * D_INNER + ch] = (bf16)f2bf(v * r * p.ssm_norm_w[ch]); }
}
constexpr int ADQ = 4, ADW = AHD / ADQ;
HD void st_attn(const P& p, long i) {
    const int dq = (int)(i % ADQ); long r = i / ADQ; const int h = (int)(r % ATTN_HPG), row = (int)(r / ATTN_HPG); bool samp; int b, t; row_bt(row, samp, b, t);
    float o[ADW];
#pragma unroll
    for (int d = 0; d < ADW; ++d) o[d] = 0.f;
    float mx = -1e30f, l = 0.f;
    for (int g = 0; g < 3; ++g) { const int dil = a_dil(g), nk = a_win(g) / dil + 1, past = samp ? a_past(g) : 0;
        const float slope = exp2f(-8.f * (float)(g * ATTN_HPG + h + 1) / (float)NAH);
        const bf16* q = p.QKV + (size_t)row * QKVW + g * 3 * AW + h * AHD;
        for (int j = 0; j < nk; ++j) { const int idx = past + t - j * dil; if (idx < 0) break;
            float s = 0.f, vv[ADW];
            if (idx >= past) { const bf16* kr = p.QKV + (size_t)(row - t + (idx - past)) * QKVW + g * 3 * AW + AW + h * AHD; const bf16* vr = kr + AW + dq * ADW;
                for (int d = 0; d < AHD; ++d) s += bf2f(q[d]) * bf2f(kr[d]);
#pragma unroll
                for (int d = 0; d < ADW; ++d) vv[d] = bf2f(vr[d]); }
            else { const float* kr = cache_of(p, g) + (((size_t)b * past + idx) * 2) * AW + h * AHD; const float* vr = kr + AW + dq * ADW;
                for (int d = 0; d < AHD; ++d) s += bf2f(q[d]) * kr[d];
#pragma unroll
                for (int d = 0; d < ADW; ++d) vv[d] = vr[d]; }
            s -= slope * (float)(dil * j);
            if (s > mx) { const float f = expf(mx - s); l *= f;
#pragma unroll
                for (int d = 0; d < ADW; ++d) o[d] *= f;
                mx = s; }
            const float e = expf(s - mx); l += e;
#pragma unroll
            for (int d = 0; d < ADW; ++d) o[d] += e * vv[d]; } }
    const float inv = 1.f / l;
#pragma unroll
    for (int d = 0; d < ADW; ++d) p.O[(size_t)row * AW + h * AHD + dq * ADW + d] = (bf16)f2bf(o[d] * inv);
}
HD void st_final(const P& p, long i) {
    const int part = (int)(i % NSS), row = (int)(i / NSS); constexpr int W = D_MODEL / NSS;
    const float r = rstd_of(p, row); float* out = row < MP ? p.y_prompt + (size_t)row * D_MODEL : p.y_sample + (size_t)(row - MP) * D_MODEL;
    for (int c = part * W; c < (part + 1) * W; ++c) out[c] = p.X[(size_t)row * D_MODEL + c] * r * p.norm_f[c];
}

struct EfSwiglu {
    HD void operator()(const P& p, int row, int hcol0, float rstd, const float* a, const float* b) const {
        unsigned w[4];
#pragma unroll
        for (int i = 0; i < 4; ++i) { const float v0 = silu_f(a[2 * i] * rstd) * (b[2 * i] * rstd), v1 = silu_f(a[2 * i + 1] * rstd) * (b[2 * i + 1] * rstd); w[i] = pk2bf(v0, v1); }
        unsigned* dst = (unsigned*)(p.H + (size_t)row * D_FF + hcol0); dst[0] = w[0]; dst[1] = w[1]; dst[2] = w[2]; dst[3] = w[3];
    }
};
struct EfResid {
    HD float operator()(const P& p, int row, int col0, const float* v) const {
        float* x = p.X + (size_t)row * D_MODEL + col0; unsigned* xb = (unsigned*)(p.XB + (size_t)row * D_MODEL + col0); float s = 0.f, nv[8];
#pragma unroll
        for (int i = 0; i < 8; ++i) { nv[i] = x[i] + v[i]; s += nv[i] * nv[i]; }
#pragma unroll
        for (int i = 0; i < 8; ++i) x[i] = nv[i];
#pragma unroll
        for (int i = 0; i < 4; ++i) xb[i] = pk2bf(nv[2 * i], nv[2 * i + 1]);
        return s;
    }
};
struct EfSsmIn {
    HD void operator()(const P& p, int row, int col0, float rstd, const float* v) const {
        if (col0 < DT_COL0) {
            unsigned* dst = (unsigned*)(p.ZX + (size_t)row * ZXP + col0);
#pragma unroll
            for (int i = 0; i < 4; ++i) dst[i] = pk2bf(v[2 * i] * rstd, v[2 * i + 1] * rstd);
            if (col0 >= D_INNER && col0 < ZXW) { bool samp; int b, t; row_bt(row, samp, b, t); const int L = samp ? DEC_SEQ : SEQ;
                if (t >= L - (CONV_W - 1)) { float* o = (samp ? p.conv_sample : p.conv_prompt) + ((size_t)b * (CONV_W - 1) + (t - (L - (CONV_W - 1)))) * CONV_DIM + (col0 - D_INNER);
#pragma unroll
                    for (int i = 0; i < 8; ++i) o[i] = v[i] * rstd; } }
        } else {
#pragma unroll
            for (int i = 0; i < 8; ++i) { const int hd = col0 - DT_COL0 + i; if (hd < SSD_HEADS) p.DT[(size_t)row * SSD_HEADS + hd] = softplus_f(v[i] * rstd + p.ssm_dt_bias[hd]); }
        }
    }
};
struct EfQkv {
    HD void operator()(const P& p, int row, int col0, float rstd, const float* v) const {
        unsigned* dst = (unsigned*)(p.QKV + (size_t)row * QKVW + col0);
#pragma unroll
        for (int i = 0; i < 4; ++i) dst[i] = pk2bf(v[2 * i] * rstd, v[2 * i + 1] * rstd);
        const int g = col0 / (3 * AW), off = col0 - g * 3 * AW - AW;
        if (off >= 0) { bool samp; int b, t; row_bt(row, samp, b, t); float* o = nullptr;
            if (samp) o = kvs_of(p, g) + ((size_t)b * DEC_SEQ + t) * 2 * AW + off;
            else { const int keep = a_keep(g); if (t >= SEQ - keep) o = kvp_of(p, g) + ((size_t)b * keep + (t - (SEQ - keep))) * 2 * AW + off; }
            if (o) {
#pragma unroll
                for (int i = 0; i < 8; ++i) o[i] = v[i] * rstd; } }
    }
};

#ifndef HOST_SIM
#define LAS __attribute__((address_space(3)))
#define GAS __attribute__((address_space(1)))
typedef GAS unsigned gu32;
#define RLX_AGENT __ATOMIC_RELAXED, __HIP_MEMORY_SCOPE_AGENT
__device__ __forceinline__ float lane_xor_f(float v, int lane, int m) { return __int_as_float(__builtin_amdgcn_ds_bpermute((lane ^ m) << 2, __float_as_int(v))); }
__device__ __forceinline__ float lane_up_f(float v, int lane, int d) { return __int_as_float(__builtin_amdgcn_ds_bpermute((lane - d) << 2, __float_as_int(v))); }

__device__ __forceinline__ float bf_lo(unsigned w) { return __uint_as_float(w << 16); }
__device__ __forceinline__ float bf_hi(unsigned w) { return __uint_as_float(w & 0xffff0000u); }
typedef float hl_f4 __attribute__((ext_vector_type(4)));
#define SPLIT2(a, b, H, L) do { const unsigned h_ = pk2bf((a), (b)); (H) = h_; (L) = pk2bf((a) - bf_lo(h_), (b) - bf_hi(h_)); } while (0)
__device__ __forceinline__ hl_f4 join4(unsigned h0, unsigned h1, unsigned l0, unsigned l1) { hl_f4 v; v[0] = bf_lo(h0) + bf_lo(l0); v[1] = bf_hi(h0) + bf_hi(l0); v[2] = bf_lo(h1) + bf_lo(l1); v[3] = bf_hi(h1) + bf_hi(l1); return v; }
namespace pg8 {
#define PG8_LAS __attribute__((address_space(3)))
typedef unsigned short bf16_t;
typedef short bf16x8 __attribute__((ext_vector_type(8)));
typedef float f32x4 __attribute__((ext_vector_type(4)));
typedef unsigned u32x4 __attribute__((ext_vector_type(4)));
constexpr int BM = 256, BK = 64, HALF = 128, HTB = HALF * BK * 2, STAGE_BYTES = 8 * HTB, NXCD = 8, WGM = 8;
__host__ __device__ __forceinline__ int lds_byte(int r, int c) { const int st = (r >> 4) * 2 + (c >> 5), rr = r & 15, cc = c & 31, ob = rr * 64 + cc * 2; return st * 1024 + (ob ^ (((ob >> 9) & 1) << 5)); }
__host__ __device__ __forceinline__ void stage_rc(int b, int& R, int& C) { const int st = b / 1024, sb = b % 1024, swz = sb ^ (((sb >> 9) & 1) << 5); R = (st >> 1) * 16 + swz / 64; C = (st & 1) * 32 + (swz % 64) / 2; }
__host__ __device__ __forceinline__ int perm32(int rho) { const int n = rho >> 4, i = rho & 15; return 8 * (i >> 2) + 4 * n + (i & 3); }
struct Unit { int pm, pn, ks; };
struct Gemm { const bf16_t* A; const bf16_t* Bt; int M, N, K, kp; };
struct StaticOrder {
    int nM, nN, nwg, G, c;
    __host__ __device__ void init(int M_, int N_, int G_, int c_) { nM = M_ / BM; nN = N_ / BM; nwg = nM * nN; G = G_; c = c_; }
    __host__ __device__ bool next(int i, Unit& u) const {
        const long L = (long)i * G + c; if (L >= nwg) return false;
        int wgid = (int)L; { const int q = nwg / NXCD, r = nwg % NXCD, xcd = wgid % NXCD, off = wgid / NXCD; wgid = (xcd < r ? xcd * (q + 1) : r * (q + 1) + (xcd - r) * q) + off; }
        const int nig = WGM * nN, gid = wgid / nig, fm = gid * WGM, gsz = (nM - fm) < WGM ? (nM - fm) : WGM;
        u.pm = fm + ((wgid % nig) % gsz); u.pn = (wgid % nig) / gsz; u.ks = 0; return true;
    }
    __device__ __forceinline__ void a_ready(const Unit&) const {}
    __device__ __forceinline__ void done(const Unit&) const {}
};

template <class Epi, class Sched, bool ALIGN_EPI = false, bool SP2 = false>
__device__ __forceinline__ void gemm_phase(PG8_LAS unsigned char* lds, const Gemm g, const Sched& S, const Epi& E) {
    int tid = threadIdx.x; asm volatile("" : "+v"(tid));
    const int wid = __builtin_amdgcn_readfirstlane(tid >> 6), lane = tid & 63, wr = wid >> 2, wc = wid & 3, fr = lane & 15, fq = lane >> 4;
    const int K = g.K, nt = K / BK, KPI = g.kp;
    unsigned voffA[2], voffB[2];
#pragma unroll
    for (int i = 0; i < 2; ++i) { int R, C; stage_rc(tid * 16 + i * 8192, R, C); const int Rb = Epi::PERM ? ((R & ~31) + perm32(R & 31)) : R;
        voffA[i] = (unsigned)(R * KPI + C) * 2u; voffB[i] = (unsigned)(Rb * KPI + C) * 2u; }
    const size_t kstep = (size_t)(BK * 2);
    const size_t hstep = (size_t)HALF * KPI * 2;
    const size_t sstep = (size_t)K * 2;
    const size_t tstep = 2 * hstep;
    const unsigned ldsw = (unsigned)wid * 1024u;
    const int aoff = lds_byte(wr * 64 + fr, fq * 8), boff = lds_byte(wc * 32 + fr, fq * 8);
#define PG8_SA(b, h) (((b) * 2 + (h)) * HTB)
#define PG8_SB(b, h) ((4 + (b) * 2 + (h)) * HTB)
#define PG8_STAGE(bufoff, gbase, voff) do { _Pragma("unroll") for (int _i = 0; _i < 2; ++_i) \
        __builtin_amdgcn_global_load_lds((const unsigned*)((const char*)(gbase) + (voff)[_i]), (PG8_LAS unsigned*)(lds + (bufoff) + ldsw + _i * 8192), 16, 0, 0); } while (0)
#define PG8_LDA(dst, b, h) do { _Pragma("unroll") for (int m = 0; m < 4; ++m) _Pragma("unroll") for (int k = 0; k < 2; ++k) dst[m][k] = *(const PG8_LAS bf16x8*)(lds + PG8_SA(b, h) + aoff + m * 2048 + k * 1024); } while (0)
#define PG8_LDB(dst, b, h) do { _Pragma("unroll") for (int n = 0; n < 2; ++n) _Pragma("unroll") for (int k = 0; k < 2; ++k) dst[n][k] = *(const PG8_LAS bf16x8*)(lds + PG8_SB(b, h) + boff + n * 2048 + k * 1024); } while (0)
#define PG8_MMA(ai, bj, At, Bt) do { __builtin_amdgcn_s_setprio(1); _Pragma("unroll") for (int m = 0; m < 4; ++m) _Pragma("unroll") for (int n = 0; n < 2; ++n) _Pragma("unroll") for (int k = 0; k < 2; ++k) \
        acc[ai][bj][m][n] = __builtin_amdgcn_mfma_f32_16x16x32_bf16(Bt[n][k], At[m][k], acc[ai][bj][m][n], 0, 0, 0); __builtin_amdgcn_s_setprio(0); } while (0)
#define PG8_WAIT_V(n) asm volatile("s_waitcnt vmcnt(" #n ")" ::: "memory")
#define PG8_WAIT_L(n) asm volatile("s_waitcnt lgkmcnt(" #n ")" ::: "memory")
#define PG8_BAR __builtin_amdgcn_s_barrier()
#define PG8_SCHED __builtin_amdgcn_sched_barrier(0)
    Unit cur, nxt; int ui = 0; typename Epi::Pre pre;
    if (!S.next(0, cur)) return;
    const bool single = Epi::STAGED && !S.next(1, nxt);
    f32x4 acc[2][2][4][2];
#pragma unroll
    for (int a = 0; a < 2; ++a)
#pragma unroll
        for (int b = 0; b < 2; ++b)
#pragma unroll
            for (int m = 0; m < 4; ++m)
#pragma unroll
                for (int n = 0; n < 2; ++n) acc[a][b][m][n] = (f32x4){0.f, 0.f, 0.f, 0.f};
    bf16x8 At[4][2], B0[2][2], B1[2][2];
    const char* cA = (const char*)g.A + (size_t)cur.pm * tstep + (size_t)cur.ks * sstep; const char* cB = (const char*)g.Bt + (size_t)cur.pn * tstep + (size_t)cur.ks * sstep;
    S.a_ready(cur);
    if constexpr (SP2) {
        PG8_STAGE(PG8_SB(0, 0), cB, voffB); PG8_STAGE(PG8_SB(0, 1), cB + hstep, voffB); PG8_STAGE(PG8_SA(0, 0), cA, voffA); PG8_STAGE(PG8_SA(0, 1), cA + hstep, voffA);
        if (wr == 1) PG8_BAR;
        PG8_WAIT_V(2); PG8_BAR;
        PG8_STAGE(PG8_SB(1, 0), cB + kstep, voffB); PG8_STAGE(PG8_SA(1, 0), cA + kstep, voffA); PG8_STAGE(PG8_SB(1, 1), cB + hstep + kstep, voffB);
        PG8_WAIT_V(6); PG8_BAR;
    } else {
        PG8_STAGE(PG8_SB(0, 0), cB, voffB); PG8_STAGE(PG8_SA(0, 0), cA, voffA); PG8_STAGE(PG8_SB(0, 1), cB + hstep, voffB); PG8_STAGE(PG8_SA(0, 1), cA + hstep, voffA);
        if (wr == 1) PG8_BAR;
        PG8_WAIT_V(4); PG8_BAR;
        PG8_STAGE(PG8_SB(1, 0), cB + kstep, voffB); PG8_STAGE(PG8_SA(1, 0), cA + kstep, voffA); PG8_STAGE(PG8_SB(1, 1), cB + hstep + kstep, voffB);
        PG8_WAIT_V(6); PG8_BAR;
    }
    for (;;) {
        const bool has_next = S.next(ui + 1, nxt);
        const char* nA = has_next ? (const char*)g.A + (size_t)nxt.pm * tstep + (size_t)nxt.ks * sstep : cA; const char* nB = has_next ? (const char*)g.Bt + (size_t)nxt.pn * tstep + (size_t)nxt.ks * sstep : cB;
        for (int t = 0; t < nt; t += 2) {
            const bool last = (t == nt - 2);
            const char* a1 = cA + (size_t)(t + 1) * kstep;
            const char* a2 = last ? nA : cA + (size_t)(t + 2) * kstep; const char* b2 = last ? nB : cB + (size_t)(t + 2) * kstep;
            const char* a3 = a2 + kstep; const char* b3 = b2 + kstep;
            if (last && has_next) S.a_ready(nxt);
            if (last) E.pre(cur, wr, fr, fq, pre);
            if constexpr (SP2) {
            PG8_LDB(B0, 0, 0); PG8_LDB(B1, 0, 1); PG8_SCHED; PG8_LDA(At, 0, 0); PG8_STAGE(PG8_SA(1, 1), a1 + hstep, voffA);
            PG8_WAIT_V(8); PG8_WAIT_L(0); PG8_BAR; PG8_MMA(0, 0, At, B0); PG8_MMA(0, 1, At, B1); PG8_BAR; PG8_SCHED;
            PG8_LDA(At, 0, 1); PG8_STAGE(PG8_SB(0, 0), b2, voffB); PG8_STAGE(PG8_SB(0, 1), b2 + hstep, voffB); PG8_STAGE(PG8_SA(0, 0), a2, voffA);
            PG8_WAIT_V(8); PG8_WAIT_L(0); PG8_BAR; PG8_MMA(1, 0, At, B0); PG8_MMA(1, 1, At, B1); PG8_BAR; PG8_SCHED;
            PG8_LDB(B0, 1, 0); PG8_LDB(B1, 1, 1); PG8_SCHED; PG8_LDA(At, 1, 0); PG8_STAGE(PG8_SA(0, 1), a2 + hstep, voffA);
            PG8_WAIT_V(8); PG8_WAIT_L(0); PG8_BAR; PG8_MMA(0, 0, At, B0); PG8_MMA(0, 1, At, B1); PG8_BAR; PG8_SCHED;
            PG8_LDA(At, 1, 1); PG8_STAGE(PG8_SB(1, 0), b3, voffB); PG8_STAGE(PG8_SB(1, 1), b3 + hstep, voffB); PG8_STAGE(PG8_SA(1, 0), a3, voffA);
            PG8_WAIT_V(8); PG8_WAIT_L(0); PG8_BAR; PG8_MMA(1, 0, At, B0); PG8_MMA(1, 1, At, B1); PG8_BAR; PG8_SCHED;
            } else {
            PG8_LDB(B0, 0, 0); PG8_SCHED; PG8_LDA(At, 0, 0); PG8_STAGE(PG8_SA(1, 1), a1 + hstep, voffA);
            PG8_WAIT_L(8); PG8_BAR; PG8_WAIT_L(0); PG8_MMA(0, 0, At, B0); PG8_BAR; PG8_SCHED;
            PG8_LDB(B1, 0, 1); PG8_STAGE(PG8_SB(0, 0), b2, voffB);
            PG8_BAR; PG8_WAIT_L(0); PG8_MMA(0, 1, At, B1); PG8_BAR;
            PG8_LDA(At, 0, 1); PG8_STAGE(PG8_SA(0, 0), a2, voffA);
            PG8_BAR; PG8_WAIT_L(0); PG8_MMA(1, 0, At, B0); PG8_BAR; PG8_SCHED;
            PG8_STAGE(PG8_SB(0, 1), b2 + hstep, voffB);
            PG8_WAIT_V(6); PG8_BAR; PG8_MMA(1, 1, At, B1); PG8_BAR;
            PG8_LDB(B0, 1, 0); PG8_SCHED; PG8_LDA(At, 1, 0); PG8_STAGE(PG8_SA(0, 1), a2 + hstep, voffA);
            PG8_WAIT_L(8); PG8_BAR; PG8_WAIT_L(0); PG8_MMA(0, 0, At, B0); PG8_BAR; PG8_SCHED;
            PG8_LDB(B1, 1, 1); PG8_STAGE(PG8_SB(1, 0), b3, voffB);
            PG8_BAR; PG8_WAIT_L(0); PG8_MMA(0, 1, At, B1); PG8_BAR;
            PG8_LDA(At, 1, 1); PG8_STAGE(PG8_SA(1, 0), a3, voffA);
            PG8_BAR; PG8_WAIT_L(0); PG8_MMA(1, 0, At, B0); PG8_BAR; PG8_SCHED;
            PG8_STAGE(PG8_SB(1, 1), b3 + hstep, voffB);
            PG8_WAIT_V(6); PG8_BAR; PG8_MMA(1, 1, At, B1); PG8_BAR;
            }
        }
        if constexpr (ALIGN_EPI) { if (wr == 0) PG8_BAR; }
        if (!(Epi::STAGED && single)) { E(acc, cur, wr, wc, fr, fq, pre); } S.done(cur);
        if (!has_next) break;
#pragma unroll
        for (int a = 0; a < 2; ++a)
#pragma unroll
            for (int b = 0; b < 2; ++b)
#pragma unroll
                for (int m = 0; m < 4; ++m)
#pragma unroll
                    for (int n = 0; n < 2; ++n) acc[a][b][m][n] = (f32x4){0.f, 0.f, 0.f, 0.f};
        cur = nxt; cA = nA; cB = nB; ++ui;
        if constexpr (ALIGN_EPI) { if (wr == 1) PG8_BAR; }
    }
    PG8_WAIT_V(0);
    if constexpr (!ALIGN_EPI) { if (wr == 0) PG8_BAR; }
    PG8_BAR;
    if constexpr (Epi::STAGED) { if (single) E.staged(acc, cur, wr, wc, fr, fq, lds); }
#undef PG8_SA
#undef PG8_SB
#undef PG8_STAGE
#undef PG8_LDA
#undef PG8_LDB
#undef PG8_MMA
#undef PG8_WAIT_V
#undef PG8_WAIT_L
#undef PG8_BAR
#undef PG8_SCHED
}

__device__ __forceinline__ float rstd_q(const P& p, int row, int fr, int fq) {
    const f32x4 t = *(const f32x4*)(p.SS + (size_t)row * NSS + 4 * fq); float s = (t[0] + t[1]) + (t[2] + t[3]); const int ln = fq * 16 + fr;
    s += lane_xor_f(s, ln, 16); s += lane_xor_f(s, ln, 32); return __builtin_amdgcn_rsqf(s * (1.f / D_MODEL) + EPS);
}
struct RowStats { f32x4 t[4]; };
__device__ __forceinline__ void rstd_issue(const P& p, int rowbase, int fq, f32x4 (&t)[4]) {
#pragma unroll
    for (int m = 0; m < 4; ++m) t[m] = *(const f32x4*)(p.SS + (size_t)(rowbase + m * 16) * NSS + 4 * fq);
}
__device__ __forceinline__ void rstd_finish(const f32x4 (&t)[4], int fr, int fq, float (&rs)[4]) {
    const int ln = fq * 16 + fr; float s[4], x[4];
#pragma unroll
    for (int m = 0; m < 4; ++m) s[m] = (t[m][0] + t[m][1]) + (t[m][2] + t[m][3]);
#pragma unroll
    for (int m = 0; m < 4; ++m) x[m] = lane_xor_f(s[m], ln, 16);
#pragma unroll
    for (int m = 0; m < 4; ++m) s[m] += x[m];
#pragma unroll
    for (int m = 0; m < 4; ++m) x[m] = lane_xor_f(s[m], ln, 32);
#pragma unroll
    for (int m = 0; m < 4; ++m) rs[m] = __builtin_amdgcn_rsqf((s[m] + x[m]) * (1.f / D_MODEL) + EPS);
}
struct NoPre { };
struct EpiSwiglu {
    static constexpr bool PERM = true, STAGED = false; P p; typedef RowStats Pre;
    __device__ __forceinline__ void pre(const Unit& u, int wr, int fr, int fq, Pre& r) const { asm volatile("" : "+v"(fr), "+v"(fq)); rstd_issue(p, u.pm * BM + wr * 64 + fr, fq, r.t); }
    __device__ __forceinline__ void operator()(const f32x4 (&acc)[2][2][4][2], const Unit& u, int wr, int wc, int fr, int fq, const Pre& pr) const {
        asm volatile("" : "+v"(fr), "+v"(fq));
        EfSwiglu F; float rs[2][4]; f32x4 t1[4]; rstd_issue(p, u.pm * BM + HALF + wr * 64 + fr, fq, t1); rstd_finish(pr.t, fr, fq, rs[0]);
#pragma unroll
        for (int ai = 0; ai < 2; ++ai) { if (ai == 1) rstd_finish(t1, fr, fq, rs[1]);
#pragma unroll
            for (int m = 0; m < 4; ++m) { const int row = u.pm * BM + ai * HALF + wr * 64 + m * 16 + fr; const float rstd = rs[ai][m];
                float a[8], b[8];
#pragma unroll
                for (int n = 0; n < 2; ++n)
#pragma unroll
                    for (int e = 0; e < 4; ++e) { a[n * 4 + e] = acc[ai][0][m][n][e]; b[n * 4 + e] = acc[ai][1][m][n][e]; }
                F(p, row, u.pn * HALF + wc * 32 + 8 * fq, rstd, a, b); } }
    }
};
template <class F> struct EpiRow {
    static constexpr bool PERM = true, STAGED = false; P p; typedef RowStats Pre;
    __device__ __forceinline__ void pre(const Unit& u, int wr, int fr, int fq, Pre& r) const { asm volatile("" : "+v"(fr), "+v"(fq)); rstd_issue(p, u.pm * BM + wr * 64 + fr, fq, r.t); }
    __device__ __forceinline__ void operator()(const f32x4 (&acc)[2][2][4][2], const Unit& u, int wr, int wc, int fr, int fq, const Pre& pr) const {
        asm volatile("" : "+v"(fr), "+v"(fq));
        F f; float rs[2][4]; f32x4 t1[4]; rstd_issue(p, u.pm * BM + HALF + wr * 64 + fr, fq, t1); rstd_finish(pr.t, fr, fq, rs[0]);
#pragma unroll
        for (int ai = 0; ai < 2; ++ai) { if (ai == 1) rstd_finish(t1, fr, fq, rs[1]);
#pragma unroll
            for (int m = 0; m < 4; ++m) { const int row = u.pm * BM + ai * HALF + wr * 64 + m * 16 + fr; const float rstd = rs[ai][m];
#pragma unroll
                for (int bj = 0; bj < 2; ++bj) { float v[8];
#pragma unroll
                    for (int n = 0; n < 2; ++n)
#pragma unroll
                        for (int e = 0; e < 4; ++e) v[n * 4 + e] = acc[ai][bj][m][n][e];
                    f(p, row, u.pn * BM + bj * HALF + wc * 32 + 8 * fq, rstd, v); } } }
    }
};
constexpr int STG_PX = 1056;
constexpr int STG_SS = 128 * STG_PX;
struct EpiResid {
    static constexpr bool PERM = true, STAGED = true; P p; int first; typedef NoPre Pre;
    __device__ __forceinline__ void pre(const Unit&, int, int, int, Pre&) const {}
    __device__ __forceinline__ void staged(const f32x4 (&acc)[2][2][4][2], const Unit& u, int wr, int wc, int fr, int fq, PG8_LAS unsigned char* lds) const {
        asm volatile("" : "+v"(fr), "+v"(fq));
        const int w8 = wr * 4 + wc, lane = fq * 16 + fr;
#pragma unroll 1
        for (int ai = 0; ai < 2; ++ai) {
            const size_t grow0 = (size_t)u.pm * BM + ai * HALF;
            f32x4 x[4][2][2];
            if (first) {
#pragma unroll
                for (int m = 0; m < 4; ++m)
#pragma unroll
                    for (int bj = 0; bj < 2; ++bj) { const float* xp = p.x_prompt + (grow0 + wr * 64 + m * 16 + fr) * D_MODEL + u.pn * BM + bj * HALF + wc * 32 + 8 * fq; x[m][bj][0] = *(const f32x4*)xp; x[m][bj][1] = *(const f32x4*)(xp + 4); }
            } else {
                u32x4 h[4][2], l[4][2];
#pragma unroll
                for (int m = 0; m < 4; ++m)
#pragma unroll
                    for (int bj = 0; bj < 2; ++bj) { const size_t go = (grow0 + wr * 64 + m * 16 + fr) * D_MODEL + u.pn * BM + bj * HALF + wc * 32 + 8 * fq; h[m][bj] = *(const u32x4*)(p.XB + go); l[m][bj] = *(const u32x4*)(p.XLO + go); }
#pragma unroll
                for (int m = 0; m < 4; ++m)
#pragma unroll
                    for (int bj = 0; bj < 2; ++bj) { x[m][bj][0] = join4(h[m][bj][0], h[m][bj][1], l[m][bj][0], l[m][bj][1]); x[m][bj][1] = join4(h[m][bj][2], h[m][bj][3], l[m][bj][2], l[m][bj][3]); }
            }
#pragma unroll
            for (int m = 0; m < 4; ++m) { const int rl = wr * 64 + m * 16 + fr; float sq = 0.f;
#pragma unroll
                for (int bj = 0; bj < 2; ++bj) { const int cf = bj * HALF + wc * 32 + 8 * fq;
#pragma unroll
                    for (int n = 0; n < 2; ++n) { const f32x4 a = ai == 0 ? acc[0][bj][m][n] : acc[1][bj][m][n]; const f32x4 v = x[m][bj][n] + a;
                        sq += (v[0] * v[0] + v[1] * v[1]) + (v[2] * v[2] + v[3] * v[3]); *(PG8_LAS f32x4*)(lds + rl * STG_PX + (cf + 4 * n) * 4) = v; } }
                sq += lane_xor_f(sq, lane, 16); sq += lane_xor_f(sq, lane, 32);
                if (fq == 0) *(PG8_LAS float*)(lds + STG_SS + (rl * 4 + wc) * 4) = sq; }
            asm volatile("s_waitcnt lgkmcnt(0)" ::: "memory"); __builtin_amdgcn_s_barrier(); asm volatile("" ::: "memory");
#pragma unroll
            for (int i = 0; i < 8; ++i) { const int rl = w8 * 16 + 2 * i + (lane >> 5), c8 = lane & 31;
                const f32x4 v0 = *(const PG8_LAS f32x4*)(lds + rl * STG_PX + c8 * 32), v1 = *(const PG8_LAS f32x4*)(lds + rl * STG_PX + c8 * 32 + 16);
                u32x4 oh, ol; SPLIT2(v0[0], v0[1], oh[0], ol[0]); SPLIT2(v0[2], v0[3], oh[1], ol[1]); SPLIT2(v1[0], v1[1], oh[2], ol[2]); SPLIT2(v1[2], v1[3], oh[3], ol[3]);
                const size_t go = (grow0 + rl) * D_MODEL + u.pn * BM + c8 * 8;
                *(u32x4*)(p.XB + go) = oh; *(u32x4*)(p.XLO + go) = ol; }
            if (w8 < 2) { const int rl = w8 * 64 + lane; const f32x4 q4 = *(const PG8_LAS f32x4*)(lds + STG_SS + rl * 16); *(f32x4*)(p.SS + (grow0 + rl) * NSS + u.pn * 4) = q4; }
            asm volatile("s_waitcnt lgkmcnt(0)" ::: "memory"); __builtin_amdgcn_s_barrier(); asm volatile("" ::: "memory");
        }
    }
    __device__ __forceinline__ void operator()(const f32x4 (&acc)[2][2][4][2], const Unit& u, int wr, int wc, int fr, int fq, const Pre&) const {
        asm volatile("" : "+v"(fr), "+v"(fq));
#pragma unroll
        for (int ai = 0; ai < 2; ++ai)
#pragma unroll
            for (int m = 0; m < 4; ++m) { const int row = u.pm * BM + ai * HALF + wr * 64 + m * 16 + fr; float s = 0.f;
#pragma unroll
                for (int bj = 0; bj < 2; ++bj) { const size_t go = (size_t)row * D_MODEL + u.pn * BM + bj * HALF + wc * 32 + 8 * fq; f32x4 x0, x1;
                    if (first) { x0 = *(const f32x4*)(p.x_prompt + go); x1 = *(const f32x4*)(p.x_prompt + go + 4); }
                    else { const u32x4 h = *(const u32x4*)(p.XB + go), l = *(const u32x4*)(p.XLO + go); x0 = join4(h[0], h[1], l[0], l[1]); x1 = join4(h[2], h[3], l[2], l[3]); }
                    x0 += acc[ai][bj][m][0]; x1 += acc[ai][bj][m][1];
                    s += ((x0[0] * x0[0] + x0[1] * x0[1]) + (x0[2] * x0[2] + x0[3] * x0[3])) + ((x1[0] * x1[0] + x1[1] * x1[1]) + (x1[2] * x1[2] + x1[3] * x1[3]));
                    u32x4 oh, ol; SPLIT2(x0[0], x0[1], oh[0], ol[0]); SPLIT2(x0[2], x0[3], oh[1], ol[1]); SPLIT2(x1[0], x1[1], oh[2], ol[2]); SPLIT2(x1[2], x1[3], oh[3], ol[3]);
                    *(u32x4*)(p.XB + go) = oh; *(u32x4*)(p.XLO + go) = ol; }
                { const int ln = fq * 16 + fr; s += lane_xor_f(s, ln, 16); s += lane_xor_f(s, ln, 32); }
                if (fq == 0) p.SS[(size_t)row * NSS + u.pn * 4 + wc] = s; }
    }
};
struct SplitOrder {
    int pm0, nN, S, n, G, c;
    __host__ __device__ void init(int pm0_, int nM_, int nN_, int S_, int G_, int c_) { pm0 = pm0_; nN = nN_; S = S_; n = nM_ * nN_ * S_; G = G_; c = c_; }
    __host__ __device__ bool next(int i, Unit& u) const { const long L = (long)i * G + c; if (L >= n) return false; const int t = (int)L / S; u.ks = (int)L % S; u.pn = t % nN; u.pm = pm0 + t / nN; return true; }
    __device__ __forceinline__ void a_ready(const Unit&) const {}
    __device__ __forceinline__ void done(const Unit&) const {}
};
struct EpiNull {
    static constexpr bool PERM = true, STAGED = false; typedef NoPre Pre;
    __device__ __forceinline__ void pre(const Unit&, int, int, int, Pre&) const {}
    __device__ __forceinline__ void operator()(const f32x4 (&acc)[2][2][4][2], const Unit&, int, int, int, int, const Pre&) const {
#pragma unroll
        for (int a = 0; a < 2; ++a)
#pragma unroll
            for (int b = 0; b < 2; ++b)
#pragma unroll
                for (int m = 0; m < 4; ++m) { asm volatile("" :: "v"(acc[a][b][m][0]), "v"(acc[a][b][m][1])); }
    }
};
struct EpiPart {
    static constexpr bool PERM = true, STAGED = true; P p; typedef NoPre Pre;
    __device__ __forceinline__ void pre(const Unit&, int, int, int, Pre&) const {}
    __device__ __forceinline__ void staged(const f32x4 (&acc)[2][2][4][2], const Unit& u, int wr, int wc, int fr, int fq, PG8_LAS unsigned char* lds) const {
        asm volatile("" : "+v"(fr), "+v"(fq));
        const int w8 = wr * 4 + wc, lane = fq * 16 + fr;
#pragma unroll 1
        for (int ai = 0; ai < 2; ++ai) {
#pragma unroll
            for (int m = 0; m < 4; ++m) { const int rl = wr * 64 + m * 16 + fr;
#pragma unroll
                for (int bj = 0; bj < 2; ++bj) { const int cf = bj * HALF + wc * 32 + 8 * fq;
#pragma unroll
                    for (int n = 0; n < 2; ++n) *(PG8_LAS f32x4*)(lds + rl * STG_PX + (cf + 4 * n) * 4) = ai == 0 ? acc[0][bj][m][n] : acc[1][bj][m][n]; } }
            asm volatile("s_waitcnt lgkmcnt(0)" ::: "memory"); __builtin_amdgcn_s_barrier(); asm volatile("" ::: "memory");
            float* base = p.PART + ((size_t)u.ks * MS + (size_t)(u.pm * BM - MP) + ai * HALF) * D_MODEL + u.pn * BM + lane * 4;
#pragma unroll
            for (int i = 0; i < 16; ++i) { const int rl = w8 * 16 + i; *(f32x4*)(base + (size_t)rl * D_MODEL) = *(const PG8_LAS f32x4*)(lds + rl * STG_PX + lane * 16); }
            asm volatile("s_waitcnt lgkmcnt(0)" ::: "memory"); __builtin_amdgcn_s_barrier(); asm volatile("" ::: "memory");
        }
    }
    __device__ __forceinline__ void operator()(const f32x4 (&acc)[2][2][4][2], const Unit& u, int wr, int wc, int fr, int fq, const Pre&) const {
        asm volatile("" : "+v"(fr), "+v"(fq));
        float* base = p.PART + ((size_t)u.ks * MS + (size_t)(u.pm * BM - MP)) * D_MODEL + u.pn * BM + wc * 32 + 8 * fq;
#pragma unroll
        for (int ai = 0; ai < 2; ++ai)
#pragma unroll
            for (int m = 0; m < 4; ++m) { float* rp = base + (size_t)(ai * HALF + wr * 64 + m * 16 + fr) * D_MODEL;
#pragma unroll
                for (int bj = 0; bj < 2; ++bj) { *(f32x4*)(rp + bj * HALF) = acc[ai][bj][m][0]; *(f32x4*)(rp + bj * HALF + 4) = acc[ai][bj][m][1]; } }
    }
};
}

#define XB_TMO      128
#define XB_XCNT(j)  (256  + 64 * (j))
#define XB_XSUB(j)  (1280 + 64 * (j))
#define XB_XGEN(j)  (2304 + 64 * (j))
#define XB_TOP      3328
#define XB_TOPGEN   3392
#define XCD_BAR_WORDS 3456
#ifndef XB_SPIN_CAP
#define XB_SPIN_CAP (1u << 26)
#endif
__device__ __forceinline__ unsigned xb_ld(unsigned* p)              { return __hip_atomic_load(p, __ATOMIC_RELAXED, __HIP_MEMORY_SCOPE_AGENT); }
__device__ __forceinline__ unsigned xb_add(unsigned* p, unsigned v) { return __hip_atomic_fetch_add(p, v, __ATOMIC_RELAXED, __HIP_MEMORY_SCOPE_AGENT); }
__device__ __forceinline__ unsigned xb_xcc_id() { return (unsigned)__builtin_amdgcn_s_getreg((3 << 11) | 20) & 0xFu; }
#define XB_SPIN(cond, bar) do { unsigned _sp = 0; while (cond) { __builtin_amdgcn_s_sleep(1); \
    if ((++_sp & 255u) == 0u) { if (xb_ld(&(bar)[XB_TMO])) break; if (_sp > XB_SPIN_CAP) { atomicAdd(&(bar)[XB_TMO], 1u); break; } } } } while (0)
struct XcdBarrier { unsigned* bar; unsigned x; volatile LAS unsigned* st; };
__device__ __forceinline__ XcdBarrier xcd_barrier_post(unsigned* bar, volatile LAS unsigned* st) {
    XcdBarrier b; b.bar = bar; b.x = xb_xcc_id(); b.st = st;
    if (threadIdx.x == 0) (void)xb_add(&bar[XB_XCNT(b.x)], 1u);
    return b;
}
__device__ __forceinline__ void xcd_barrier_complete(unsigned* bar, unsigned x, unsigned& nloc, unsigned& nx) {
    const unsigned G = gridDim.x * gridDim.y * gridDim.z;
    unsigned sum, cnt, mine, sp = 0u;
    for (;;) {
        sum = 0u; cnt = 0u; mine = 0u;
#pragma unroll
        for (unsigned j = 0; j < 16; ++j) { const unsigned c = xb_ld(&bar[XB_XCNT(j)]); sum += c; cnt += (c > 0u) ? 1u : 0u; mine = (j == x) ? c : mine; }
        if (sum == G) break;
        __builtin_amdgcn_s_sleep(1);
        if ((++sp & 255u) == 0u) { if (xb_ld(&bar[XB_TMO])) break; if (sp > XB_SPIN_CAP) { atomicAdd(&bar[XB_TMO], 1u); break; } }
    }
    nloc = mine > 0u ? mine : 1u; nx = cnt > 0u ? cnt : 1u;
}
__device__ __attribute__((noinline)) void xcd_barrier(const XcdBarrier b) {
    asm volatile("s_waitcnt vmcnt(0)" ::: "memory");
    __syncthreads();
    if (threadIdx.x == 0) {
        unsigned* bar = b.bar;
        __builtin_amdgcn_s_waitcnt(0);
        unsigned nloc = b.st[0], nx = b.st[1];
        if (nloc == 0u) { xcd_barrier_complete(bar, b.x, nloc, nx); b.st[0] = nloc; b.st[1] = nx; }
        const unsigned old = xb_add(&bar[XB_XSUB(b.x)], 1u);
        const unsigned gen = old / nloc;
        if (old + 1u == (gen + 1u) * nloc) {
            __builtin_amdgcn_fence(__ATOMIC_RELEASE, "agent");
            asm volatile("s_waitcnt vmcnt(0)" ::: "memory");
            const unsigned og = xb_add(&bar[XB_TOP], 1u);
            const unsigned tg = og / nx;
            if (og + 1u == (tg + 1u) * nx) xb_add(&bar[XB_TOPGEN], 1u);
            else XB_SPIN(xb_ld(&bar[XB_TOPGEN]) == tg, bar);
            __builtin_amdgcn_fence(__ATOMIC_ACQUIRE, "agent");
            xb_add(&bar[XB_XGEN(b.x)], 1u);
            asm volatile("s_waitcnt vmcnt(0)" ::: "memory");
        } else {
            XB_SPIN(xb_ld(&bar[XB_XGEN(b.x)]) == gen, bar);
            __builtin_amdgcn_fence(__ATOMIC_ACQUIRE, "agent");
            asm volatile("s_waitcnt vmcnt(0)" ::: "memory");
        }
    }
    __syncthreads();
}


constexpr int MISC_OFF_ = 163840 - 1024, NTHR_ = 512, NWAVES_ = 8;
#ifndef PROBE_MASK
#define PROBE_MASK 0
#endif
#define REP(k) for (int rep_ = 0; rep_ < (((PROBE_MASK) >> (k)) & 1 ? 2 : 1); ++rep_)
namespace ssd {
typedef short bf16x8 __attribute__((ext_vector_type(8)));
typedef float f32x4 __attribute__((ext_vector_type(4)));
typedef unsigned u32x4 __attribute__((ext_vector_type(4)));
typedef unsigned u32x2 __attribute__((ext_vector_type(2)));
constexpr int PT = 136;
constexpr int L_C = 0, L_B = L_C + 128 * PT * 2, L_X = L_B + 128 * PT * 2, L_TA = L_X + 256 * PT * 2, L_TD = L_TA + 2048, L_END = L_TD + 2048;
static_assert(L_END <= MISC_OFF_ && SSD_HPG == 4 && D_STATE == 128 && GW == 256 && CHUNK == 128, "ssd fast path geometry");
__device__ __forceinline__ unsigned pk_bf16(float lo, float hi) { return pk2bf(lo, hi); }
__device__ __forceinline__ void unpack8(const u32x4 v, float* o) {
#pragma unroll
    for (int i = 0; i < 4; ++i) { o[2 * i] = __uint_as_float(v[i] << 16); o[2 * i + 1] = __uint_as_float(v[i] & 0xffff0000u); }
}
__device__ __forceinline__ float fast_silu(float x) { return silu_f(x); }

__device__ __forceinline__ void tables_issue(const P& p, int row0, int g, int w, int lane, float (&tin)[3]) {
    if (w < 4) { const int head = g * 4 + w;
        tin[0] = p.DT[(size_t)(row0 + 2 * lane) * SSD_HEADS + head]; tin[1] = p.DT[(size_t)(row0 + 2 * lane + 1) * SSD_HEADS + head]; tin[2] = p.ssm_a_log[head]; }
}
__device__ __forceinline__ void tables_finish(const float (&tin)[3], LAS float* tA, LAS float* tD, int w, int lane) {
    if (w < 4) {
        const float a = -expf(tin[2]); const float d0 = tin[0], d1 = tin[1];
        const float v0 = d0 * a, v1 = d1 * a; float s = v0 + v1;
#pragma unroll
        for (int o = 1; o < 64; o <<= 1) { const float t = lane_up_f(s, lane, o); if (lane >= o) s += t; }
        tA[w * 128 + 2 * lane] = s - v1; tA[w * 128 + 2 * lane + 1] = s; tD[w * 128 + 2 * lane] = d0; tD[w * 128 + 2 * lane + 1] = d1;
    }
}
struct ConvIn { u32x4 raw[16], wn[3]; f32x4 wt[10]; };
template <int MODE> __device__ __forceinline__ void conv_issue(const P& p, int row0, bool first_chunk, int g, int w, int lane, ConvIn& ci) {
    const int cls = lane < 32 ? 0 : (lane < 48 ? 1 : 2);
    if (MODE == 0 && cls == 2) return;
    const int chb = cls == 0 ? g * GW + 8 * lane : (cls == 1 ? D_INNER + g * D_STATE + 8 * (lane - 32) : D_INNER + SSD_GROUPS * D_STATE + g * D_STATE + 8 * (lane - 48));
#pragma unroll
    for (int k = 0; k < 4; ++k) { ci.wt[2 * k] = *(const f32x4*)(p.ssm_conv_w + k * CONV_DIM + chb); ci.wt[2 * k + 1] = *(const f32x4*)(p.ssm_conv_w + k * CONV_DIM + chb + 4); }
    ci.wt[8] = *(const f32x4*)(p.ssm_conv_b + chb); ci.wt[9] = *(const f32x4*)(p.ssm_conv_b + chb + 4);
    const bf16* src = p.ZX + (size_t)row0 * ZXP + D_INNER + chb;
    const int r0 = 16 * w;
#pragma unroll
    for (int i = 0; i < 3; ++i) { const int rr = r0 - 3 + i;
        if (rr < 0 && first_chunk) ci.wn[i] = (u32x4){0u, 0u, 0u, 0u}; else ci.wn[i] = *(const u32x4*)(src + (long)rr * ZXP); }
#pragma unroll
    for (int i = 0; i < 16; ++i) ci.raw[i] = *(const u32x4*)(src + (long)(r0 + i) * ZXP);
}
template <int MODE> __device__ __forceinline__ void conv_compute(LAS unsigned char* lds, int w, int lane, const ConvIn& ci) {
    const int cls = lane < 32 ? 0 : (lane < 48 ? 1 : 2);
    if (MODE == 0 && cls == 2) return;
    float cw[4][8], cb[8];
#pragma unroll
    for (int k = 0; k < 4; ++k)
#pragma unroll
        for (int e = 0; e < 4; ++e) { cw[k][e] = ci.wt[2 * k][e]; cw[k][4 + e] = ci.wt[2 * k + 1][e]; }
#pragma unroll
    for (int e = 0; e < 4; ++e) { cb[e] = ci.wt[8][e]; cb[4 + e] = ci.wt[9][e]; }
    const int r0 = 16 * w; float win[3][8];
#pragma unroll
    for (int i = 0; i < 3; ++i) unpack8(ci.wn[i], win[i]);
    const LAS float* tA = (const LAS float*)(lds + L_TA); const LAS float* tD = (const LAS float*)(lds + L_TD);
    const int j = lane >> 3;
    float alast = 0.f; if (MODE == 0 && cls == 0) alast = tA[j * 128 + 127];
    const bool transposed = (cls == 0) || (MODE == 0);
    const int tbase = cls == 0 ? L_X + (8 * lane) * PT * 2 : L_B + (8 * (lane - 32)) * PT * 2;
    const int nbase = cls == 1 ? L_B + 8 * (lane - 32) * 2 : L_C + 8 * (lane - 48) * 2;
    const u32x4 (&raw)[16] = ci.raw;
#pragma unroll
    for (int half = 0; half < 2; ++half) {
        unsigned tp[4][8];
#pragma unroll
        for (int rp = 0; rp < 4; ++rp) {
            const int sr = r0 + half * 8 + rp * 2;
            float c0[8], c1[8], o0[8], o1[8]; unpack8(raw[half * 8 + 2 * rp], c0); unpack8(raw[half * 8 + 2 * rp + 1], c1);
#pragma unroll
            for (int e = 0; e < 8; ++e) {
                o0[e] = fast_silu(cb[e] + cw[0][e] * win[0][e] + cw[1][e] * win[1][e] + cw[2][e] * win[2][e] + cw[3][e] * c0[e]);
                o1[e] = fast_silu(cb[e] + cw[0][e] * win[1][e] + cw[1][e] * win[2][e] + cw[2][e] * c0[e] + cw[3][e] * c1[e]);
                win[0][e] = win[2][e]; win[1][e] = c0[e]; win[2][e] = c1[e]; }
            if (MODE == 0 && cls == 0) { const float f0 = tD[j * 128 + sr] * __expf(alast - tA[j * 128 + sr]), f1 = tD[j * 128 + sr + 1] * __expf(alast - tA[j * 128 + sr + 1]);
#pragma unroll
                for (int e = 0; e < 8; ++e) { o0[e] *= f0; o1[e] *= f1; } }
            if (transposed) {
#pragma unroll
                for (int e = 0; e < 8; ++e) tp[rp][e] = pk_bf16(o0[e], o1[e]);
            } else {
                u32x4 v0, v1;
#pragma unroll
                for (int e = 0; e < 4; ++e) { v0[e] = pk_bf16(o0[2 * e], o0[2 * e + 1]); v1[e] = pk_bf16(o1[2 * e], o1[2 * e + 1]); }
                *(LAS u32x4*)(lds + nbase + sr * PT * 2) = v0; *(LAS u32x4*)(lds + nbase + (sr + 1) * PT * 2) = v1;
            }
        }
        if (transposed) {
#pragma unroll
            for (int e = 0; e < 8; ++e) *(LAS u32x4*)(lds + tbase + e * PT * 2 + (r0 + half * 8) * 2) = (u32x4){tp[0][e], tp[1][e], tp[2][e], tp[3][e]};
        }
    }
}
__device__ __forceinline__ void states_phase(const P& p, int G, int bx, LAS unsigned char* lds) {
    LAS float* tA = (LAS float*)(lds + L_TA); LAS float* tD = (LAS float*)(lds + L_TD);
    constexpr int NU = BATCH * NCHUNK * SSD_GROUPS;
    ConvIn ci; float tin[3];
    int u = bx;
    if (u < NU) { int t0 = threadIdx.x; asm volatile("" : "+v"(t0)); const int w0 = __builtin_amdgcn_readfirstlane(t0 >> 6), l0 = t0 & 63;
        const int bc = u / SSD_GROUPS, g = u % SSD_GROUPS; tables_issue(p, bc * CHUNK, g, w0, l0, tin); conv_issue<0>(p, bc * CHUNK, (bc % NCHUNK) == 0, g, w0, l0, ci); }
    for (; u < NU; u += G) {
    int tid = threadIdx.x; asm volatile("" : "+v"(tid));
    const int w = __builtin_amdgcn_readfirstlane(tid >> 6), lane = tid & 63, fr = lane & 15, fq = lane >> 4;
    const int bc = u / SSD_GROUPS, g = u % SSD_GROUPS;
    tables_finish(tin, tA, tD, w, lane);
    __syncthreads();
    if (tid < 4) p.CDEC[bc * SSD_HEADS + g * 4 + tid] = __expf(tA[tid * 128 + 127]);
    conv_compute<0>(lds, w, lane, ci);
    { const int un = u + G;
      if (un < NU) { int t1 = threadIdx.x; asm volatile("" : "+v"(t1)); const int w1 = __builtin_amdgcn_readfirstlane(t1 >> 6), l1 = t1 & 63;
          const int bcn = un / SSD_GROUPS, gn = un % SSD_GROUPS; tables_issue(p, bcn * CHUNK, gn, w1, l1, tin); conv_issue<0>(p, bcn * CHUNK, (bcn % NCHUNK) == 0, gn, w1, l1, ci); } }
    __syncthreads();
    bf16x8 af[4];
#pragma unroll
    for (int kk = 0; kk < 4; ++kk) af[kk] = *(const LAS bf16x8*)(lds + L_B + ((16 * w + fr) * PT + 32 * kk + 8 * fq) * 2);
#pragma unroll
    for (int j = 0; j < 4; ++j)
#pragma unroll
        for (int pt = 0; pt < 4; ++pt) { f32x4 acc = {0.f, 0.f, 0.f, 0.f};
#pragma unroll
            for (int kk = 0; kk < 4; ++kk) { const bf16x8 b = *(const LAS bf16x8*)(lds + L_X + ((j * 64 + 16 * pt + fr) * PT + 32 * kk + 8 * fq) * 2);
                acc = __builtin_amdgcn_mfma_f32_16x16x32_bf16(af[kk], b, acc, 0, 0, 0); }
            *(f32x4*)(p.STATES + (((size_t)bc * SSD_HEADS + g * 4 + j) * HEADDIM + 16 * pt + fr) * D_STATE + 16 * w + 4 * fq) = acc; }
    __syncthreads();
    }
}
constexpr long N_SCAN4 = (long)BATCH * SSD_HEADS * HEADDIM * D_STATE / 4;
__device__ __forceinline__ void scan4(const P& p, long i) {
    const int e4 = (int)(i % (HEADDIM * D_STATE / 4)); long r = i / (HEADDIM * D_STATE / 4); const int head = (int)(r % SSD_HEADS), b = (int)(r / SSD_HEADS);
    f32x4 h = {0.f, 0.f, 0.f, 0.f};
    for (int c = 0; c < NCHUNK; ++c) { const size_t idx = (((size_t)(b * NCHUNK + c)) * SSD_HEADS + head) * (HEADDIM * D_STATE) + e4 * 4;
        const f32x4 st = *(const f32x4*)(p.STATES + idx); const float dec = p.CDEC[(b * NCHUNK + c) * SSD_HEADS + head];
        u32x2 o; o[0] = pk_bf16(h[0], h[1]); o[1] = pk_bf16(h[2], h[3]); *(u32x2*)(p.HPREV + idx) = o;
        h = h * dec + st; }
    *(f32x4*)(p.ssm_prompt + (size_t)i * 4) = h;
}
__device__ __forceinline__ void y_unit(const P& p, int bc, int g, LAS unsigned char* lds) {
    int tid = threadIdx.x; asm volatile("" : "+v"(tid));
    const int w = __builtin_amdgcn_readfirstlane(tid >> 6), lane = tid & 63, fr = lane & 15, fq = lane >> 4;
    const int row0 = bc * CHUNK; LAS float* tA = (LAS float*)(lds + L_TA); LAS float* tD = (LAS float*)(lds + L_TD);
    { ConvIn ci; float tin[3];
      tables_issue(p, row0, g, w, lane, tin); conv_issue<1>(p, row0, (bc % NCHUNK) == 0, g, w, lane, ci);
      tables_finish(tin, tA, tD, w, lane);
      conv_compute<1>(lds, w, lane, ci); }
    __syncthreads();
    const int q = 16 * w + fr;
    bf16x8 cf[4];
#pragma unroll
    for (int kk = 0; kk < 4; ++kk) cf[kk] = *(const LAS bf16x8*)(lds + L_C + (q * PT + 32 * kk + 8 * fq) * 2);
    unsigned cbt[8][2];
#pragma unroll
    for (int st = 0; st < 8; ++st) { f32x4 t = {0.f, 0.f, 0.f, 0.f};
        if (st <= w) {
#pragma unroll
            for (int kk = 0; kk < 4; ++kk) { const bf16x8 a = *(const LAS bf16x8*)(lds + L_B + ((16 * st + fr) * PT + 32 * kk + 8 * fq) * 2);
                t = __builtin_amdgcn_mfma_f32_16x16x32_bf16(a, cf[kk], t, 0, 0, 0); } }
        cbt[st][0] = pk_bf16(t[0], t[1]); cbt[st][1] = pk_bf16(t[2], t[3]); }
    float ss = 0.f;
    bf16* gzrow = p.GZ + (size_t)(row0 + q) * D_INNER + g * GW + 4 * fq;
#pragma unroll 1
    for (int j = 0; j < 4; ++j) {
        const int head = g * 4 + j; const float aq = tA[j * 128 + q], dskip = p.ssm_d[head];
        const bf16* hp = p.HPREV + ((size_t)bc * SSD_HEADS + head) * (HEADDIM * D_STATE);
        bf16x8 hfa[4][4]; u32x2 zra[4];
#pragma unroll
        for (int pt = 0; pt < 4; ++pt) {
#pragma unroll
            for (int kk = 0; kk < 4; ++kk) hfa[pt][kk] = *(const bf16x8*)(hp + (16 * pt + fr) * D_STATE + 32 * kk + 8 * fq);
            zra[pt] = *(const u32x2*)(p.ZX + (size_t)(row0 + q) * ZXP + head * HEADDIM + 16 * pt + 4 * fq); }
        bf16x8 wf[4]; unsigned gvh[4][2];
#pragma unroll
        for (int kk = 0; kk < 4; ++kk) { unsigned pk[4];
            if (2 * kk <= w) {
                float v[8];
#pragma unroll
                for (int hh = 0; hh < 2; ++hh) { const int st = 2 * kk + hh; const int s0 = 16 * st + 4 * fq;
                    const f32x4 as = *(const LAS f32x4*)(tA + j * 128 + s0), ds = *(const LAS f32x4*)(tD + j * 128 + s0);
#pragma unroll
                    for (int i = 0; i < 4; ++i) { const int sidx = s0 + i; float x = 0.f; const unsigned cw2 = cbt[st][i >> 1]; const float cbv = __uint_as_float((i & 1) ? (cw2 & 0xffff0000u) : (cw2 << 16));
                        if (sidx <= q) x = cbv * __expf(aq - as[i]) * ds[i];
                        if (sidx == q) x += dskip;
                        v[hh * 4 + i] = x; } }
#pragma unroll
                for (int e = 0; e < 4; ++e) pk[e] = pk_bf16(v[2 * e], v[2 * e + 1]);
            } else { pk[0] = pk[1] = pk[2] = pk[3] = 0u; }
            wf[kk] = __builtin_bit_cast(bf16x8, (u32x4){pk[0], pk[1], pk[2], pk[3]}); }
        const float eaq = __expf(aq);
#pragma unroll
        for (int pt = 0; pt < 4; ++pt) {
            f32x4 yd = {0.f, 0.f, 0.f, 0.f}, yo = {0.f, 0.f, 0.f, 0.f};
#pragma unroll
            for (int kk = 0; kk < 4; ++kk) if (2 * kk <= w) {
                const LAS unsigned char* xr = lds + L_X + ((j * 64 + 16 * pt + fr) * PT + 32 * kk + 4 * fq) * 2;
                const u32x2 lo = *(const LAS u32x2*)xr, hi = *(const LAS u32x2*)(xr + 32);
                const bf16x8 a = __builtin_bit_cast(bf16x8, (u32x4){lo[0], lo[1], hi[0], hi[1]});
                yd = __builtin_amdgcn_mfma_f32_16x16x32_bf16(a, wf[kk], yd, 0, 0, 0); }
#pragma unroll
            for (int kk = 0; kk < 4; ++kk) { const bf16x8 c = *(const LAS bf16x8*)(lds + L_C + (q * PT + 32 * kk + 8 * fq) * 2); yo = __builtin_amdgcn_mfma_f32_16x16x32_bf16(hfa[pt][kk], c, yo, 0, 0, 0); }
            const u32x2 zr = zra[pt];
            const float z[4] = {__uint_as_float(zr[0] << 16), __uint_as_float(zr[0] & 0xffff0000u), __uint_as_float(zr[1] << 16), __uint_as_float(zr[1] & 0xffff0000u)};
            float vv[4];
#pragma unroll
            for (int i = 0; i < 4; ++i) { const float y = yd[i] + eaq * yo[i]; vv[i] = y * fast_silu(z[i]); ss += vv[i] * vv[i]; }
            gvh[pt][0] = pk_bf16(vv[0], vv[1]); gvh[pt][1] = pk_bf16(vv[2], vv[3]);
        }
        __syncthreads();
#pragma unroll
        for (int pt = 0; pt < 4; ++pt) *(LAS u32x2*)(lds + L_X + j * (HEADDIM * PT * 2) + w * 2048 + (pt * 64 + lane) * 8) = (u32x2){gvh[pt][0], gvh[pt][1]};
    }
    ss += lane_xor_f(ss, lane, 16); ss += lane_xor_f(ss, lane, 32);
    const float rn = 1.f / sqrtf(ss * (1.f / GW) + EPS);
#pragma unroll
    for (int j = 0; j < 4; ++j)
#pragma unroll
        for (int pt = 0; pt < 4; ++pt) { const f32x4 nw = *(const f32x4*)(p.ssm_norm_w + g * GW + 4 * fq + j * HEADDIM + 16 * pt);
            const u32x2 t = *(const LAS u32x2*)(lds + L_X + j * (HEADDIM * PT * 2) + w * 2048 + (pt * 64 + lane) * 8);
            const float v0 = __uint_as_float(t[0] << 16), v1 = __uint_as_float(t[0] & 0xffff0000u), v2 = __uint_as_float(t[1] << 16), v3 = __uint_as_float(t[1] & 0xffff0000u);
            u32x2 o; o[0] = pk_bf16(v0 * rn * nw[0], v1 * rn * nw[1]); o[1] = pk_bf16(v2 * rn * nw[2], v3 * rn * nw[3]);
            *(u32x2*)(gzrow + j * HEADDIM + 16 * pt) = o; }
    __syncthreads();
}
}

namespace att {
typedef short bf16x8 __attribute__((ext_vector_type(8)));
typedef short v4i16_t __attribute__((ext_vector_type(4)));
typedef float f32x4 __attribute__((ext_vector_type(4)));
typedef unsigned u32x4 __attribute__((ext_vector_type(4)));
typedef unsigned u32x2 __attribute__((ext_vector_type(2)));
constexpr int KP = 72;
constexpr int L_K = 0, L_V = 256 * KP * 2, L_END = 2 * 256 * KP * 2;
constexpr float LOG2E = 1.4426950408889634f;
constexpr int N_PUNITS = BATCH * 3 * ATTN_HPG * (SEQ / 128);
constexpr int N_SUNITS = DEC_BATCH * 13;
static_assert(L_END <= MISC_OFF_ && ATTN_HPG == 8 && AHD == 64 && DEC_SEQ == 8 && PAST_LEN >= 2048, "attention fast path geometry");
__device__ __forceinline__ unsigned pk_bf16(float lo, float hi) { return pk2bf(lo, hi); }
__device__ __forceinline__ v4i16_t tr_read(const LAS unsigned char* p) { return __builtin_amdgcn_ds_read_tr16_b64_v4i16((LAS v4i16_t*)p); }

struct PromptIn { u32x4 kv[4], vv[4]; bf16x8 qf[2]; };
__device__ __forceinline__ void prompt_issue(const P& p, int u, PromptIn& pi) {
    int tid = threadIdx.x; asm volatile("" : "+v"(tid));
    const int w = __builtin_amdgcn_readfirstlane(tid >> 6), lane = tid & 63, fr = lane & 15, fq = lane >> 4;
    const int blk = u & 31, h = (u >> 5) & 7, bg = u >> 8, g = bg % 3, b = bg / 3;
    const int dil = a_dil(g), nb = (SEQ / dil) / 128, r = blk / nb, m0 = 128 * (blk % nb);
    const size_t seqrow0 = (size_t)b * SEQ + r;
    const bf16* kbase = p.QKV + g * 3 * AW + AW + h * AHD;
#pragma unroll
    for (int i = 0; i < 4; ++i) { const int id = tid + NTHR_ * i, kr = id >> 3, ch = id & 7; int m = m0 - 128 + kr; m = m < 0 ? 0 : m;
        const bf16* src = kbase + (seqrow0 + (size_t)dil * m) * QKVW + ch * 8;
        pi.kv[i] = *(const u32x4*)src; pi.vv[i] = *(const u32x4*)(src + AW); }
    const size_t qrow = seqrow0 + (size_t)dil * (m0 + 16 * w + fr);
#pragma unroll
    for (int ks = 0; ks < 2; ++ks) pi.qf[ks] = *(const bf16x8*)(p.QKV + qrow * QKVW + g * 3 * AW + h * AHD + 32 * ks + 8 * fq);
}
__device__ __forceinline__ void prompt_phase(const P& p, int G, int bx, LAS unsigned char* lds) {
    PromptIn pi;
    int u = bx;
    if (u < N_PUNITS) prompt_issue(p, u, pi);
    for (; u < N_PUNITS; u += G) {
    int tid = threadIdx.x; asm volatile("" : "+v"(tid));
    const int w = __builtin_amdgcn_readfirstlane(tid >> 6), lane = tid & 63, fr = lane & 15, fq = lane >> 4;
    const int blk = u & 31, h = (u >> 5) & 7, bg = u >> 8, g = bg % 3, b = bg / 3;
    const int dil = a_dil(g), nb = (SEQ / dil) / 128, r = blk / nb, m0 = 128 * (blk % nb);
    const size_t seqrow0 = (size_t)b * SEQ + r;
#pragma unroll
    for (int i = 0; i < 4; ++i) { const int id = tid + NTHR_ * i, kr = id >> 3, ch = id & 7;
        *(LAS u32x4*)(lds + L_K + (kr * KP + ch * 8) * 2) = pi.kv[i]; *(LAS u32x4*)(lds + L_V + (kr * KP + ch * 8) * 2) = pi.vv[i]; }
    const size_t qrow = seqrow0 + (size_t)dil * (m0 + 16 * w + fr);
    bf16x8 qf[2]; qf[0] = pi.qf[0]; qf[1] = pi.qf[1];
    __syncthreads();
    if (u + G < N_PUNITS) prompt_issue(p, u + G, pi);
    f32x4 st[9];
#pragma unroll
    for (int kt = 0; kt < 9; ++kt) { st[kt] = (f32x4){0.f, 0.f, 0.f, 0.f};
#pragma unroll
        for (int ks = 0; ks < 2; ++ks) { const bf16x8 a = *(const LAS bf16x8*)(lds + L_K + ((16 * w + 16 * kt + fr) * KP + 32 * ks + 8 * fq) * 2);
            st[kt] = __builtin_amdgcn_mfma_f32_16x16x32_bf16(a, qf[ks], st[kt], 0, 0, 0); } }
    const float sl = exp2f(-8.f * (float)(g * ATTN_HPG + h + 1) / (float)NAH) * (float)dil * LOG2E;
    float mx = -1e30f;
#pragma unroll
    for (int kt = 0; kt < 9; ++kt)
#pragma unroll
        for (int i = 0; i < 4; ++i) { const int kr = 16 * w + 16 * kt + 4 * fq + i, j = 128 + 16 * w + fr - kr;
            const bool ok = j >= 0 && j <= 128 && (m0 - 128 + kr) >= 0;
            const float v = ok ? st[kt][i] * LOG2E - sl * (float)j : -1e30f; st[kt][i] = v; mx = fmaxf(mx, v); }
    mx = fmaxf(mx, lane_xor_f(mx, lane, 16)); mx = fmaxf(mx, lane_xor_f(mx, lane, 32));
    float l = 0.f;
#pragma unroll
    for (int kt = 0; kt < 9; ++kt)
#pragma unroll
        for (int i = 0; i < 4; ++i) { const float e = exp2f(st[kt][i] - mx); st[kt][i] = e; l += e; }
    l += lane_xor_f(l, lane, 16); l += lane_xor_f(l, lane, 32);
    bf16x8 pf[5];
#pragma unroll
    for (int kk = 0; kk < 5; ++kk) { u32x4 t; t[0] = pk_bf16(st[2 * kk][0], st[2 * kk][1]); t[1] = pk_bf16(st[2 * kk][2], st[2 * kk][3]);
        if (kk < 4) { t[2] = pk_bf16(st[2 * kk + 1][0], st[2 * kk + 1][1]); t[3] = pk_bf16(st[2 * kk + 1][2], st[2 * kk + 1][3]); } else { t[2] = 0u; t[3] = 0u; }
        pf[kk] = __builtin_bit_cast(bf16x8, t); }
    const float inv = 1.f / l;
    bf16* og = p.OG + ((size_t)g * M + qrow) * AW + h * AHD;
#pragma unroll
    for (int dt = 0; dt < 4; ++dt) { f32x4 acc = {0.f, 0.f, 0.f, 0.f};
#pragma unroll
        for (int kk = 0; kk < 5; ++kk) { const LAS unsigned char* vp = lds + L_V + ((16 * w + 32 * kk + 4 * fq + (fr >> 2)) * KP + 16 * dt + 4 * (fr & 3)) * 2;
            const v4i16_t lo = tr_read(vp); v4i16_t hi = {0, 0, 0, 0}; if (kk < 4) hi = tr_read(vp + 16 * KP * 2);
            const bf16x8 a = {lo[0], lo[1], lo[2], lo[3], hi[0], hi[1], hi[2], hi[3]};
            acc = __builtin_amdgcn_mfma_f32_16x16x32_bf16(a, pf[kk], acc, 0, 0, 0); }
        u32x2 o; o[0] = pk_bf16(acc[0] * inv, acc[1] * inv); o[1] = pk_bf16(acc[2] * inv, acc[3] * inv);
        *(u32x2*)(og + 16 * dt + 4 * fq) = o; }
    if (fq == 0) p.LSE[((size_t)g * M + qrow) * ATTN_HPG + h] = mx + log2f(l);
    __syncthreads();
    }
}
constexpr int L_P = 0;
__device__ __forceinline__ void sample_unit(const P& p, int u, LAS unsigned char* lds) {
    int tid = threadIdx.x; asm volatile("" : "+v"(tid));
    const int h = __builtin_amdgcn_readfirstlane(tid >> 6), lane = tid & 63, fr = lane & 15, fq = lane >> 4;
    const int b = u / 13, kind = u % 13;
    int g, NN, tok0, tstep, c0;
    if (kind == 0) { g = 0; NN = 8; tok0 = 0; tstep = 1; c0 = 0; } else if (kind < 5) { g = 1; NN = 2; tok0 = kind - 1; tstep = 4; c0 = kind - 1; } else { g = 2; NN = 1; tok0 = kind - 5; tstep = 1; c0 = kind - 5; }
    const int dil = a_dil(g), past = a_past(g);
    const float* cbase = cache_of(p, g) + ((size_t)b * past + c0) * 2 * AW + h * AHD;
    const bf16* nbase = p.QKV + ((size_t)MP + b * DEC_SEQ + tok0) * QKVW + g * 3 * AW + h * AHD;
    bf16x8 qf[2];
#pragma unroll
    for (int ks = 0; ks < 2; ++ks) { qf[ks] = (bf16x8){0, 0, 0, 0, 0, 0, 0, 0}; if (fr < NN) qf[ks] = *(const bf16x8*)(nbase + (size_t)tstep * fr * QKVW + 32 * ks + 8 * fq); }
    f32x4 st[9];
#pragma unroll
    for (int kt = 0; kt < 8; ++kt) { st[kt] = (f32x4){0.f, 0.f, 0.f, 0.f}; const float* kr = cbase + (size_t)dil * (16 * kt + fr) * 2 * AW + 8 * fq;
#pragma unroll
        for (int ks = 0; ks < 2; ++ks) { const f32x4 x0 = *(const f32x4*)(kr + 32 * ks), x1 = *(const f32x4*)(kr + 32 * ks + 4);
            u32x4 t; t[0] = pk_bf16(x0[0], x0[1]); t[1] = pk_bf16(x0[2], x0[3]); t[2] = pk_bf16(x1[0], x1[1]); t[3] = pk_bf16(x1[2], x1[3]);
            st[kt] = __builtin_amdgcn_mfma_f32_16x16x32_bf16(__builtin_bit_cast(bf16x8, t), qf[ks], st[kt], 0, 0, 0); } }
    { st[8] = (f32x4){0.f, 0.f, 0.f, 0.f};
#pragma unroll
      for (int ks = 0; ks < 2; ++ks) { bf16x8 a = {0, 0, 0, 0, 0, 0, 0, 0}; if (fr < NN) a = *(const bf16x8*)(nbase + (size_t)tstep * fr * QKVW + AW + 32 * ks + 8 * fq);
          st[8] = __builtin_amdgcn_mfma_f32_16x16x32_bf16(a, qf[ks], st[8], 0, 0, 0); } }
    const float sl = exp2f(-8.f * (float)(g * ATTN_HPG + h + 1) / (float)NAH) * (float)dil * LOG2E;
    float mx = -1e30f;
#pragma unroll
    for (int kt = 0; kt < 9; ++kt)
#pragma unroll
        for (int i = 0; i < 4; ++i) { const int n = 16 * kt + 4 * fq + i, j = 128 + fr - n; const bool ok = j >= 0 && j <= 128 && fr < NN;
            const float v = ok ? st[kt][i] * LOG2E - sl * (float)j : -1e30f; st[kt][i] = v; mx = fmaxf(mx, v); }
    mx = fmaxf(mx, lane_xor_f(mx, lane, 16)); mx = fmaxf(mx, lane_xor_f(mx, lane, 32));
    float l = 0.f;
#pragma unroll
    for (int kt = 0; kt < 9; ++kt)
#pragma unroll
        for (int i = 0; i < 4; ++i) { const float e = (fr < NN) ? exp2f(st[kt][i] - mx) : 0.f; st[kt][i] = e; l += e; }
    l += lane_xor_f(l, lane, 16); l += lane_xor_f(l, lane, 32);
    const float inv = (fr < NN) ? 1.f / l : 0.f;
    LAS float* Pl = (LAS float*)(lds + L_P) + h * (8 * 144);
    if (fr < 8) {
#pragma unroll
        for (int kt = 0; kt < 9; ++kt) *(LAS f32x4*)(Pl + fr * 144 + 16 * kt + 4 * fq) = st[kt] * inv; }
    if (fq == 0 && fr < NN) p.LSE[((size_t)g * M + MP + b * DEC_SEQ + tok0 + tstep * fr) * ATTN_HPG + h] = mx + log2f(l);
    asm volatile("s_waitcnt lgkmcnt(0)" ::: "memory");
    const int ks4 = lane >> 4, dq = lane & 15;
    f32x4 o[8];
#pragma unroll
    for (int iq = 0; iq < 8; ++iq) o[iq] = (f32x4){0.f, 0.f, 0.f, 0.f};
    const float* vb = cbase + AW + 4 * dq;
#pragma unroll 1
    for (int kb0 = 0; kb0 < 32; kb0 += 8) {
        f32x4 v[8];
#pragma unroll
        for (int x = 0; x < 8; ++x) v[x] = *(const f32x4*)(vb + (size_t)dil * (4 * (kb0 + x) + ks4) * 2 * AW);
#pragma unroll
        for (int x = 0; x < 8; ++x) { const int n = 4 * (kb0 + x) + ks4;
#pragma unroll
            for (int iq = 0; iq < 8; ++iq) if (iq < NN) o[iq] += v[x] * Pl[iq * 144 + n]; } }
#pragma unroll
    for (int kb = 32; kb < 34; ++kb) { const int n = 4 * kb + ks4, x = n - 128;
        if (x < NN) { const u32x2 r2 = *(const u32x2*)(nbase + (size_t)tstep * x * QKVW + 2 * AW + 4 * dq);
            const f32x4 v = {__uint_as_float(r2[0] << 16), __uint_as_float(r2[0] & 0xffff0000u), __uint_as_float(r2[1] << 16), __uint_as_float(r2[1] & 0xffff0000u)};
#pragma unroll
            for (int iq = 0; iq < 8; ++iq) if (iq < NN) o[iq] += v * Pl[iq * 144 + n]; } }
#pragma unroll
    for (int iq = 0; iq < 8; ++iq) if (iq < NN) {
#pragma unroll
        for (int e = 0; e < 4; ++e) { float t = o[iq][e]; t += lane_xor_f(t, lane, 16); t += lane_xor_f(t, lane, 32); o[iq][e] = t; }
        if (ks4 == 0) { u32x2 w2; w2[0] = pk_bf16(o[iq][0], o[iq][1]); w2[1] = pk_bf16(o[iq][2], o[iq][3]);
            *(u32x2*)(p.OG + ((size_t)g * M + MP + b * DEC_SEQ + tok0 + tstep * iq) * AW + h * AHD + 4 * dq) = w2; } }
    __syncthreads();
}
constexpr long N_MERGE = (long)M * ATTN_HPG * 8;
__device__ __forceinline__ void merge(const P& p, long i) {
    const int dc = (int)(i & 7), h = (int)((i >> 3) & 7); const size_t row = (size_t)(i >> 6);
    const float l0 = p.LSE[(0 * (size_t)M + row) * 8 + h], l1 = p.LSE[(1 * (size_t)M + row) * 8 + h], l2 = p.LSE[(2 * (size_t)M + row) * 8 + h];
    const float mx = fmaxf(l0, fmaxf(l1, l2)); float w0 = exp2f(l0 - mx), w1 = exp2f(l1 - mx), w2 = exp2f(l2 - mx); const float inv = 1.f / (w0 + w1 + w2); w0 *= inv; w1 *= inv; w2 *= inv;
    const size_t off = row * AW + h * AHD + dc * 8;
    const u32x4 a = *(const u32x4*)(p.OG + off), bq = *(const u32x4*)(p.OG + (size_t)M * AW + off), c = *(const u32x4*)(p.OG + 2 * (size_t)M * AW + off); u32x4 o;
#pragma unroll
    for (int e = 0; e < 4; ++e) { const float lo = w0 * __uint_as_float(a[e] << 16) + w1 * __uint_as_float(bq[e] << 16) + w2 * __uint_as_float(c[e] << 16);
        const float hi = w0 * __uint_as_float(a[e] & 0xffff0000u) + w1 * __uint_as_float(bq[e] & 0xffff0000u) + w2 * __uint_as_float(c[e] & 0xffff0000u); o[e] = pk_bf16(lo, hi); }
    *(u32x4*)(p.O + off) = o;
}
__device__ __forceinline__ void merge_phase(const P& p, int G, int bx) {
    int tid = threadIdx.x; asm volatile("" : "+v"(tid));
    const long stride = (long)G * 512;
    for (long i0 = (long)bx * 512 + tid; i0 < N_MERGE; i0 += 4 * stride) {
        float l[4][3]; u32x4 g[4][3]; size_t off[4]; bool ok[4];
#pragma unroll
        for (int q = 0; q < 4; ++q) { const long iq = i0 + q * stride; ok[q] = iq < N_MERGE; const long i = ok[q] ? iq : i0;
            const int dc = (int)(i & 7), h = (int)((i >> 3) & 7); const size_t row = (size_t)(i >> 6); off[q] = row * AW + h * AHD + dc * 8;
#pragma unroll
            for (int k = 0; k < 3; ++k) { l[q][k] = p.LSE[(k * (size_t)M + row) * 8 + h]; g[q][k] = *(const u32x4*)(p.OG + k * (size_t)M * AW + off[q]); } }
#pragma unroll
        for (int q = 0; q < 4; ++q) { const float mx = fmaxf(l[q][0], fmaxf(l[q][1], l[q][2])); float w0 = exp2f(l[q][0] - mx), w1 = exp2f(l[q][1] - mx), w2 = exp2f(l[q][2] - mx);
            const float inv = 1.f / (w0 + w1 + w2); w0 *= inv; w1 *= inv; w2 *= inv; u32x4 o;
#pragma unroll
            for (int e = 0; e < 4; ++e) { const float lo = w0 * __uint_as_float(g[q][0][e] << 16) + w1 * __uint_as_float(g[q][1][e] << 16) + w2 * __uint_as_float(g[q][2][e] << 16);
                const float hi = w0 * __uint_as_float(g[q][0][e] & 0xffff0000u) + w1 * __uint_as_float(g[q][1][e] & 0xffff0000u) + w2 * __uint_as_float(g[q][2][e] & 0xffff0000u); o[e] = pk_bf16(lo, hi); }
            if (ok[q]) *(u32x4*)(p.O + off[q]) = o; }
    }
}
}

namespace misc {
typedef float f32x4 __attribute__((ext_vector_type(4)));
typedef unsigned u32x4 __attribute__((ext_vector_type(4)));
typedef unsigned u32x2 __attribute__((ext_vector_type(2)));
__device__ __forceinline__ unsigned pk_bf16(float lo, float hi) { return pk2bf(lo, hi); }
template <int KIND> __device__ __forceinline__ void convert_w(const P& p, LAS unsigned char* lds, int ls, int wi, int nw) {
    constexpr int K = KIND == 1 ? D_FF : KIND == 3 ? D_INNER : KIND == 5 ? AW : D_MODEL;
    constexpr int N = KIND == 0 ? 2 * D_FF : KIND == 2 ? D_IN_PROJ : KIND == 4 ? QKVW : D_MODEL;
    constexpr int NBLK = N / 32, NIT = (K / 64) * NBLK; constexpr bool HAS_GAIN = KIND == 0 || KIND == 2 || KIND == 4;
    static_assert(N % 32 == 0 && K % 64 == 0, "item geometry");
    const float* W; bf16* WT; const float* gain = p.norm_w;
    if constexpr (KIND == 0) { W = p.w_ffn_in + (size_t)ls * D_MODEL * 2 * D_FF; WT = p.WFI + (size_t)ls * 2 * D_FF * D_MODEL; gain = p.norm_w + ((ls >> 1) * 3 + ((ls & 1) ? 2 : 0)) * D_MODEL; }
    else if constexpr (KIND == 1) { W = p.w_ffn_out + (size_t)ls * D_FF * D_MODEL; WT = p.WFO + (size_t)ls * D_MODEL * D_FF; }
    else if constexpr (KIND == 2) { W = p.ssm_w_in; WT = p.WSI; gain = p.norm_w + (0 * 3 + 1) * D_MODEL; }
    else if constexpr (KIND == 3) { W = p.ssm_w_out; WT = p.WSO; }
    else if constexpr (KIND == 4) { W = p.attn_w_qkv; WT = p.WQKV; gain = p.norm_w + (1 * 3 + 1) * D_MODEL; }
    else { W = p.attn_w_o; WT = p.WO; }
    int tid = threadIdx.x; asm volatile("" : "+v"(tid));
    const int w = __builtin_amdgcn_readfirstlane(tid >> 6), lane = tid & 63; LAS float* scr = (LAS float*)(lds + w * 16384);
    const int lh = lane >> 5, ln = lane & 31, c = lane & 7;
    float t[32];
    int it = wi;
    if (it < NIT) { const int kb = it / NBLK, nb = it % NBLK;
#pragma unroll
        for (int i = 0; i < 32; ++i) t[i] = W[(size_t)(64 * kb + 2 * i + lh) * N + 32 * nb + ln]; }
    while (it < NIT) {
        const int nx = it + nw; float tn[32];
        if (nx < NIT) { const int kb = nx / NBLK, nb = nx % NBLK;
#pragma unroll
            for (int i = 0; i < 32; ++i) tn[i] = W[(size_t)(64 * kb + 2 * i + lh) * N + 32 * nb + ln]; }
        const int kb = it / NBLK, nb = it % NBLK, k0 = 64 * kb, n0 = 32 * nb;
        int orow = n0; float cs = 1.f;
        if constexpr (KIND == 0) orow = n0 < D_FF ? 256 * (n0 / 128) + n0 % 128 : 256 * ((n0 - D_FF) / 128) + 128 + (n0 - D_FF) % 128;
        if constexpr (KIND == 1) cs = 0.5f;
        if constexpr (KIND == 4) cs = (n0 / AW) % 3 == 0 ? 0.125f : 1.f;
#pragma unroll
        for (int i = 0; i < 32; ++i) scr[(2 * i + lh) * 33 + ln] = t[i];
        asm volatile("s_waitcnt lgkmcnt(0)" ::: "memory");
        float gk[8];
#pragma unroll
        for (int e = 0; e < 8; ++e) gk[e] = (HAS_GAIN ? gain[k0 + 8 * c + e] : 1.f) * cs;
#pragma unroll
        for (int j = 0; j < 4; ++j) { const int n = (lane >> 3) + 8 * j; const LAS float* sp = scr + (8 * c) * 33 + n;
            u32x4 o; o[0] = pk_bf16(sp[0 * 33] * gk[0], sp[1 * 33] * gk[1]); o[1] = pk_bf16(sp[2 * 33] * gk[2], sp[3 * 33] * gk[3]); o[2] = pk_bf16(sp[4 * 33] * gk[4], sp[5 * 33] * gk[5]); o[3] = pk_bf16(sp[6 * 33] * gk[6], sp[7 * 33] * gk[7]);
            *(u32x4*)(WT + (size_t)(orow + n) * K + k0 + 8 * c) = o; }
        asm volatile("s_waitcnt lgkmcnt(0)" ::: "memory");
#pragma unroll
        for (int i = 0; i < 32; ++i) t[i] = tn[i];
        it = nx;
    }
}
template <int KIND> __device__ __forceinline__ void convert_in_tail(const P& p, LAS unsigned char* lds, int ls, int n_units, int G, int bx) {
    int tid = threadIdx.x; asm volatile("" : "+v"(tid)); const int w = __builtin_amdgcn_readfirstlane(tid >> 6);
    const int nb = n_units % G; if (nb && bx < nb) return;
    const int idx = nb ? bx - nb : bx, cnt = nb ? G - nb : G;
    convert_w<KIND>(p, lds, ls, idx * NWAVES_ + w, cnt * NWAVES_);
}
__device__ __forceinline__ void prologue(const P& p, LAS unsigned char* lds, int G, int bx) {
    int tid = threadIdx.x; asm volatile("" : "+v"(tid));
    const int w = __builtin_amdgcn_readfirstlane(tid >> 6), lane = tid & 63;
    const int gw = bx * NWAVES_ + w, NGW = G * NWAVES_;
    convert_w<0>(p, lds, 0, gw, NGW); convert_w<2>(p, lds, 0, gw, NGW);
    { const long nz = (long)(NSI - D_IN_PROJ) * D_MODEL / 8; u32x4* z = (u32x4*)(p.WSI + (size_t)D_IN_PROJ * D_MODEL);
        for (long i = (long)bx * NTHR_ + tid; i < nz; i += (long)G * NTHR_) z[i] = (u32x4){0u, 0u, 0u, 0u}; }
    for (int row = gw; row < M; row += NGW) {
        const float* src = row < MP ? p.x_prompt + (size_t)row * D_MODEL : p.x_sample + (size_t)(row - MP) * D_MODEL; float s = 0.f;
#pragma unroll
        for (int j = 0; j < 4; ++j) { const f32x4 v = *(const f32x4*)(src + 256 * j + 4 * lane); s += (v[0] * v[0] + v[1] * v[1]) + (v[2] * v[2] + v[3] * v[3]);
            u32x2 o; o[0] = pk_bf16(v[0], v[1]); o[1] = pk_bf16(v[2], v[3]); *(u32x2*)(p.XB + (size_t)row * D_MODEL + 256 * j + 4 * lane) = o; }
        s += lane_xor_f(s, lane, 1); s += lane_xor_f(s, lane, 2);
        if ((lane & 3) == 0) p.SS[(size_t)row * NSS + (lane >> 2)] = s; }
}
constexpr int S_LAST = 11;
__device__ __forceinline__ void final_norm(const P& p, LAS unsigned char* lds, int G, int bx) {
    int tid = threadIdx.x; asm volatile("" : "+v"(tid));
    const int w = __builtin_amdgcn_readfirstlane(tid >> 6), lane = tid & 63; const int gw = bx * NWAVES_ + w, NGW = G * NWAVES_;
    f32x4 nf[4];
#pragma unroll
    for (int j = 0; j < 4; ++j) nf[j] = *(const f32x4*)(p.norm_f + 256 * j + 4 * lane);
    LAS float* hs = (LAS float*)lds;
    for (int r4 = bx * 4; r4 < MS; r4 += G * 4) { const int r = r4 + (w >> 1), hf = w & 1; const size_t go = ((size_t)MP + r) * D_MODEL; f32x4 v[2]; float s = 0.f;
        u32x2 h[2], l[2]; f32x4 pv[2][S_LAST];
#pragma unroll
        for (int jj = 0; jj < 2; ++jj) { const size_t o = 256 * (2 * hf + jj) + 4 * lane; h[jj] = *(const u32x2*)(p.XB + go + o); l[jj] = *(const u32x2*)(p.XLO + go + o);
#pragma unroll
            for (int k = 0; k < S_LAST; ++k) pv[jj][k] = *(const f32x4*)(p.PART + ((size_t)k * MS + r) * D_MODEL + o); }
#pragma unroll
        for (int jj = 0; jj < 2; ++jj) { v[jj] = join4(h[jj][0], h[jj][1], l[jj][0], l[jj][1]);
#pragma unroll
            for (int k = 0; k < S_LAST; ++k) v[jj] += pv[jj][k];
            s += (v[jj][0] * v[jj][0] + v[jj][1] * v[jj][1]) + (v[jj][2] * v[jj][2] + v[jj][3] * v[jj][3]); }
#pragma unroll
        for (int o = 1; o < 64; o <<= 1) s += lane_xor_f(s, lane, o);
        if (lane == 0) hs[w] = s;
        __syncthreads();
        const float rr = 1.f / sqrtf((hs[w & ~1] + hs[w | 1]) * (1.f / D_MODEL) + EPS);
        __syncthreads();
#pragma unroll
        for (int jj = 0; jj < 2; ++jj) *(f32x4*)(p.y_sample + (size_t)r * D_MODEL + 256 * (2 * hf + jj) + 4 * lane) = v[jj] * rr * nf[2 * hf + jj]; }
    for (int row0 = gw; row0 < MP; row0 += 2 * NGW) {
        const bool two = row0 + NGW < MP; const int row1 = two ? row0 + NGW : row0;
        f32x4 q0[4], q1[4]; u32x2 h0[4], l0[4], h1[4], l1[4];
#pragma unroll
        for (int j = 0; j < 4; ++j) { q0[j] = *(const f32x4*)(p.SS + (size_t)row0 * NSS + 4 * j); q1[j] = *(const f32x4*)(p.SS + (size_t)row1 * NSS + 4 * j); }
#pragma unroll
        for (int j = 0; j < 4; ++j) { const size_t g0 = (size_t)row0 * D_MODEL + 256 * j + 4 * lane, g1 = (size_t)row1 * D_MODEL + 256 * j + 4 * lane;
            h0[j] = *(const u32x2*)(p.XB + g0); l0[j] = *(const u32x2*)(p.XLO + g0); h1[j] = *(const u32x2*)(p.XB + g1); l1[j] = *(const u32x2*)(p.XLO + g1); }
        float s0 = 0.f, s1 = 0.f;
#pragma unroll
        for (int j = 0; j < 4; ++j) { s0 += (q0[j][0] + q0[j][1]) + (q0[j][2] + q0[j][3]); s1 += (q1[j][0] + q1[j][1]) + (q1[j][2] + q1[j][3]); }
        const float r0 = 1.f / sqrtf(s0 * (1.f / D_MODEL) + EPS), r1 = 1.f / sqrtf(s1 * (1.f / D_MODEL) + EPS);
        float* out0 = p.y_prompt + (size_t)row0 * D_MODEL; float* out1 = p.y_prompt + (size_t)row1 * D_MODEL;
#pragma unroll
        for (int j = 0; j < 4; ++j) *(f32x4*)(out0 + 256 * j + 4 * lane) = join4(h0[j][0], h0[j][1], l0[j][0], l0[j][1]) * r0 * nf[j];
        if (two) {
#pragma unroll
            for (int j = 0; j < 4; ++j) *(f32x4*)(out1 + 256 * j + 4 * lane) = join4(h1[j][0], h1[j][1], l1[j][0], l1[j][1]) * r1 * nf[j]; } }
}
constexpr int LS_XS = 0, LS_Y = 16384, LS_DT = 24576, LS_DA = LS_DT + 128;
struct SampIn { float cw[4], bias, hs[3], dt, al; bf16 zx[8]; };
__device__ __forceinline__ void samp_issue(const P& p, int u, SampIn& si) {
    int tid = threadIdx.x; asm volatile("" : "+v"(tid));
    const int b = u / SSD_GROUPS, g = u % SSD_GROUPS; const int row0 = MP + b * DEC_SEQ;
    const int c = tid; const int chb = c < 256 ? g * GW + c : (c < 384 ? D_INNER + g * D_STATE + (c - 256) : D_INNER + SSD_GROUPS * D_STATE + g * D_STATE + (c - 384));
#pragma unroll
    for (int k = 0; k < 4; ++k) si.cw[k] = p.ssm_conv_w[k * CONV_DIM + chb];
    si.bias = p.ssm_conv_b[chb];
#pragma unroll
    for (int k = 0; k < 3; ++k) si.hs[k] = p.state_conv[((size_t)b * 3 + k) * CONV_DIM + chb];
#pragma unroll
    for (int t = 0; t < DEC_SEQ; ++t) si.zx[t] = p.ZX[(size_t)(row0 + t) * ZXP + D_INNER + chb];
    si.dt = 0.f; si.al = 0.f;
    if (tid < 32) { const int t = tid >> 2, j = tid & 3, head = g * 4 + j; si.dt = p.DT[(size_t)(row0 + t) * SSD_HEADS + head]; si.al = p.ssm_a_log[head]; }
}
__device__ __forceinline__ const float* samp_sbase(const P& p, int u) {
    int tid = threadIdx.x; asm volatile("" : "+v"(tid));
    const int w = __builtin_amdgcn_readfirstlane(tid >> 6), lane = tid & 63, nq = lane & 31, psel = lane >> 5; const int b = u / SSD_GROUPS, g = u % SSD_GROUPS;
    return p.state_ssm + (((size_t)b * SSD_HEADS + g * 4) * HEADDIM + 2 * w + psel) * D_STATE + 4 * nq;
}
__device__ __forceinline__ void ssd_sample_phase(const P& p, int G, int bx, LAS unsigned char* lds) {
    constexpr int NU = DEC_BATCH * SSD_GROUPS;
    LAS float* xs = (LAS float*)(lds + LS_XS); LAS float* Yl = (LAS float*)(lds + LS_Y); LAS float* tdt = (LAS float*)(lds + LS_DT); LAS float* tda = (LAS float*)(lds + LS_DA);
    SampIn si; f32x4 hn[4];
    int u = bx;
    if (u < NU) { samp_issue(p, u, si); const float* sb0 = samp_sbase(p, u);
#pragma unroll
        for (int ps = 0; ps < 4; ++ps) hn[ps] = *(const f32x4*)(sb0 + (size_t)(16 * ps) * D_STATE); }
    for (; u < NU; u += G) {
    int tid = threadIdx.x; asm volatile("" : "+v"(tid));
    const int w = __builtin_amdgcn_readfirstlane(tid >> 6), lane = tid & 63; const int b = u / SSD_GROUPS, g = u % SSD_GROUPS; const int row0 = MP + b * DEC_SEQ;
    const int un = u + G;
    { const int c = tid; float h0 = si.hs[0], h1 = si.hs[1], h2 = si.hs[2];
#pragma unroll
        for (int t = 0; t < DEC_SEQ; ++t) { const float cur = bf2f(si.zx[t]); const float a = si.bias + si.cw[0] * h0 + si.cw[1] * h1 + si.cw[2] * h2 + si.cw[3] * cur;
            xs[t * 512 + c] = a / (1.f + __expf(-a)); h0 = h1; h1 = h2; h2 = cur; } }
    if (tid < 32) { const int t = tid >> 2, j = tid & 3; tdt[t * 4 + j] = si.dt; tda[t * 4 + j] = __expf(-si.dt * expf(si.al)); }
    if (un < NU) samp_issue(p, un, si);
    __syncthreads();
    const int nq = lane & 31, psel = lane >> 5;
    f32x4 Bv[8], Cv[8];
#pragma unroll
    for (int t = 0; t < 8; ++t) { Bv[t] = *(const LAS f32x4*)(xs + t * 512 + 256 + 4 * nq); Cv[t] = *(const LAS f32x4*)(xs + t * 512 + 384 + 4 * nq); }
    const float* sbase = samp_sbase(p, u);
    f32x4 hv[4];
#pragma unroll 1
    for (int j = 0; j < 4; ++j) { const int head = g * 4 + j; const float dsk = p.ssm_d[head];
#pragma unroll
        for (int ps = 0; ps < 4; ++ps) hv[ps] = hn[ps];
        if (j < 3) {
#pragma unroll
            for (int ps = 0; ps < 4; ++ps) hn[ps] = *(const f32x4*)(sbase + (size_t)((j + 1) * HEADDIM + 16 * ps) * D_STATE);
        } else if (un < NU) { const float* sbn = samp_sbase(p, un);
#pragma unroll
            for (int ps = 0; ps < 4; ++ps) hn[ps] = *(const f32x4*)(sbn + (size_t)(16 * ps) * D_STATE); }
#pragma unroll
        for (int ps = 0; ps < 4; ++ps) { const int pidx = 16 * ps + 2 * w + psel; f32x4 h = hv[ps]; float y[8];
#pragma unroll
            for (int t = 0; t < 8; ++t) { const float coef = tdt[t * 4 + j] * xs[t * 512 + j * 64 + pidx]; h = h * tda[t * 4 + j] + Bv[t] * coef;
                y[t] = (Cv[t][0] * h[0] + Cv[t][1] * h[1]) + (Cv[t][2] * h[2] + Cv[t][3] * h[3]); }
            *(f32x4*)(p.ssm_sample + (((size_t)b * SSD_HEADS + head) * HEADDIM + pidx) * D_STATE + 4 * nq) = h;
            float r4[4], r2[2], r1;
            { const bool up = (lane & 16) != 0;
#pragma unroll
              for (int k = 0; k < 4; ++k) { const float keep = up ? y[4 + k] : y[k], give = up ? y[k] : y[4 + k]; r4[k] = keep + lane_xor_f(give, lane, 16); } }
            { const bool up = (lane & 8) != 0;
#pragma unroll
              for (int k = 0; k < 2; ++k) { const float keep = up ? r4[2 + k] : r4[k], give = up ? r4[k] : r4[2 + k]; r2[k] = keep + lane_xor_f(give, lane, 8); } }
            { const bool up = (lane & 4) != 0; const float keep = up ? r2[1] : r2[0], give = up ? r2[0] : r2[1]; r1 = keep + lane_xor_f(give, lane, 4); }
            r1 += lane_xor_f(r1, lane, 2); r1 += lane_xor_f(r1, lane, 1);
            if ((lane & 3) == 0) { const int t = ((lane >> 4) & 1) * 4 + ((lane >> 3) & 1) * 2 + ((lane >> 2) & 1); Yl[t * 256 + j * 64 + pidx] = r1 + dsk * xs[t * 512 + j * 64 + pidx]; } } }
    __syncthreads();
    { const int t = w, c = 4 * lane; const size_t row = (size_t)(row0 + t);
        const u32x2 zr = *(const u32x2*)(p.ZX + row * ZXP + g * GW + c);
        const float z[4] = {__uint_as_float(zr[0] << 16), __uint_as_float(zr[0] & 0xffff0000u), __uint_as_float(zr[1] << 16), __uint_as_float(zr[1] & 0xffff0000u)};
        const f32x4 yv = *(const LAS f32x4*)(Yl + t * 256 + c); float v[4], ss = 0.f;
#pragma unroll
        for (int e = 0; e < 4; ++e) { v[e] = yv[e] * (z[e] / (1.f + __expf(-z[e]))); ss += v[e] * v[e]; }
#pragma unroll
        for (int o = 1; o < 64; o <<= 1) ss += lane_xor_f(ss, lane, o);
        const float rn = 1.f / sqrtf(ss * (1.f / GW) + EPS); const f32x4 nw = *(const f32x4*)(p.ssm_norm_w + g * GW + c);
        u32x2 o2; o2[0] = pk_bf16(v[0] * rn * nw[0], v[1] * rn * nw[1]); o2[1] = pk_bf16(v[2] * rn * nw[2], v[3] * rn * nw[3]);
        *(u32x2*)(p.GZ + row * D_INNER + g * GW + c) = o2; }
    __syncthreads();
    }
}

template <int S> __device__ __forceinline__ void splitk_fixup_s(const P& p, int G, int bx, int first) {
    int tid = threadIdx.x; asm volatile("" : "+v"(tid));
    const int w = __builtin_amdgcn_readfirstlane(tid >> 6), lane = tid & 63; const int gw = bx * NWAVES_ + w, NGW = G * NWAVES_;
    for (int it0 = gw; it0 < MS * 4; it0 += 2 * NGW) {
        const bool two = it0 + NGW < MS * 4; const int it1 = two ? it0 + NGW : it0;
        const int r0 = it0 >> 2, j0 = it0 & 3, r1 = it1 >> 2, j1 = it1 & 3;
        const size_t go0 = ((size_t)MP + r0) * D_MODEL + 256 * j0 + 4 * lane, go1 = ((size_t)MP + r1) * D_MODEL + 256 * j1 + 4 * lane;
        f32x4 pa[S], pb[S], va, vb;
#pragma unroll
        for (int k = 0; k < S; ++k) { pa[k] = *(const f32x4*)(p.PART + ((size_t)k * MS + r0) * D_MODEL + 256 * j0 + 4 * lane); pb[k] = *(const f32x4*)(p.PART + ((size_t)k * MS + r1) * D_MODEL + 256 * j1 + 4 * lane); }
        if (first) { va = *(const f32x4*)(p.x_sample + (size_t)r0 * D_MODEL + 256 * j0 + 4 * lane); vb = *(const f32x4*)(p.x_sample + (size_t)r1 * D_MODEL + 256 * j1 + 4 * lane); }
        else { const u32x2 h0 = *(const u32x2*)(p.XB + go0), l0 = *(const u32x2*)(p.XLO + go0), h1 = *(const u32x2*)(p.XB + go1), l1 = *(const u32x2*)(p.XLO + go1);
               va = join4(h0[0], h0[1], l0[0], l0[1]); vb = join4(h1[0], h1[1], l1[0], l1[1]); }
#pragma unroll
        for (int k = 0; k < S; ++k) { va += pa[k]; vb += pb[k]; }
        float sa = (va[0] * va[0] + va[1] * va[1]) + (va[2] * va[2] + va[3] * va[3]), sb = (vb[0] * vb[0] + vb[1] * vb[1]) + (vb[2] * vb[2] + vb[3] * vb[3]);
        u32x2 oh, ol; SPLIT2(va[0], va[1], oh[0], ol[0]); SPLIT2(va[2], va[3], oh[1], ol[1]); *(u32x2*)(p.XB + go0) = oh; *(u32x2*)(p.XLO + go0) = ol;
        if (two) { SPLIT2(vb[0], vb[1], oh[0], ol[0]); SPLIT2(vb[2], vb[3], oh[1], ol[1]); *(u32x2*)(p.XB + go1) = oh; *(u32x2*)(p.XLO + go1) = ol; }
        sa += lane_xor_f(sa, lane, 1); sb += lane_xor_f(sb, lane, 1); sa += lane_xor_f(sa, lane, 2); sb += lane_xor_f(sb, lane, 2);
        sa += lane_xor_f(sa, lane, 4); sb += lane_xor_f(sb, lane, 4); sa += lane_xor_f(sa, lane, 8); sb += lane_xor_f(sb, lane, 8);
        if ((lane & 15) == 0) { p.SS[((size_t)MP + r0) * NSS + 4 * j0 + (lane >> 4)] = sa; if (two) p.SS[((size_t)MP + r1) * NSS + 4 * j1 + (lane >> 4)] = sb; } }
}
__device__ __forceinline__ void splitk_fixup(const P& p, int S, int G, int bx, int first) {
    if (S == 11) splitk_fixup_s<11>(p, G, bx, first); else if (S == 8) splitk_fixup_s<8>(p, G, bx, first); else splitk_fixup_s<4>(p, G, bx, first);
}
}

constexpr int NWAVES = 8, NTHR = NWAVES * 64;
constexpr int RING_BYTES = 131072, LDS_BYTES = 163840, MISC_OFF = MISC_OFF_;
#ifndef FAST_SSD
#define FAST_SSD 1
#endif
#ifndef FAST_ATTN
#define FAST_ATTN 1
#endif
#ifndef FAST_MISC
#define FAST_MISC 1
#endif
#ifndef MK_PER_PHASE
#define MK_PER_PHASE 0
#endif
constexpr int CW_BAR = 4096;

constexpr size_t al4k(size_t x) { return (x + 4095) & ~(size_t)4095; }
constexpr size_t CTL_BYTES = 1u << 15;
constexpr size_t OO_y_prompt = 0;
constexpr size_t OO_y_sample = OO_y_prompt + (size_t)MP * D_MODEL;
constexpr size_t OO_conv_prompt = OO_y_sample + (size_t)MS * D_MODEL;
constexpr size_t OO_conv_sample = OO_conv_prompt + (size_t)BATCH * (CONV_W - 1) * CONV_DIM;
constexpr size_t OO_ssm_prompt = OO_conv_sample + (size_t)DEC_BATCH * (CONV_W - 1) * CONV_DIM;
constexpr size_t OO_ssm_sample = OO_ssm_prompt + (size_t)BATCH * SSD_HEADS * HEADDIM * D_STATE;
constexpr size_t OO_kvp0 = OO_ssm_sample + (size_t)DEC_BATCH * SSD_HEADS * HEADDIM * D_STATE;
constexpr size_t OO_kvs0 = OO_kvp0 + (size_t)BATCH * 128 * 2 * AW;
constexpr size_t OO_kvp1 = OO_kvs0 + (size_t)MS * 2 * AW;
constexpr size_t OO_kvs1 = OO_kvp1 + (size_t)BATCH * 512 * 2 * AW;
constexpr size_t OO_kvp2 = OO_kvs1 + (size_t)MS * 2 * AW;
constexpr size_t OO_kvs2 = OO_kvp2 + (size_t)BATCH * 2048 * 2 * AW;
constexpr size_t OUT_ELEMS = OO_kvs2 + (size_t)MS * 2 * AW;
constexpr size_t WO_ctl = 0;
constexpr size_t WO_WFI = WO_ctl + al4k(CTL_BYTES);
constexpr size_t WO_WFO = WO_WFI + al4k((size_t)N_WFI * 2);
constexpr size_t WO_WSI = WO_WFO + al4k((size_t)N_WFO * 2);
constexpr size_t WO_WSO = WO_WSI + al4k((size_t)N_WSI * 2);
constexpr size_t WO_WQKV = WO_WSO + al4k((size_t)N_WSO * 2);
constexpr size_t WO_WO = WO_WQKV + al4k((size_t)N_WQKV * 2);
constexpr size_t WO_X = WO_WO + al4k((size_t)N_WO * 2);
constexpr size_t WO_XB = WO_X + al4k((size_t)M * D_MODEL * 4);
constexpr size_t WO_SS = WO_XB + al4k((size_t)M * D_MODEL * 2);
constexpr size_t WO_H = WO_SS + al4k((size_t)M * NSS * 4);
constexpr size_t WO_ZX = WO_H + al4k((size_t)M * D_FF * 2);
constexpr size_t WO_DT = WO_ZX + al4k((size_t)M * ZXP * 2);
constexpr size_t WO_STATES = WO_DT + al4k((size_t)M * SSD_HEADS * 4);
constexpr size_t WO_HPREV = WO_STATES + al4k((size_t)N_STATES * 4);
constexpr size_t WO_CDEC = WO_HPREV + al4k((size_t)N_STATES * 2);
constexpr size_t WO_GZ = WO_CDEC + al4k((size_t)BATCH * NCHUNK * SSD_HEADS * 4);
constexpr size_t WO_QKV = WO_GZ + al4k((size_t)M * D_INNER * 2);
constexpr size_t WO_O = WO_QKV + al4k((size_t)M * QKVW * 2);
constexpr size_t WO_OG = WO_O + al4k((size_t)M * AW * 2);
constexpr size_t WO_LSE = WO_OG + al4k((size_t)3 * M * AW * 2);
constexpr size_t WO_PART = WO_LSE + al4k((size_t)3 * M * ATTN_HPG * 4);
constexpr size_t WS_NEED = WO_PART + al4k((size_t)16 * MS * D_MODEL * 4);
struct KArgs { const float* x_prompt; const float* x_sample; const float* state_conv; const float* state_ssm; const float* cache0; const float* cache1; const float* cache2; const float* norm_w; const float* w_ffn_in; const float* w_ffn_out; const float* ssm_w_in; const float* ssm_conv_w; const float* ssm_conv_b; const float* ssm_dt_bias; const float* ssm_a_log; const float* ssm_d; const float* ssm_norm_w; const float* ssm_w_out; const float* attn_w_qkv; const float* attn_w_o; const float* norm_f; float* out; unsigned char* ws; int ph_lo, ph_hi; };
__device__ __forceinline__ P make_p(const KArgs& a) { P p;
    size_t z = 0; asm volatile("" : "+s"(z));
    p.x_prompt = a.x_prompt + z;
    p.x_sample = a.x_sample + z;
    p.state_conv = a.state_conv + z;
    p.state_ssm = a.state_ssm + z;
    p.cache0 = a.cache0 + z;
    p.cache1 = a.cache1 + z;
    p.cache2 = a.cache2 + z;
    p.norm_w = a.norm_w + z;
    p.w_ffn_in = a.w_ffn_in + z;
    p.w_ffn_out = a.w_ffn_out + z;
    p.ssm_w_in = a.ssm_w_in + z;
    p.ssm_conv_w = a.ssm_conv_w + z;
    p.ssm_conv_b = a.ssm_conv_b + z;
    p.ssm_dt_bias = a.ssm_dt_bias + z;
    p.ssm_a_log = a.ssm_a_log + z;
    p.ssm_d = a.ssm_d + z;
    p.ssm_norm_w = a.ssm_norm_w + z;
    p.ssm_w_out = a.ssm_w_out + z;
    p.attn_w_qkv = a.attn_w_qkv + z;
    p.attn_w_o = a.attn_w_o + z;
    p.norm_f = a.norm_f + z;
    float* out = a.out + z; unsigned char* ws = a.ws + z;
    p.y_prompt = out + OO_y_prompt;
    p.y_sample = out + OO_y_sample;
    p.conv_prompt = out + OO_conv_prompt;
    p.conv_sample = out + OO_conv_sample;
    p.ssm_prompt = out + OO_ssm_prompt;
    p.ssm_sample = out + OO_ssm_sample;
    p.kvp0 = out + OO_kvp0;
    p.kvs0 = out + OO_kvs0;
    p.kvp1 = out + OO_kvp1;
    p.kvs1 = out + OO_kvs1;
    p.kvp2 = out + OO_kvp2;
    p.kvs2 = out + OO_kvs2;
    p.ctl = (unsigned*)(ws + WO_ctl);
    p.WFI = (bf16*)(ws + WO_WFI);
    p.WFO = (bf16*)(ws + WO_WFO);
    p.WSI = (bf16*)(ws + WO_WSI);
    p.WSO = (bf16*)(ws + WO_WSO);
    p.WQKV = (bf16*)(ws + WO_WQKV);
    p.WO = (bf16*)(ws + WO_WO);
    p.X = nullptr; p.XLO = (bf16*)(ws + WO_X);
    p.XB = (bf16*)(ws + WO_XB);
    p.SS = (float*)(ws + WO_SS);
    p.H = (bf16*)(ws + WO_H);
    p.ZX = (bf16*)(ws + WO_ZX);
    p.DT = (float*)(ws + WO_DT);
    p.STATES = (float*)(ws + WO_STATES);
    p.HPREV = (bf16*)(ws + WO_HPREV);
    p.CDEC = (float*)(ws + WO_CDEC);
    p.GZ = (bf16*)(ws + WO_GZ);
    p.QKV = (bf16*)(ws + WO_QKV);
    p.O = (bf16*)(ws + WO_O);
    p.OG = (bf16*)(ws + WO_OG);
    p.LSE = (float*)(ws + WO_LSE);
    p.PART = (float*)(ws + WO_PART);
    p.ACUM = nullptr; p.XC = nullptr; p.Y = nullptr;
    p.cd1 = (const char*)a.cache1 - (const char*)a.cache0; p.cd2 = (const char*)a.cache2 - (const char*)a.cache0;
    return p; }

#define GRID_STRIDE(N, CALL) do { const long _n = (long)(N); int _t0 = threadIdx.x; asm volatile("" : "+v"(_t0));     \
    for (long i = (long)blockIdx.x * NTHR + _t0; i < _n; i += (long)gridDim.x * NTHR) { CALL; } } while (0)

__global__ void __launch_bounds__(NTHR, 2) mega_fwd(KArgs args) {
    extern __shared__ __attribute__((aligned(16))) unsigned char lds[];
    LAS unsigned char* ldsp = (LAS unsigned char*)lds;
    volatile LAS unsigned* MISC = (volatile LAS unsigned*)(ldsp + MISC_OFF + 512);
    { const int tid = threadIdx.x;
      for (int u = tid; u < (LDS_BYTES - MISC_OFF) / 4; u += NTHR) ((LAS unsigned*)(ldsp + MISC_OFF))[u] = 0u;
      __syncthreads();
      __syncthreads(); }
    XcdBarrier bar; bar.bar = (unsigned*)(args.ws + WO_ctl) + CW_BAR; bar.x = 0; bar.st = nullptr;
    if (!MK_PER_PHASE) bar = xcd_barrier_post((unsigned*)(args.ws + WO_ctl) + CW_BAR, MISC + 8);
    const int lo = args.ph_lo, hi = args.ph_hi;
    int ph = 0;
#define RUN() (lo <= ph && ph < hi)
#define SEAM() do { if (!MK_PER_PHASE && ph + 1 < hi) { xcd_barrier(bar); if ((PROBE_MASK >> 12) & 1) xcd_barrier(bar); } ++ph; } while (0)
#define PHASE_BEGIN() const P p = make_p(args); int bx = blockIdx.x, G = gridDim.x; asm volatile("" : "+s"(bx), "+s"(G))

    if (RUN()) { PHASE_BEGIN(); REP(0) misc::prologue(p, ldsp, G, bx); }
    SEAM();
    for (int slot = 0; slot < 4; ++slot) {
        if (RUN()) { PHASE_BEGIN();
            pg8::Gemm g{p.XB, p.WFI + (size_t)slot * 2 * D_FF * D_MODEL, M, 2 * D_FF, D_MODEL, D_MODEL}; pg8::StaticOrder S; S.init(M, 2 * D_FF, G, bx);
            if ((PROBE_MASK >> 17) & 1) { pg8::EpiNull E0; pg8::gemm_phase<pg8::EpiNull, pg8::StaticOrder, true, true>(ldsp, g, S, E0); }
            pg8::EpiSwiglu E{p}; REP(1) pg8::gemm_phase<pg8::EpiSwiglu, pg8::StaticOrder, true, true>(ldsp, g, S, E);
            __syncthreads(); misc::convert_in_tail<1>(p, ldsp, slot, (M / 256) * (2 * D_FF / 256), G, bx);
            if (slot == 1) misc::convert_in_tail<4>(p, ldsp, 0, (M / 256) * (2 * D_FF / 256), G, bx);
        }
        SEAM();
        for (int job = 0; job < 2; ++job) {
            if (job == 1) {
                if (slot == 0) {
                    if (RUN()) { PHASE_BEGIN();
                        pg8::Gemm g{p.XB, p.WSI, M, NSI, D_MODEL, D_MODEL}; pg8::StaticOrder S; S.init(M, NSI, G, bx);
                        pg8::EpiRow<EfSsmIn> E{p}; REP(2) pg8::gemm_phase<pg8::EpiRow<EfSsmIn>, pg8::StaticOrder, true, true>(ldsp, g, S, E);
                        __syncthreads(); misc::convert_in_tail<3>(p, ldsp, 0, (M / 256) * (NSI / 256), G, bx);
                        misc::convert_in_tail<0>(p, ldsp, 1, (M / 256) * (NSI / 256), G, bx);
                        misc::convert_in_tail<0>(p, ldsp, 2, (M / 256) * (NSI / 256), G, bx);
                    }
                    SEAM();
                    if (RUN()) { PHASE_BEGIN();
#pragma unroll 1
                        for (int part = 0; part < 2; ++part) {
                            if (((part ^ (bx >> 3)) & 1) == 0) { REP(3) ssd::states_phase(p, G, bx, ldsp); }
                            else { REP(14) misc::ssd_sample_phase(p, G, bx, ldsp); } } }
                    SEAM();
                    if (RUN()) { PHASE_BEGIN(); REP(4) GRID_STRIDE(ssd::N_SCAN4, ssd::scan4(p, i)); }
                    SEAM();
                    if (RUN()) { PHASE_BEGIN(); REP(5) for (int u = bx; u < BATCH * NCHUNK * SSD_GROUPS; u += G) ssd::y_unit(p, u / SSD_GROUPS, u % SSD_GROUPS, ldsp); }
                    SEAM();
                } else if (slot == 2) {
                    if (RUN()) { PHASE_BEGIN();
                        pg8::Gemm g{p.XB, p.WQKV, M, QKVW, D_MODEL, D_MODEL}; pg8::StaticOrder S; S.init(M, QKVW, G, bx);
                        pg8::EpiRow<EfQkv> E{p}; REP(6) pg8::gemm_phase<pg8::EpiRow<EfQkv>, pg8::StaticOrder, true, true>(ldsp, g, S, E);
                        __syncthreads(); misc::convert_in_tail<5>(p, ldsp, 0, (M / 256) * (QKVW / 256), G, bx);
                        misc::convert_in_tail<0>(p, ldsp, 3, (M / 256) * (QKVW / 256), G, bx);
                    }
                    SEAM();
                    if (RUN()) { PHASE_BEGIN();
#pragma unroll 1
                        for (int part = 0; part < 2; ++part) {
                            if (((part ^ (bx >> 3)) & 1) == 0) { REP(7) att::prompt_phase(p, G, bx, ldsp); }
                            else { REP(10) for (int u = bx; u < att::N_SUNITS; u += G) att::sample_unit(p, u, ldsp); } } }
                    SEAM();
                    if (RUN()) { PHASE_BEGIN(); REP(8) att::merge_phase(p, G, bx); }
                    SEAM();
                } else break;
            }
            const int rk = job == 0 ? D_FF : (slot == 0 ? D_INNER : AW), rs = job == 0 ? 11 : (slot == 0 ? 8 : 4);
            if (RUN()) { PHASE_BEGIN();
                const bf16* A = job == 0 ? p.H : (slot == 0 ? p.GZ : p.O); const bf16* Bt = job == 0 ? p.WFO + (size_t)slot * D_MODEL * D_FF : (slot == 0 ? p.WSO : p.WO);
                { pg8::Gemm g{A, Bt, MP, D_MODEL, rk, rk}; pg8::StaticOrder S; S.init(MP, D_MODEL, G, bx);
                  if ((PROBE_MASK >> 13) & 1) { pg8::EpiNull E0; pg8::gemm_phase<pg8::EpiNull, pg8::StaticOrder, true, true>(ldsp, g, S, E0); }
                  pg8::EpiResid E{p, slot + job == 0}; pg8::gemm_phase<pg8::EpiResid, pg8::StaticOrder, true, true>(ldsp, g, S, E); }
                { pg8::Gemm g{A, Bt, M, D_MODEL, rk / rs, rk}; pg8::SplitOrder S; S.init(MP / 256, MS / 256, D_MODEL / 256, rs, G, bx);
                  pg8::EpiPart E{p}; REP(11) pg8::gemm_phase<pg8::EpiPart, pg8::SplitOrder, true, true>(ldsp, g, S, E); }
            }
            SEAM();
            if (slot == 3 && job == 0) { static_assert(misc::S_LAST == 11, "the final norm sums the last GEMM's partials itself"); break; }
            if (RUN()) { PHASE_BEGIN(); misc::splitk_fixup(p, rs, G, bx, slot + job == 0); }
            SEAM();
        }
    }
    if (RUN()) { PHASE_BEGIN(); REP(9) misc::final_norm(p, ldsp, G, bx); }
#undef RUN
#undef SEAM
}
constexpr int N_PHASES = 1 + 4 * 3 + 6 + 5 + 1 - 1;

extern "C" void kernel_launch(void* const* d_in, const int* in_sizes, int n_in, void* d_out, int out_size, void* d_ws, size_t ws_size, hipStream_t stream) {
    static int grid = 0;
    if (grid == 0) {
        int dev = 0, cus = 0, per_cu = 0;
        if (hipGetDevice(&dev) != hipSuccess || hipDeviceGetAttribute(&cus, hipDeviceAttributeMultiprocessorCount, dev) != hipSuccess) { fprintf(stderr, "kernel_launch: device query failed\n"); grid = -1; return; }
        if (hipFuncSetAttribute((const void*)mega_fwd, hipFuncAttributeMaxDynamicSharedMemorySize, LDS_BYTES) != hipSuccess) { fprintf(stderr, "kernel_launch: hipFuncSetAttribute failed\n"); grid = -1; return; }
        if (hipOccupancyMaxActiveBlocksPerMultiprocessor(&per_cu, (const void*)mega_fwd, NTHR, LDS_BYTES) != hipSuccess || per_cu < 1) fprintf(stderr, "kernel_launch: occupancy query says %d\n", per_cu);
        (void)hipGetLastError();
        grid = cus;
    }
    if (grid < 0) return;
    KArgs a; memset(&a, 0, sizeof(a));
    const float* const* in = (const float* const*)d_in;
    a.x_prompt = in[0]; a.x_sample = in[1]; a.state_conv = in[2]; a.state_ssm = in[3]; a.cache0 = in[4]; a.cache1 = in[5]; a.cache2 = in[6]; a.norm_w = in[7]; a.w_ffn_in = in[8]; a.w_ffn_out = in[9]; a.ssm_w_in = in[10]; a.ssm_conv_w = in[11]; a.ssm_conv_b = in[12]; a.ssm_dt_bias = in[13]; a.ssm_a_log = in[14]; a.ssm_d = in[15]; a.ssm_norm_w = in[16]; a.ssm_w_out = in[17]; a.attn_w_qkv = in[18]; a.attn_w_o = in[19]; a.norm_f = in[20];
    a.out = (float*)d_out; a.ws = (unsigned char*)d_ws;
    if (OUT_ELEMS != (size_t)out_size) fprintf(stderr, "kernel_launch: output size mismatch: %zu vs %d\n", (size_t)OUT_ELEMS, out_size);
    if (WS_NEED > ws_size) { fprintf(stderr, "kernel_launch: workspace too small: need %zu have %zu\n", (size_t)WS_NEED, ws_size); return; }
    if (hipMemsetAsync((unsigned char*)d_ws + WO_ctl, 0, CTL_BYTES, stream) != hipSuccess) { fprintf(stderr, "kernel_launch: memset failed\n"); return; }
#if MK_PER_PHASE
    for (int k = 0; k < N_PHASES; ++k) { a.ph_lo = k; a.ph_hi = k + 1; hipLaunchKernelGGL(mega_fwd, dim3(grid), dim3(NTHR), LDS_BYTES, stream, a); }
#else
    a.ph_lo = 0; a.ph_hi = N_PHASES; hipLaunchKernelGGL(mega_fwd, dim3(grid), dim3(NTHR), LDS_BYTES, stream, a);
#endif
    const hipError_t le = hipPeekAtLastError();
    if (le != hipSuccess) fprintf(stderr, "kernel_launch: launch failed: %s\n", hipGetErrorName(le));
}
#endif
```

```cpp
#ifndef HOST_SIM
#include <hip/hip_runtime.h>
#define HD __host__ __device__ __forceinline__
#else
#include <cmath>
#define HD inline
#endif
#include <cstdio>
#include <cstdint>
#include <cstddef>
#include <cstring>

#ifdef SMALL
constexpr int D_MODEL = 128, BATCH = 1, SEQ = 4096, DEC_BATCH = 2, DEC_SEQ = 8, PAST_LEN = 2048, D_FF = 256, SSD_GROUPS = 2, D_STATE = 32, ATTN_HPG = 2;
#else
constexpr int D_MODEL = 1024, BATCH = 4, SEQ = 4096, DEC_BATCH = 128, DEC_SEQ = 8, PAST_LEN = 2048, D_FF = 2816, SSD_GROUPS = 8, D_STATE = 128, ATTN_HPG = 8;
#endif
constexpr float EPS = 1e-6f;
constexpr int D_INNER = 2 * D_MODEL, HEADDIM = 64, SSD_HEADS = D_INNER / HEADDIM, SSD_HPG = SSD_HEADS / SSD_GROUPS;
constexpr int CONV_W = 4, CONV_DIM = D_INNER + 2 * SSD_GROUPS * D_STATE, D_IN_PROJ = D_INNER + CONV_DIM + SSD_HEADS, CHUNK = 128, NCHUNK = SEQ / CHUNK;
constexpr int GW = D_INNER / SSD_GROUPS;
constexpr int AHD = 64, AW = ATTN_HPG * AHD, QKVW = 9 * AW, NAH = 3 * ATTN_HPG;
constexpr int MP = BATCH * SEQ, MS = DEC_BATCH * DEC_SEQ, M = MP + MS;
constexpr int ZXW = D_INNER + CONV_DIM;
constexpr int DT_COL0 = (ZXW + 255) / 256 * 256;
constexpr int NSI = DT_COL0 + 256;
constexpr int ZXP = DT_COL0;
constexpr int NSS = 16;
HD int a_win(int g) { return g == 0 ? 128 : (g == 1 ? 512 : 2048); }
HD int a_dil(int g) { return g == 0 ? 1 : (g == 1 ? 4 : 16); }
HD int a_past(int g) { return a_win(g) < PAST_LEN ? a_win(g) : PAST_LEN; }
HD int a_keep(int g) { return a_win(g) < SEQ ? a_win(g) : SEQ; }

typedef unsigned short bf16;
HD unsigned f2bf(float f) { unsigned u; memcpy(&u, &f, 4); return (u + 0x7fffu + ((u >> 16) & 1u)) >> 16; }
HD float bf2f(bf16 h) { unsigned u = (unsigned)h << 16; float f; memcpy(&f, &u, 4); return f; }
HD unsigned pk2bf(float lo, float hi) {
#if defined(__HIP_DEVICE_COMPILE__)
    typedef float f32x2_t __attribute__((ext_vector_type(2))); typedef __bf16 bf16x2_t __attribute__((ext_vector_type(2)));
    const f32x2_t v = {lo, hi}; const bf16x2_t b = __builtin_convertvector(v, bf16x2_t); return __builtin_bit_cast(unsigned, b);
#else
    return pk2bf(lo, hi);
#endif
}
HD float silu_f(float x) {
#if defined(__HIP_DEVICE_COMPILE__)
    return x * __builtin_amdgcn_rcpf(1.f + __expf(-x));
#else
    return x / (1.f + expf(-x));
#endif
}
HD float softplus_f(float x) { return x > 20.f ? x : log1pf(expf(x)); }

struct P {
    const float *x_prompt, *x_sample, *state_conv, *state_ssm, *cache0, *cache1, *cache2, *norm_w, *w_ffn_in, *w_ffn_out, *ssm_w_in, *ssm_conv_w, *ssm_conv_b,
        *ssm_dt_bias, *ssm_a_log, *ssm_d, *ssm_norm_w, *ssm_w_out, *attn_w_qkv, *attn_w_o, *norm_f;
    float *y_prompt, *y_sample, *conv_prompt, *conv_sample, *ssm_prompt, *ssm_sample, *kvp0, *kvs0, *kvp1, *kvs1, *kvp2, *kvs2;
    bf16 *WFI, *WFO, *WSI, *WSO, *WQKV, *WO, *XB, *H, *ZX, *HPREV, *GZ, *QKV, *O, *OG;
    float *X, *SS, *DT, *ACUM, *XC, *STATES, *Y, *CDEC, *LSE, *PART;
    bf16* XLO;
    unsigned* ctl;
    long cd1, cd2;
};
HD const float* cache_of(const P& p, int g) { return (const float*)((const char*)p.cache0 + (g == 0 ? 0 : (g == 1 ? p.cd1 : p.cd2))); }
HD float* kvp_of(const P& p, int g) { return p.kvp0 + (g == 0 ? 0 : (g == 1 ? (long)(p.kvp1 - p.kvp0) : (long)(p.kvp2 - p.kvp0))); }
HD float* kvs_of(const P& p, int g) { return p.kvs0 + (g == 0 ? 0 : (g == 1 ? (long)(p.kvs1 - p.kvs0) : (long)(p.kvs2 - p.kvs0))); }
HD float rstd_of(const P& p, int row) { float s = 0.f; for (int i = 0; i < NSS; ++i) s += p.SS[(size_t)row * NSS + i];
#if defined(__HIP_DEVICE_COMPILE__)
    return __builtin_amdgcn_rsqf(s * (1.f / D_MODEL) + EPS);
#else
    return 1.f / sqrtf(s * (1.f / D_MODEL) + EPS);
#endif
}
HD void row_bt(int row, bool& samp, int& b, int& t) { samp = row >= MP; if (!samp) { b = row / SEQ; t = row % SEQ; } else { const int r = row - MP; b = r / DEC_SEQ; t = r % DEC_SEQ; } }

constexpr long N_WFI = 4L * 2 * D_FF * D_MODEL, N_WFO = 4L * D_MODEL * D_FF, N_WSI = (long)NSI * D_MODEL, N_WSO = (long)D_MODEL * D_INNER, N_WQKV = (long)QKVW * D_MODEL, N_WO = (long)D_MODEL * AW;
HD void st_wfi(const P& p, long i) {
    const int k = (int)(i % D_MODEL); long r = i / D_MODEL; const int n = (int)(r % (2 * D_FF)); const int ls = (int)(r / (2 * D_FF));
    const int pn = n / 256, j = n % 256, oc = j < 128 ? 128 * pn + j : D_FF + 128 * pn + (j - 128);
    const float g = p.norm_w[((ls >> 1) * 3 + ((ls & 1) ? 2 : 0)) * D_MODEL + k];
    p.WFI[i] = (bf16)f2bf(p.w_ffn_in[((size_t)ls * D_MODEL + k) * (2 * D_FF) + oc] * g);
}
HD void st_wfo(const P& p, long i) {
    const int k = (int)(i % D_FF); long r = i / D_FF; const int n = (int)(r % D_MODEL); const int ls = (int)(r / D_MODEL);
    p.WFO[i] = (bf16)f2bf(0.5f * p.w_ffn_out[((size_t)ls * D_FF + k) * D_MODEL + n]);
}
HD void st_wsi(const P& p, long i) {
    const int k = (int)(i % D_MODEL), n = (int)(i / D_MODEL); int oc = -1;
    if (n < ZXW) oc = n; else if (n >= DT_COL0 && n < DT_COL0 + SSD_HEADS) oc = ZXW + (n - DT_COL0);
    p.WSI[i] = oc < 0 ? (bf16)0 : (bf16)f2bf(p.ssm_w_in[(size_t)k * D_IN_PROJ + oc] * p.norm_w[(0 * 3 + 1) * D_MODEL + k]);
}
HD void st_wso(const P& p, long i) { const int k = (int)(i % D_INNER), n = (int)(i / D_INNER); p.WSO[i] = (bf16)f2bf(p.ssm_w_out[(size_t)k * D_MODEL + n]); }
HD void st_wqkv(const P& p, long i) {
    const int k = (int)(i % D_MODEL), n = (int)(i / D_MODEL); const bool isq = (n / AW) % 3 == 0;
    p.WQKV[i] = (bf16)f2bf(p.attn_w_qkv[(size_t)k * QKVW + n] * p.norm_w[(1 * 3 + 1) * D_MODEL + k] * (isq ? 0.125f : 1.f));
}
HD void st_wo(const P& p, long i) { const int k = (int)(i % AW), n = (int)(i / AW); p.WO[i] = (bf16)f2bf(p.attn_w_o[(size_t)k * D_MODEL + n]); }
HD void st_xinit(const P& p, long i) {
    const int part = (int)(i % NSS), row = (int)(i / NSS); constexpr int W = D_MODEL / NSS;
    const float* src = row < MP ? p.x_prompt + (size_t)row * D_MODEL : p.x_sample + (size_t)(row - MP) * D_MODEL; float s = 0.f;
    for (int c = part * W; c < (part + 1) * W; ++c) { const float v = src[c]; p.X[(size_t)row * D_MODEL + c] = v; p.XB[(size_t)row * D_MODEL + c] = (bf16)f2bf(v); s += v * v; }
    p.SS[(size_t)row * NSS + part] = s;
}
HD float ssd_a(const P& p, int head) { return -expf(p.ssm_a_log[head]); }
HD void st_acum(const P& p, long i) {
    const int head = (int)(i % SSD_HEADS); const int sc = (int)(i / SSD_HEADS); int row0, len;
    if (sc < MP / CHUNK) { row0 = sc * CHUNK; len = CHUNK; } else { row0 = MP + (sc - MP / CHUNK) * DEC_SEQ; len = DEC_SEQ; }
    const float a = ssd_a(p, head); float c = 0.f;
    for (int t = 0; t < len; ++t) { c += p.DT[(size_t)(row0 + t) * SSD_HEADS + head] * a; p.ACUM[(size_t)(row0 + t) * SSD_HEADS + head] = c; }
}
constexpr long N_ACUM = (long)(MP / CHUNK + DEC_BATCH) * SSD_HEADS;
HD void st_conv(const P& p, long i) {
    const int ch = (int)(i % CONV_DIM), row = (int)(i / CONV_DIM); bool samp; int b, t; row_bt(row, samp, b, t);
    float acc = p.ssm_conv_b[ch];
    for (int k = 0; k < CONV_W; ++k) { const int tt = t - (CONV_W - 1) + k; float v;
        if (tt >= 0) v = bf2f(p.ZX[(size_t)(row - t + tt) * ZXP + D_INNER + ch]);
        else v = samp ? p.state_conv[((size_t)b * (CONV_W - 1) + (tt + CONV_W - 1)) * CONV_DIM + ch] : 0.f;
        acc += p.ssm_conv_w[k * CONV_DIM + ch] * v; }
    p.XC[(size_t)row * CONV_DIM + ch] = silu_f(acc);
}
HD void st_states(const P& p, long i) {
    const int n = (int)(i % D_STATE); long r = i / D_STATE; const int pp = (int)(r % HEADDIM); r /= HEADDIM; const int head = (int)(r % SSD_HEADS); const int bc = (int)(r / SSD_HEADS);
    const int row0 = bc * CHUNK, g = head / SSD_HPG; const float alast = p.ACUM[(size_t)(row0 + CHUNK - 1) * SSD_HEADS + head]; float s = 0.f;
    for (int t = 0; t < CHUNK; ++t) { const size_t rr = row0 + t;
        s += expf(alast - p.ACUM[rr * SSD_HEADS + head]) * p.DT[rr * SSD_HEADS + head] * p.XC[rr * CONV_DIM + head * HEADDIM + pp] * p.XC[rr * CONV_DIM + D_INNER + g * D_STATE + n]; }
    p.STATES[i] = s;
}
constexpr long N_STATES = (long)BATCH * NCHUNK * SSD_HEADS * HEADDIM * D_STATE;
HD void st_scan(const P& p, long i) {
    const long per = (long)HEADDIM * D_STATE; const long e = i % per; long r = i / per; const int head = (int)(r % SSD_HEADS), b = (int)(r / SSD_HEADS); float h = 0.f;
    for (int c = 0; c < NCHUNK; ++c) { const size_t idx = (((size_t)(b * NCHUNK + c)) * SSD_HEADS + head) * per + e;
        p.HPREV[idx] = (bf16)f2bf(h);
        h = expf(p.ACUM[(size_t)((b * NCHUNK + c) * CHUNK + CHUNK - 1) * SSD_HEADS + head]) * h + p.STATES[idx]; }
    p.ssm_prompt[i] = h;
}
constexpr long N_SCAN = (long)BATCH * SSD_HEADS * HEADDIM * D_STATE;
HD void st_y(const P& p, long i) {
    const int pp = (int)(i % HEADDIM); long r = i / HEADDIM; const int head = (int)(r % SSD_HEADS), row = (int)(r / SSD_HEADS); const int g = head / SSD_HPG;
    const int bc = row / CHUNK, row0 = bc * CHUNK; const float at = p.ACUM[(size_t)row * SSD_HEADS + head];
    const float* Ct = p.XC + (size_t)row * CONV_DIM + D_INNER + SSD_GROUPS * D_STATE + g * D_STATE; float y = 0.f;
    for (int rr = row0; rr <= row; ++rr) { const float* Bs = p.XC + (size_t)rr * CONV_DIM + D_INNER + g * D_STATE; float cb = 0.f;
        for (int n = 0; n < D_STATE; ++n) cb += Ct[n] * Bs[n];
        y += cb * expf(at - p.ACUM[(size_t)rr * SSD_HEADS + head]) * p.DT[(size_t)rr * SSD_HEADS + head] * p.XC[(size_t)rr * CONV_DIM + head * HEADDIM + pp]; }
    const bf16* hp = p.HPREV + (((size_t)bc * SSD_HEADS + head) * HEADDIM + pp) * D_STATE; float yo = 0.f;
    for (int n = 0; n < D_STATE; ++n) yo += Ct[n] * bf2f(hp[n]);
    p.Y[(size_t)row * D_INNER + head * HEADDIM + pp] = y + yo * expf(at) + p.ssm_d[head] * p.XC[(size_t)row * CONV_DIM + head * HEADDIM + pp];
}
constexpr long N_Y = (long)MP * SSD_HEADS * HEADDIM;
HD void st_ssd_sample(const P& p, long i) {
    const int pp = (int)(i % HEADDIM); long r = i / HEADDIM; const int head = (int)(r % SSD_HEADS), b = (int)(r / SSD_HEADS); const int g = head / SSD_HPG;
    const int row0 = MP + b * DEC_SEQ; const float a = ssd_a(p, head); float ya[DEC_SEQ];
    for (int t = 0; t < DEC_SEQ; ++t) ya[t] = 0.f;
    const size_t sb = (((size_t)b * SSD_HEADS + head) * HEADDIM + pp) * D_STATE;
    for (int n = 0; n < D_STATE; ++n) { float h = p.state_ssm[sb + n];
#pragma unroll
        for (int t = 0; t < DEC_SEQ; ++t) { const size_t rr = row0 + t; const float dt = p.DT[rr * SSD_HEADS + head];
            h = expf(dt * a) * h + dt * p.XC[rr * CONV_DIM + D_INNER + g * D_STATE + n] * p.XC[rr * CONV_DIM + head * HEADDIM + pp];
            ya[t] += p.XC[rr * CONV_DIM + D_INNER + SSD_GROUPS * D_STATE + g * D_STATE + n] * h; }
        p.ssm_sample[sb + n] = h; }
#pragma unroll
    for (int t = 0; t < DEC_SEQ; ++t) { const size_t rr = row0 + t; p.Y[rr * D_INNER + head * HEADDIM + pp] = ya[t] + p.ssm_d[head] * p.XC[rr * CONV_DIM + head * HEADDIM + pp]; }
}
constexpr long N_SSDS = (long)DEC_BATCH * SSD_HEADS * HEADDIM;
HD void st_gate(const P& p, long i) {
    const int g = (int)(i % SSD_GROUPS), row = (int)(i / SSD_GROUPS); float ms = 0.f;
    for (int c = 0; c < GW; ++c) { const int ch = g * GW + c; const float v = p.Y[(size_t)row * D_INNER + ch] * silu_f(bf2f(p.ZX[(size_t)row * ZXP + ch])); ms += v * v; }
    const float r = 1.f / sqrtf(ms * (1.f / GW) + EPS);
    for (int c = 0; c < GW; ++c) { const int ch = g * GW + c; const float v = p.Y[(size_t)row * D_INNER + ch] * silu_f(bf2f(p.ZX[(size_t)row * ZXP + ch]));
        p.GZ[(size_t)row * D_INNER + ch] = (bf16)f2bf(v * r * p.ssm_norm_w[ch]); }
}
constexpr int ADQ = 4, ADW = AHD / ADQ;
HD void st_attn(const P& p, long i) {
    const int dq = (int)(i % ADQ); long r = i / ADQ; const int h = (int)(r % ATTN_HPG), row = (int)(r / ATTN_HPG); bool samp; int b, t; row_bt(row, samp, b, t);
    float o[ADW];
#pragma unroll
    for (int d = 0; d < ADW; ++d) o[d] = 0.f;
    float mx = -1e30f, l = 0.f;
    for (int g = 0; g < 3; ++g) { const int dil = a_dil(g), nk = a_win(g) / dil + 1, past = samp ? a_past(g) : 0;
        const float slope = exp2f(-8.f * (float)(g * ATTN_HPG + h + 1) / (float)NAH);
        const bf16* q = p.QKV + (size_t)row * QKVW + g * 3 * AW + h * AHD;
        for (int j = 0; j < nk; ++j) { const int idx = past + t - j * dil; if (idx < 0) break;
            float s = 0.f, vv[ADW];
            if (idx >= past) { const bf16* kr = p.QKV + (size_t)(row - t + (idx - past)) * QKVW + g * 3 * AW + AW + h * AHD; const bf16* vr = kr + AW + dq * ADW;
                for (int d = 0; d < AHD; ++d) s += bf2f(q[d]) * bf2f(kr[d]);
#pragma unroll
                for (int d = 0; d < ADW; ++d) vv[d] = bf2f(vr[d]); }
            else { const float* kr = cache_of(p, g) + (((size_t)b * past + idx) * 2) * AW + h * AHD; const float* vr = kr + AW + dq * ADW;
                for (int d = 0; d < AHD; ++d) s += bf2f(q[d]) * kr[d];
#pragma unroll
                for (int d = 0; d < ADW; ++d) vv[d] = vr[d]; }
            s -= slope * (float)(dil * j);
            if (s > mx) { const float f = expf(mx - s); l *= f;
#pragma unroll
                for (int d = 0; d < ADW; ++d) o[d] *= f;
                mx = s; }
            const float e = expf(s - mx); l += e;
#pragma unroll
            for (int d = 0; d < ADW; ++d) o[d] += e * vv[d]; } }
    const float inv = 1.f / l;
#pragma unroll
    for (int d = 0; d < ADW; ++d) p.O[(size_t)row * AW + h * AHD + dq * ADW + d] = (bf16)f2bf(o[d] * inv);
}
HD void st_final(const P& p, long i) {
    const int part = (int)(i % NSS), row = (int)(i / NSS); constexpr int W = D_MODEL / NSS;
    const float r = rstd_of(p, row); float* out = row < MP ? p.y_prompt + (size_t)row * D_MODEL : p.y_sample + (size_t)(row - MP) * D_MODEL;
    for (int c = part * W; c < (part + 1) * W; ++c) out[c] = p.X[(size_t)row * D_MODEL + c] * r * p.norm_f[c];
}

struct EfSwiglu {
    HD void operator()(const P& p, int row, int hcol0, float rstd, const float* a, const float* b) const {
        unsigned w[4];
#pragma unroll
        for (int i = 0; i < 4; ++i) { const float v0 = silu_f(a[2 * i] * rstd) * (b[2 * i] * rstd), v1 = silu_f(a[2 * i + 1] * rstd) * (b[2 * i + 1] * rstd); w[i] = pk2bf(v0, v1); }
        unsigned* dst = (unsigned*)(p.H + (size_t)row * D_FF + hcol0); dst[0] = w[0]; dst[1] = w[1]; dst[2] = w[2]; dst[3] = w[3];
    }
};
struct EfResid {
    HD float operator()(const P& p, int row, int col0, const float* v) const {
        float* x = p.X + (size_t)row * D_MODEL + col0; unsigned* xb = (unsigned*)(p.XB + (size_t)row * D_MODEL + col0); float s = 0.f, nv[8];
#pragma unroll
        for (int i = 0; i < 8; ++i) { nv[i] = x[i] + v[i]; s += nv[i] * nv[i]; }
#pragma unroll
        for (int i = 0; i < 8; ++i) x[i] = nv[i];
#pragma unroll
        for (int i = 0; i < 4; ++i) xb[i] = pk2bf(nv[2 * i], nv[2 * i + 1]);
        return s;
    }
};
struct EfSsmIn {
    HD void operator()(const P& p, int row, int col0, float rstd, const float* v) const {
        if (col0 < DT_COL0) {
            unsigned* dst = (unsigned*)(p.ZX + (size_t)row * ZXP + col0);
#pragma unroll
            for (int i = 0; i < 4; ++i) dst[i] = pk2bf(v[2 * i] * rstd, v[2 * i + 1] * rstd);
            if (col0 >= D_INNER && col0 < ZXW) { bool samp; int b, t; row_bt(row, samp, b, t); const int L = samp ? DEC_SEQ : SEQ;
                if (t >= L - (CONV_W - 1)) { float* o = (samp ? p.conv_sample : p.conv_prompt) + ((size_t)b * (CONV_W - 1) + (t - (L - (CONV_W - 1)))) * CONV_DIM + (col0 - D_INNER);
#pragma unroll
                    for (int i = 0; i < 8; ++i) o[i] = v[i] * rstd; } }
        } else {
#pragma unroll
            for (int i = 0; i < 8; ++i) { const int hd = col0 - DT_COL0 + i; if (hd < SSD_HEADS) p.DT[(size_t)row * SSD_HEADS + hd] = softplus_f(v[i] * rstd + p.ssm_dt_bias[hd]); }
        }
    }
};
struct EfQkv {
    HD void operator()(const P& p, int row, int col0, float rstd, const float* v) const {
        unsigned* dst = (unsigned*)(p.QKV + (size_t)row * QKVW + col0);
#pragma unroll
        for (int i = 0; i < 4; ++i) dst[i] = pk2bf(v[2 * i] * rstd, v[2 * i + 1] * rstd);
        const int g = col0 / (3 * AW), off = col0 - g * 3 * AW - AW;
        if (off >= 0) { bool samp; int b, t; row_bt(row, samp, b, t); float* o = nullptr;
            if (samp) o = kvs_of(p, g) + ((size_t)b * DEC_SEQ + t) * 2 * AW + off;
            else { const int keep = a_keep(g); if (t >= SEQ - keep) o = kvp_of(p, g) + ((size_t)b * keep + (t - (SEQ - keep))) * 2 * AW + off; }
            if (o) {
#pragma unroll
                for (int i = 0; i < 8; ++i) o[i] = v[i] * rstd; } }
    }
};

#ifndef HOST_SIM
#define LAS __attribute__((address_space(3)))
#define GAS __attribute__((address_space(1)))
typedef GAS unsigned gu32;
#define RLX_AGENT __ATOMIC_RELAXED, __HIP_MEMORY_SCOPE_AGENT
__device__ __forceinline__ float lane_xor_f(float v, int lane, int m) { return __int_as_float(__builtin_amdgcn_ds_bpermute((lane ^ m) << 2, __float_as_int(v))); }
__device__ __forceinline__ float lane_up_f(float v, int lane, int d) { return __int_as_float(__builtin_amdgcn_ds_bpermute((lane - d) << 2, __float_as_int(v))); }

__device__ __forceinline__ float bf_lo(unsigned w) { return __uint_as_float(w << 16); }
__device__ __forceinline__ float bf_hi(unsigned w) { return __uint_as_float(w & 0xffff0000u); }
typedef float hl_f4 __attribute__((ext_vector_type(4)));
#define SPLIT2(a, b, H, L) do { const unsigned h_ = pk2bf((a), (b)); (H) = h_; (L) = pk2bf((a) - bf_lo(h_), (b) - bf_hi(h_)); } while (0)
__device__ __forceinline__ hl_f4 join4(unsigned h0, unsigned h1, unsigned l0, unsigned l1) { hl_f4 v; v[0] = bf_lo(h0) + bf_lo(l0); v[1] = bf_hi(h0) + bf_hi(l0); v[2] = bf_lo(h1) + bf_lo(l1); v[3] = bf_hi(h1) + bf_hi(l1); return v; }
namespace pg8 {
#define PG8_LAS __attribute__((address_space(3)))
typedef unsigned short bf16_t;
typedef short bf16x8 __attribute__((ext_vector_type(8)));
typedef float f32x4 __attribute__((ext_vector_type(4)));
typedef unsigned u32x4 __attribute__((ext_vector_type(4)));
constexpr int BM = 256, BK = 64, HALF = 128, HTB = HALF * BK * 2, STAGE_BYTES = 8 * HTB, NXCD = 8, WGM = 8;
__host__ __device__ __forceinline__ int lds_byte(int r, int c) { const int st = (r >> 4) * 2 + (c >> 5), rr = r & 15, cc = c & 31, ob = rr * 64 + cc * 2; return st * 1024 + (ob ^ (((ob >> 9) & 1) << 5)); }
__host__ __device__ __forceinline__ void stage_rc(int b, int& R, int& C) { const int st = b / 1024, sb = b % 1024, swz = sb ^ (((sb >> 9) & 1) << 5); R = (st >> 1) * 16 + swz / 64; C = (st & 1) * 32 + (swz % 64) / 2; }
__host__ __device__ __forceinline__ int perm32(int rho) { const int n = rho >> 4, i = rho & 15; return 8 * (i >> 2) + 4 * n + (i & 3); }
struct Unit { int pm, pn, ks; };
struct Gemm { const bf16_t* A; const bf16_t* Bt; int M, N, K, kp; };
struct StaticOrder {
    int nM, nN, nwg, G, c;
    __host__ __device__ void init(int M_, int N_, int G_, int c_) { nM = M_ / BM; nN = N_ / BM; nwg = nM * nN; G = G_; c = c_; }
    __host__ __device__ bool next(int i, Unit& u) const {
        const long L = (long)i * G + c; if (L >= nwg) return false;
        int wgid = (int)L; { const int q = nwg / NXCD, r = nwg % NXCD, xcd = wgid % NXCD, off = wgid / NXCD; wgid = (xcd < r ? xcd * (q + 1) : r * (q + 1) + (xcd - r) * q) + off; }
        const int nig = WGM * nN, gid = wgid / nig, fm = gid * WGM, gsz = (nM - fm) < WGM ? (nM - fm) : WGM;
        u.pm = fm + ((wgid % nig) % gsz); u.pn = (wgid % nig) / gsz; u.ks = 0; return true;
    }
    __device__ __forceinline__ void a_ready(const Unit&) const {}
    __device__ __forceinline__ void done(const Unit&) const {}
};

template <class Epi, class Sched, bool ALIGN_EPI = false, bool SP2 = false>
__device__ __forceinline__ void gemm_phase(PG8_LAS unsigned char* lds, const Gemm g, const Sched& S, const Epi& E) {
    int tid = threadIdx.x; asm volatile("" : "+v"(tid));
    const int wid = __builtin_amdgcn_readfirstlane(tid >> 6), lane = tid & 63, wr = wid >> 2, wc = wid & 3, fr = lane & 15, fq = lane >> 4;
    const int K = g.K, nt = K / BK, KPI = g.kp;
    unsigned voffA[2], voffB[2];
#pragma unroll
    for (int i = 0; i < 2; ++i) { int R, C; stage_rc(tid * 16 + i * 8192, R, C); const int Rb = Epi::PERM ? ((R & ~31) + perm32(R & 31)) : R;
        voffA[i] = (unsigned)(R * KPI + C) * 2u; voffB[i] = (unsigned)(Rb * KPI + C) * 2u; }
    const size_t kstep = (size_t)(BK * 2);
    const size_t hstep = (size_t)HALF * KPI * 2;
    const size_t sstep = (size_t)K * 2;
    const size_t tstep = 2 * hstep;
    const unsigned ldsw = (unsigned)wid * 1024u;
    const int aoff = lds_byte(wr * 64 + fr, fq * 8), boff = lds_byte(wc * 32 + fr, fq * 8);
#define PG8_SA(b, h) (((b) * 2 + (h)) * HTB)
#define PG8_SB(b, h) ((4 + (b) * 2 + (h)) * HTB)
#define PG8_STAGE(bufoff, gbase, voff) do { _Pragma("unroll") for (int _i = 0; _i < 2; ++_i) \
        __builtin_amdgcn_global_load_lds((const unsigned*)((const char*)(gbase) + (voff)[_i]), (PG8_LAS unsigned*)(lds + (bufoff) + ldsw + _i * 8192), 16, 0, 0); } while (0)
#define PG8_LDA(dst, b, h) do { _Pragma("unroll") for (int m = 0; m < 4; ++m) _Pragma("unroll") for (int k = 0; k < 2; ++k) dst[m][k] = *(const PG8_LAS bf16x8*)(lds + PG8_SA(b, h) + aoff + m * 2048 + k * 1024); } while (0)
#define PG8_LDB(dst, b, h) do { _Pragma("unroll") for (int n = 0; n < 2; ++n) _Pragma("unroll") for (int k = 0; k < 2; ++k) dst[n][k] = *(const PG8_LAS bf16x8*)(lds + PG8_SB(b, h) + boff + n * 2048 + k * 1024); } while (0)
#define PG8_MMA(ai, bj, At, Bt) do { __builtin_amdgcn_s_setprio(1); _Pragma("unroll") for (int m = 0; m < 4; ++m) _Pragma("unroll") for (int n = 0; n < 2; ++n) _Pragma("unroll") for (int k = 0; k < 2; ++k) \
        acc[ai][bj][m][n] = __builtin_amdgcn_mfma_f32_16x16x32_bf16(Bt[n][k], At[m][k], acc[ai][bj][m][n], 0, 0, 0); __builtin_amdgcn_s_setprio(0); } while (0)
#define PG8_WAIT_V(n) asm volatile("s_waitcnt vmcnt(" #n ")" ::: "memory")
#define PG8_WAIT_L(n) asm volatile("s_waitcnt lgkmcnt(" #n ")" ::: "memory")
#define PG8_BAR __builtin_amdgcn_s_barrier()
#define PG8_SCHED __builtin_amdgcn_sched_barrier(0)
    Unit cur, nxt; int ui = 0; typename Epi::Pre pre;
    if (!S.next(0, cur)) return;
    const bool single = Epi::STAGED && !S.next(1, nxt);
    f32x4 acc[2][2][4][2];
#pragma unroll
    for (int a = 0; a < 2; ++a)
#pragma unroll
        for (int b = 0; b < 2; ++b)
#pragma unroll
            for (int m = 0; m < 4; ++m)
#pragma unroll
                for (int n = 0; n < 2; ++n) acc[a][b][m][n] = (f32x4){0.f, 0.f, 0.f, 0.f};
    bf16x8 At[4][2], B0[2][2], B1[2][2];
    const char* cA = (const char*)g.A + (size_t)cur.pm * tstep + (size_t)cur.ks * sstep; const char* cB = (const char*)g.Bt + (size_t)cur.pn * tstep + (size_t)cur.ks * sstep;
    S.a_ready(cur);
    if constexpr (SP2) {
        PG8_STAGE(PG8_SB(0, 0), cB, voffB); PG8_STAGE(PG8_SB(0, 1), cB + hstep, voffB); PG8_STAGE(PG8_SA(0, 0), cA, voffA); PG8_STAGE(PG8_SA(0, 1), cA + hstep, voffA);
        if (wr == 1) PG8_BAR;
        PG8_WAIT_V(2); PG8_BAR;
        PG8_STAGE(PG8_SB(1, 0), cB + kstep, voffB); PG8_STAGE(PG8_SA(1, 0), cA + kstep, voffA); PG8_STAGE(PG8_SB(1, 1), cB + hstep + kstep, voffB);
        PG8_WAIT_V(6); PG8_BAR;
    } else {
        PG8_STAGE(PG8_SB(0, 0), cB, voffB); PG8_STAGE(PG8_SA(0, 0), cA, voffA); PG8_STAGE(PG8_SB(0, 1), cB + hstep, voffB); PG8_STAGE(PG8_SA(0, 1), cA + hstep, voffA);
        if (wr == 1) PG8_BAR;
        PG8_WAIT_V(4); PG8_BAR;
        PG8_STAGE(PG8_SB(1, 0), cB + kstep, voffB); PG8_STAGE(PG8_SA(1, 0), cA + kstep, voffA); PG8_STAGE(PG8_SB(1, 1), cB + hstep + kstep, voffB);
        PG8_WAIT_V(6); PG8_BAR;
    }
    for (;;) {
        const bool has_next = S.next(ui + 1, nxt);
        const char* nA = has_next ? (const char*)g.A + (size_t)nxt.pm * tstep + (size_t)nxt.ks * sstep : cA; const char* nB = has_next ? (const char*)g.Bt + (size_t)nxt.pn * tstep + (size_t)nxt.ks * sstep : cB;
        for (int t = 0; t < nt; t += 2) {
            const bool last = (t == nt - 2);
            const char* a1 = cA + (size_t)(t + 1) * kstep;
            const char* a2 = last ? nA : cA + (size_t)(t + 2) * kstep; const char* b2 = last ? nB : cB + (size_t)(t + 2) * kstep;
            const char* a3 = a2 + kstep; const char* b3 = b2 + kstep;
            if (last && has_next) S.a_ready(nxt);
            if (last) E.pre(cur, wr, fr, fq, pre);
            if constexpr (SP2) {
            PG8_LDB(B0, 0, 0); PG8_LDB(B1, 0, 1); PG8_SCHED; PG8_LDA(At, 0, 0); PG8_STAGE(PG8_SA(1, 1), a1 + hstep, voffA);
            PG8_WAIT_V(8); PG8_WAIT_L(0); PG8_BAR; PG8_MMA(0, 0, At, B0); PG8_MMA(0, 1, At, B1); PG8_BAR; PG8_SCHED;
            PG8_LDA(At, 0, 1); PG8_STAGE(PG8_SB(0, 0), b2, voffB); PG8_STAGE(PG8_SB(0, 1), b2 + hstep, voffB); PG8_STAGE(PG8_SA(0, 0), a2, voffA);
            PG8_WAIT_V(8); PG8_WAIT_L(0); PG8_BAR; PG8_MMA(1, 0, At, B0); PG8_MMA(1, 1, At, B1); PG8_BAR; PG8_SCHED;
            PG8_LDB(B0, 1, 0); PG8_LDB(B1, 1, 1); PG8_SCHED; PG8_LDA(At, 1, 0); PG8_STAGE(PG8_SA(0, 1), a2 + hstep, voffA);
            PG8_WAIT_V(8); PG8_WAIT_L(0); PG8_BAR; PG8_MMA(0, 0, At, B0); PG8_MMA(0, 1, At, B1); PG8_BAR; PG8_SCHED;
            PG8_LDA(At, 1, 1); PG8_STAGE(PG8_SB(1, 0), b3, voffB); PG8_STAGE(PG8_SB(1, 1), b3 + hstep, voffB); PG8_STAGE(PG8_SA(1, 0), a3, voffA);
            PG8_WAIT_V(8); PG8_WAIT_L(0); PG8_BAR; PG8_MMA(1, 0, At, B0); PG8_MMA(1, 1, At, B1); PG8_BAR; PG8_SCHED;
            } else {
            PG8_LDB(B0, 0, 0); PG8_SCHED; PG8_LDA(At, 0, 0); PG8_STAGE(PG8_SA(1, 1), a1 + hstep, voffA);
            PG8_WAIT_L(8); PG8_BAR; PG8_WAIT_L(0); PG8_MMA(0, 0, At, B0); PG8_BAR; PG8_SCHED;
            PG8_LDB(B1, 0, 1); PG8_STAGE(PG8_SB(0, 0), b2, voffB);
            PG8_BAR; PG8_WAIT_L(0); PG8_MMA(0, 1, At, B1); PG8_BAR;
            PG8_LDA(At, 0, 1); PG8_STAGE(PG8_SA(0, 0), a2, voffA);
            PG8_BAR; PG8_WAIT_L(0); PG8_MMA(1, 0, At, B0); PG8_BAR; PG8_SCHED;
            PG8_STAGE(PG8_SB(0, 1), b2 + hstep, voffB);
            PG8_WAIT_V(6); PG8_BAR; PG8_MMA(1, 1, At, B1); PG8_BAR;
            PG8_LDB(B0, 1, 0); PG8_SCHED; PG8_LDA(At, 1, 0); PG8_STAGE(PG8_SA(0, 1), a2 + hstep, voffA);
            PG8_WAIT_L(8); PG8_BAR; PG8_WAIT_L(0); PG8_MMA(0, 0, At, B0); PG8_BAR; PG8_SCHED;
            PG8_LDB(B1, 1, 1); PG8_STAGE(PG8_SB(1, 0), b3, voffB);
            PG8_BAR; PG8_WAIT_L(0); PG8_MMA(0, 1, At, B1); PG8_BAR;
            PG8_LDA(At, 1, 1); PG8_STAGE(PG8_SA(1, 0), a3, voffA);
            PG8_BAR; PG8_WAIT_L(0); PG8_MMA(1, 0, At, B0); PG8_BAR; PG8_SCHED;
            PG8_STAGE(PG8_SB(1, 1), b3 + hstep, voffB);
            PG8_WAIT_V(6); PG8_BAR; PG8_MMA(1, 1, At, B1); PG8_BAR;
            }
        }
        if constexpr (ALIGN_EPI) { if (wr == 0) PG8_BAR; }
        if (!(Epi::STAGED && single)) { E(acc, cur, wr, wc, fr, fq, pre); } S.done(cur);
        if (!has_next) break;
#pragma unroll
        for (int a = 0; a < 2; ++a)
#pragma unroll
            for (int b = 0; b < 2; ++b)
#pragma unroll
                for (int m = 0; m < 4; ++m)
#pragma unroll
                    for (int n = 0; n < 2; ++n) acc[a][b][m][n] = (f32x4){0.f, 0.f, 0.f, 0.f};
        cur = nxt; cA = nA; cB = nB; ++ui;
        if constexpr (ALIGN_EPI) { if (wr == 1) PG8_BAR; }
    }
    PG8_WAIT_V(0);
    if constexpr (!ALIGN_EPI) { if (wr == 0) PG8_BAR; }
    PG8_BAR;
    if constexpr (Epi::STAGED) { if (single) E.staged(acc, cur, wr, wc, fr, fq, lds); }
#undef PG8_SA
#undef PG8_SB
#undef PG8_STAGE
#undef PG8_LDA
#undef PG8_LDB
#undef PG8_MMA
#undef PG8_WAIT_V
#undef PG8_WAIT_L
#undef PG8_BAR
#undef PG8_SCHED
}

__device__ __forceinline__ float rstd_q(const P& p, int row, int fr, int fq) {
    const f32x4 t = *(const f32x4*)(p.SS + (size_t)row * NSS + 4 * fq); float s = (t[0] + t[1]) + (t[2] + t[3]); const int ln = fq * 16 + fr;
    s += lane_xor_f(s, ln, 16); s += lane_xor_f(s, ln, 32); return __builtin_amdgcn_rsqf(s * (1.f / D_MODEL) + EPS);
}
struct RowStats { f32x4 t[4]; };
__device__ __forceinline__ void rstd_issue(const P& p, int rowbase, int fq, f32x4 (&t)[4]) {
#pragma unroll
    for (int m = 0; m < 4; ++m) t[m] = *(const f32x4*)(p.SS + (size_t)(rowbase + m * 16) * NSS + 4 * fq);
}
__device__ __forceinline__ void rstd_finish(const f32x4 (&t)[4], int fr, int fq, float (&rs)[4]) {
    const int ln = fq * 16 + fr; float s[4], x[4];
#pragma unroll
    for (int m = 0; m < 4; ++m) s[m] = (t[m][0] + t[m][1]) + (t[m][2] + t[m][3]);
#pragma unroll
    for (int m = 0; m < 4; ++m) x[m] = lane_xor_f(s[m], ln, 16);
#pragma unroll
    for (int m = 0; m < 4; ++m) s[m] += x[m];
#pragma unroll
    for (int m = 0; m < 4; ++m) x[m] = lane_xor_f(s[m], ln, 32);
#pragma unroll
    for (int m = 0; m < 4; ++m) rs[m] = __builtin_amdgcn_rsqf((s[m] + x[m]) * (1.f / D_MODEL) + EPS);
}
struct NoPre { };
struct EpiSwiglu {
    static constexpr bool PERM = true, STAGED = false; P p; typedef RowStats Pre;
    __device__ __forceinline__ void pre(const Unit& u, int wr, int fr, int fq, Pre& r) const { asm volatile("" : "+v"(fr), "+v"(fq)); rstd_issue(p, u.pm * BM + wr * 64 + fr, fq, r.t); }
    __device__ __forceinline__ void operator()(const f32x4 (&acc)[2][2][4][2], const Unit& u, int wr, int wc, int fr, int fq, const Pre& pr) const {
        asm volatile("" : "+v"(fr), "+v"(fq));
        EfSwiglu F; float rs[2][4]; f32x4 t1[4]; rstd_issue(p, u.pm * BM + HALF + wr * 64 + fr, fq, t1); rstd_finish(pr.t, fr, fq, rs[0]);
#pragma unroll
        for (int ai = 0; ai < 2; ++ai) { if (ai == 1) rstd_finish(t1, fr, fq, rs[1]);
#pragma unroll
            for (int m = 0; m < 4; ++m) { const int row = u.pm * BM + ai * HALF + wr * 64 + m * 16 + fr; const float rstd = rs[ai][m];
                float a[8], b[8];
#pragma unroll
                for (int n = 0; n < 2; ++n)
#pragma unroll
                    for (int e = 0; e < 4; ++e) { a[n * 4 + e] = acc[ai][0][m][n][e]; b[n * 4 + e] = acc[ai][1][m][n][e]; }
                F(p, row, u.pn * HALF + wc * 32 + 8 * fq, rstd, a, b); } }
    }
};
template <class F> struct EpiRow {
    static constexpr bool PERM = true, STAGED = false; P p; typedef RowStats Pre;
    __device__ __forceinline__ void pre(const Unit& u, int wr, int fr, int fq, Pre& r) const { asm volatile("" : "+v"(fr), "+v"(fq)); rstd_issue(p, u.pm * BM + wr * 64 + fr, fq, r.t); }
    __device__ __forceinline__ void operator()(const f32x4 (&acc)[2][2][4][2], const Unit& u, int wr, int wc, int fr, int fq, const Pre& pr) const {
        asm volatile("" : "+v"(fr), "+v"(fq));
        F f; float rs[2][4]; f32x4 t1[4]; rstd_issue(p, u.pm * BM + HALF + wr * 64 + fr, fq, t1); rstd_finish(pr.t, fr, fq, rs[0]);
#pragma unroll
        for (int ai = 0; ai < 2; ++ai) { if (ai == 1) rstd_finish(t1, fr, fq, rs[1]);
#pragma unroll
            for (int m = 0; m < 4; ++m) { const int row = u.pm * BM + ai * HALF + wr * 64 + m * 16 + fr; const float rstd = rs[ai][m];
#pragma unroll
                for (int bj = 0; bj < 2; ++bj) { float v[8];
#pragma unroll
                    for (int n = 0; n < 2; ++n)
#pragma unroll
                        for (int e = 0; e < 4; ++e) v[n * 4 + e] = acc[ai][bj][m][n][e];
                    f(p, row, u.pn * BM + bj * HALF + wc * 32 + 8 * fq, rstd, v); } } }
    }
};
constexpr int STG_PX = 1056;
constexpr int STG_SS = 128 * STG_PX;
struct EpiResid {
    static constexpr bool PERM = true, STAGED = true; P p; int first; typedef NoPre Pre;
    __device__ __forceinline__ void pre(const Unit&, int, int, int, Pre&) const {}
    __device__ __forceinline__ void staged(const f32x4 (&acc)[2][2][4][2], const Unit& u, int wr, int wc, int fr, int fq, PG8_LAS unsigned char* lds) const {
        asm volatile("" : "+v"(fr), "+v"(fq));
        const int w8 = wr * 4 + wc, lane = fq * 16 + fr;
#pragma unroll 1
        for (int ai = 0; ai < 2; ++ai) {
            const size_t grow0 = (size_t)u.pm * BM + ai * HALF;
            f32x4 x[4][2][2];
            if (first) {
#pragma unroll
                for (int m = 0; m < 4; ++m)
#pragma unroll
                    for (int bj = 0; bj < 2; ++bj) { const float* xp = p.x_prompt + (grow0 + wr * 64 + m * 16 + fr) * D_MODEL + u.pn * BM + bj * HALF + wc * 32 + 8 * fq; x[m][bj][0] = *(const f32x4*)xp; x[m][bj][1] = *(const f32x4*)(xp + 4); }
            } else {
                u32x4 h[4][2], l[4][2];
#pragma unroll
                for (int m = 0; m < 4; ++m)
#pragma unroll
                    for (int bj = 0; bj < 2; ++bj) { const size_t go = (grow0 + wr * 64 + m * 16 + fr) * D_MODEL + u.pn * BM + bj * HALF + wc * 32 + 8 * fq; h[m][bj] = *(const u32x4*)(p.XB + go); l[m][bj] = *(const u32x4*)(p.XLO + go); }
#pragma unroll
                for (int m = 0; m < 4; ++m)
#pragma unroll
                    for (int bj = 0; bj < 2; ++bj) { x[m][bj][0] = join4(h[m][bj][0], h[m][bj][1], l[m][bj][0], l[m][bj][1]); x[m][bj][1] = join4(h[m][bj][2], h[m][bj][3], l[m][bj][2], l[m][bj][3]); }
            }
#pragma unroll
            for (int m = 0; m < 4; ++m) { const int rl = wr * 64 + m * 16 + fr; float sq = 0.f;
#pragma unroll
                for (int bj = 0; bj < 2; ++bj) { const int cf = bj * HALF + wc * 32 + 8 * fq;
#pragma unroll
                    for (int n = 0; n < 2; ++n) { const f32x4 a = ai == 0 ? acc[0][bj][m][n] : acc[1][bj][m][n]; const f32x4 v = x[m][bj][n] + a;
                        sq += (v[0] * v[0] + v[1] * v[1]) + (v[2] * v[2] + v[3] * v[3]); *(PG8_LAS f32x4*)(lds + rl * STG_PX + (cf + 4 * n) * 4) = v; } }
                sq += lane_xor_f(sq, lane, 16); sq += lane_xor_f(sq, lane, 32);
                if (fq == 0) *(PG8_LAS float*)(lds + STG_SS + (rl * 4 + wc) * 4) = sq; }
            asm volatile("s_waitcnt lgkmcnt(0)" ::: "memory"); __builtin_amdgcn_s_barrier(); asm volatile("" ::: "memory");
#pragma unroll
            for (int i = 0; i < 8; ++i) { const int rl = w8 * 16 + 2 * i + (lane >> 5), c8 = lane & 31;
                const f32x4 v0 = *(const PG8_LAS f32x4*)(lds + rl * STG_PX + c8 * 32), v1 = *(const PG8_LAS f32x4*)(lds + rl * STG_PX + c8 * 32 + 16);
                u32x4 oh, ol; SPLIT2(v0[0], v0[1], oh[0], ol[0]); SPLIT2(v0[2], v0[3], oh[1], ol[1]); SPLIT2(v1[0], v1[1], oh[2], ol[2]); SPLIT2(v1[2], v1[3], oh[3], ol[3]);
                const size_t go = (grow0 + rl) * D_MODEL + u.pn * BM + c8 * 8;
                *(u32x4*)(p.XB + go) = oh; *(u32x4*)(p.XLO + go) = ol; }
            if (w8 < 2) { const int rl = w8 * 64 + lane; const f32x4 q4 = *(const PG8_LAS f32x4*)(lds + STG_SS + rl * 16); *(f32x4*)(p.SS + (grow0 + rl) * NSS + u.pn * 4) = q4; }
            asm volatile("s_waitcnt lgkmcnt(0)" ::: "memory"); __builtin_amdgcn_s_barrier(); asm volatile("" ::: "memory");
        }
    }
    __device__ __forceinline__ void operator()(const f32x4 (&acc)[2][2][4][2], const Unit& u, int wr, int wc, int fr, int fq, const Pre&) const {
        asm volatile("" : "+v"(fr), "+v"(fq));
#pragma unroll
        for (int ai = 0; ai < 2; ++ai)
#pragma unroll
            for (int m = 0; m < 4; ++m) { const int row = u.pm * BM + ai * HALF + wr * 64 + m * 16 + fr; float s = 0.f;
#pragma unroll
                for (int bj = 0; bj < 2; ++bj) { const size_t go = (size_t)row * D_MODEL + u.pn * BM + bj * HALF + wc * 32 + 8 * fq; f32x4 x0, x1;
                    if (first) { x0 = *(const f32x4*)(p.x_prompt + go); x1 = *(const f32x4*)(p.x_prompt + go + 4); }
                    else { const u32x4 h = *(const u32x4*)(p.XB + go), l = *(const u32x4*)(p.XLO + go); x0 = join4(h[0], h[1], l[0], l[1]); x1 = join4(h[2], h[3], l[2], l[3]); }
                    x0 += acc[ai][bj][m][0]; x1 += acc[ai][bj][m][1];
                    s += ((x0[0] * x0[0] + x0[1] * x0[1]) + (x0[2] * x0[2] + x0[3] * x0[3])) + ((x1[0] * x1[0] + x1[1] * x1[1]) + (x1[2] * x1[2] + x1[3] * x1[3]));
                    u32x4 oh, ol; SPLIT2(x0[0], x0[1], oh[0], ol[0]); SPLIT2(x0[2], x0[3], oh[1], ol[1]); SPLIT2(x1[0], x1[1], oh[2], ol[2]); SPLIT2(x1[2], x1[3], oh[3], ol[3]);
                    *(u32x4*)(p.XB + go) = oh; *(u32x4*)(p.XLO + go) = ol; }
                { const int ln = fq * 16 + fr; s += lane_xor_f(s, ln, 16); s += lane_xor_f(s, ln, 32); }
                if (fq == 0) p.SS[(size_t)row * NSS + u.pn * 4 + wc] = s; }
    }
};
struct SplitOrder {
    int pm0, nN, S, n, G, c;
    __host__ __device__ void init(int pm0_, int nM_, int nN_, int S_, int G_, int c_) { pm0 = pm0_; nN = nN_; S = S_; n = nM_ * nN_ * S_; G = G_; c = c_; }
    __host__ __device__ bool next(int i, Unit& u) const { const long L = (long)i * G + c; if (L >= n) return false; const int t = (int)L / S; u.ks = (int)L % S; u.pn = t % nN; u.pm = pm0 + t / nN; return true; }
    __device__ __forceinline__ void a_ready(const Unit&) const {}
    __device__ __forceinline__ void done(const Unit&) const {}
};
struct EpiNull {
    static constexpr bool PERM = true, STAGED = false; typedef NoPre Pre;
    __device__ __forceinline__ void pre(const Unit&, int, int, int, Pre&) const {}
    __device__ __forceinline__ void operator()(const f32x4 (&acc)[2][2][4][2], const Unit&, int, int, int, int, const Pre&) const {
#pragma unroll
        for (int a = 0; a < 2; ++a)
#pragma unroll
            for (int b = 0; b < 2; ++b)
#pragma unroll
                for (int m = 0; m < 4; ++m) { asm volatile("" :: "v"(acc[a][b][m][0]), "v"(acc[a][b][m][1])); }
    }
};
struct EpiPart {
    static constexpr bool PERM = true, STAGED = true; P p; typedef NoPre Pre;
    __device__ __forceinline__ void pre(const Unit&, int, int, int, Pre&) const {}
    __device__ __forceinline__ void staged(const f32x4 (&acc)[2][2][4][2], const Unit& u, int wr, int wc, int fr, int fq, PG8_LAS unsigned char* lds) const {
        asm volatile("" : "+v"(fr), "+v"(fq));
        const int w8 = wr * 4 + wc, lane = fq * 16 + fr;
#pragma unroll 1
        for (int ai = 0; ai < 2; ++ai) {
#pragma unroll
            for (int m = 0; m < 4; ++m) { const int rl = wr * 64 + m * 16 + fr;
#pragma unroll
                for (int bj = 0; bj < 2; ++bj) { const int cf = bj * HALF + wc * 32 + 8 * fq;
#pragma unroll
                    for (int n = 0; n < 2; ++n) *(PG8_LAS f32x4*)(lds + rl * STG_PX + (cf + 4 * n) * 4) = ai == 0 ? acc[0][bj][m][n] : acc[1][bj][m][n]; } }
            asm volatile("s_waitcnt lgkmcnt(0)" ::: "memory"); __builtin_amdgcn_s_barrier(); asm volatile("" ::: "memory");
            float* base = p.PART + ((size_t)u.ks * MS + (size_t)(u.pm * BM - MP) + ai * HALF) * D_MODEL + u.pn * BM + lane * 4;
#pragma unroll
            for (int i = 0; i < 16; ++i) { const int rl = w8 * 16 + i; *(f32x4*)(base + (size_t)rl * D_MODEL) = *(const PG8_LAS f32x4*)(lds + rl * STG_PX + lane * 16); }
            asm volatile("s_waitcnt lgkmcnt(0)" ::: "memory"); __builtin_amdgcn_s_barrier(); asm volatile("" ::: "memory");
        }
    }
    __device__ __forceinline__ void operator()(const f32x4 (&acc)[2][2][4][2], const Unit& u, int wr, int wc, int fr, int fq, const Pre&) const {
        asm volatile("" : "+v"(fr), "+v"(fq));
        float* base = p.PART + ((size_t)u.ks * MS + (size_t)(u.pm * BM - MP)) * D_MODEL + u.pn * BM + wc * 32 + 8 * fq;
#pragma unroll
        for (int ai = 0; ai < 2; ++ai)
#pragma unroll
            for (int m = 0; m < 4; ++m) { float* rp = base + (size_t)(ai * HALF + wr * 64 + m * 16 + fr) * D_MODEL;
#pragma unroll
                for (int bj = 0; bj < 2; ++bj) { *(f32x4*)(rp + bj * HALF) = acc[ai][bj][m][0]; *(f32x4*)(rp + bj * HALF + 4) = acc[ai][bj][m][1]; } }
    }
};
}

#define XB_TMO      128
#define XB_XCNT(j)  (256  + 64 * (j))
#define XB_XSUB(j)  (1280 + 64 * (j))
#define XB_XGEN(j)  (2304 + 64 * (j))
#define XB_TOP      3328
#define XB_TOPGEN   3392
#define XCD_BAR_WORDS 3456
#ifndef XB_SPIN_CAP
#define XB_SPIN_CAP (1u << 26)
#endif
__device__ __forceinline__ unsigned xb_ld(unsigned* p)              { return __hip_atomic_load(p, __ATOMIC_RELAXED, __HIP_MEMORY_SCOPE_AGENT); }
__device__ __forceinline__ unsigned xb_add(unsigned* p, unsigned v) { return __hip_atomic_fetch_add(p, v, __ATOMIC_RELAXED, __HIP_MEMORY_SCOPE_AGENT); }
__device__ __forceinline__ unsigned xb_xcc_id() { return (unsigned)__builtin_amdgcn_s_getreg((3 << 11) | 20) & 0xFu; }
#define XB_SPIN(cond, bar) do { unsigned _sp = 0; while (cond) { __builtin_amdgcn_s_sleep(1); \
    if ((++_sp & 255u) == 0u) { if (xb_ld(&(bar)[XB_TMO])) break; if (_sp > XB_SPIN_CAP) { atomicAdd(&(bar)[XB_TMO], 1u); break; } } } } while (0)
struct XcdBarrier { unsigned* bar; unsigned x; volatile LAS unsigned* st; };
__device__ __forceinline__ XcdBarrier xcd_barrier_post(unsigned* bar, volatile LAS unsigned* st) {
    XcdBarrier b; b.bar = bar; b.x = xb_xcc_id(); b.st = st;
    if (threadIdx.x == 0) (void)xb_add(&bar[XB_XCNT(b.x)], 1u);
    return b;
}
__device__ __forceinline__ void xcd_barrier_complete(unsigned* bar, unsigned x, unsigned& nloc, unsigned& nx) {
    const unsigned G = gridDim.x * gridDim.y * gridDim.z;
    unsigned sum, cnt, mine, sp = 0u;
    for (;;) {
        sum = 0u; cnt = 0u; mine = 0u;
#pragma unroll
        for (unsigned j = 0; j < 16; ++j) { const unsigned c = xb_ld(&bar[XB_XCNT(j)]); sum += c; cnt += (c > 0u) ? 1u : 0u; mine = (j == x) ? c : mine; }
        if (sum == G) break;
        __builtin_amdgcn_s_sleep(1);
        if ((++sp & 255u) == 0u) { if (xb_ld(&bar[XB_TMO])) break; if (sp > XB_SPIN_CAP) { atomicAdd(&bar[XB_TMO], 1u); break; } }
    }
    nloc = mine > 0u ? mine : 1u; nx = cnt > 0u ? cnt : 1u;
}
__device__ __attribute__((noinline)) void xcd_barrier(const XcdBarrier b) {
    asm volatile("s_waitcnt vmcnt(0)" ::: "memory");
    __syncthreads();
    if (threadIdx.x == 0) {
        unsigned* bar = b.bar;
        __builtin_amdgcn_s_waitcnt(0);
        unsigned nloc = b.st[0], nx = b.st[1];
        if (nloc == 0u) { xcd_barrier_complete(bar, b.x, nloc, nx); b.st[0] = nloc; b.st[1] = nx; }
        const unsigned old = xb_add(&bar[XB_XSUB(b.x)], 1u);
        const unsigned gen = old / nloc;
        if (old + 1u == (gen + 1u) * nloc) {
            __builtin_amdgcn_fence(__ATOMIC_RELEASE, "agent");
            asm volatile("s_waitcnt vmcnt(0)" ::: "memory");
            const unsigned og = xb_add(&bar[XB_TOP], 1u);
            const unsigned tg = og / nx;
            if (og + 1u == (tg + 1u) * nx) xb_add(&bar[XB_TOPGEN], 1u);
            else XB_SPIN(xb_ld(&bar[XB_TOPGEN]) == tg, bar);
            __builtin_amdgcn_fence(__ATOMIC_ACQUIRE, "agent");
            xb_add(&bar[XB_XGEN(b.x)], 1u);
            asm volatile("s_waitcnt vmcnt(0)" ::: "memory");
        } else {
            XB_SPIN(xb_ld(&bar[XB_XGEN(b.x)]) == gen, bar);
            __builtin_amdgcn_fence(__ATOMIC_ACQUIRE, "agent");
            asm volatile("s_waitcnt vmcnt(0)" ::: "memory");
        }
    }
    __syncthreads();
}


constexpr int MISC_OFF_ = 163840 - 1024, NTHR_ = 512, NWAVES_ = 8;
#ifndef PROBE_MASK
#define PROBE_MASK 0
#endif
#define REP(k) for (int rep_ = 0; rep_ < (((PROBE_MASK) >> (k)) & 1 ? 2 : 1); ++rep_)
namespace ssd {
typedef short bf16x8 __attribute__((ext_vector_type(8)));
typedef float f32x4 __attribute__((ext_vector_type(4)));
typedef unsigned u32x4 __attribute__((ext_vector_type(4)));
typedef unsigned u32x2 __attribute__((ext_vector_type(2)));
constexpr int PT = 136;
constexpr int L_C = 0, L_B = L_C + 128 * PT * 2, L_X = L_B + 128 * PT * 2, L_TA = L_X + 256 * PT * 2, L_TD = L_TA + 2048, L_END = L_TD + 2048;
static_assert(L_END <= MISC_OFF_ && SSD_HPG == 4 && D_STATE == 128 && GW == 256 && CHUNK == 128, "ssd fast path geometry");
__device__ __forceinline__ unsigned pk_bf16(float lo, float hi) { return pk2bf(lo, hi); }
__device__ __forceinline__ void unpack8(const u32x4 v, float* o) {
#pragma unroll
    for (int i = 0; i < 4; ++i) { o[2 * i] = __uint_as_float(v[i] << 16); o[2 * i + 1] = __uint_as_float(v[i] & 0xffff0000u); }
}
__device__ __forceinline__ float fast_silu(float x) { return silu_f(x); }

__device__ __forceinline__ void tables_issue(const P& p, int row0, int g, int w, int lane, float (&tin)[3]) {
    if (w < 4) { const int head = g * 4 + w;
        tin[0] = p.DT[(size_t)(row0 + 2 * lane) * SSD_HEADS + head]; tin[1] = p.DT[(size_t)(row0 + 2 * lane + 1) * SSD_HEADS + head]; tin[2] = p.ssm_a_log[head]; }
}
__device__ __forceinline__ void tables_finish(const float (&tin)[3], LAS float* tA, LAS float* tD, int w, int lane) {
    if (w < 4) {
        const float a = -expf(tin[2]); const float d0 = tin[0], d1 = tin[1];
        const float v0 = d0 * a, v1 = d1 * a; float s = v0 + v1;
#pragma unroll
        for (int o = 1; o < 64; o <<= 1) { const float t = lane_up_f(s, lane, o); if (lane >= o) s += t; }
        tA[w * 128 + 2 * lane] = s - v1; tA[w * 128 + 2 * lane + 1] = s; tD[w * 128 + 2 * lane] = d0; tD[w * 128 + 2 * lane + 1] = d1;
    }
}
struct ConvIn { u32x4 raw[16], wn[3]; f32x4 wt[10]; };
template <int MODE> __device__ __forceinline__ void conv_issue(const P& p, int row0, bool first_chunk, int g, int w, int lane, ConvIn& ci) {
    const int cls = lane < 32 ? 0 : (lane < 48 ? 1 : 2);
    if (MODE == 0 && cls == 2) return;
    const int chb = cls == 0 ? g * GW + 8 * lane : (cls == 1 ? D_INNER + g * D_STATE + 8 * (lane - 32) : D_INNER + SSD_GROUPS * D_STATE + g * D_STATE + 8 * (lane - 48));
#pragma unroll
    for (int k = 0; k < 4; ++k) { ci.wt[2 * k] = *(const f32x4*)(p.ssm_conv_w + k * CONV_DIM + chb); ci.wt[2 * k + 1] = *(const f32x4*)(p.ssm_conv_w + k * CONV_DIM + chb + 4); }
    ci.wt[8] = *(const f32x4*)(p.ssm_conv_b + chb); ci.wt[9] = *(const f32x4*)(p.ssm_conv_b + chb + 4);
    const bf16* src = p.ZX + (size_t)row0 * ZXP + D_INNER + chb;
    const int r0 = 16 * w;
#pragma unroll
    for (int i = 0; i < 3; ++i) { const int rr = r0 - 3 + i;
        if (rr < 0 && first_chunk) ci.wn[i] = (u32x4){0u, 0u, 0u, 0u}; else ci.wn[i] = *(const u32x4*)(src + (long)rr * ZXP); }
#pragma unroll
    for (int i = 0; i < 16; ++i) ci.raw[i] = *(const u32x4*)(src + (long)(r0 + i) * ZXP);
}
template <int MODE> __device__ __forceinline__ void conv_compute(LAS unsigned char* lds, int w, int lane, const ConvIn& ci) {
    const int cls = lane < 32 ? 0 : (lane < 48 ? 1 : 2);
    if (MODE == 0 && cls == 2) return;
    float cw[4][8], cb[8];
#pragma unroll
    for (int k = 0; k < 4; ++k)
#pragma unroll
        for (int e = 0; e < 4; ++e) { cw[k][e] = ci.wt[2 * k][e]; cw[k][4 + e] = ci.wt[2 * k + 1][e]; }
#pragma unroll
    for (int e = 0; e < 4; ++e) { cb[e] = ci.wt[8][e]; cb[4 + e] = ci.wt[9][e]; }
    const int r0 = 16 * w; float win[3][8];
#pragma unroll
    for (int i = 0; i < 3; ++i) unpack8(ci.wn[i], win[i]);
    const LAS float* tA = (const LAS float*)(lds + L_TA); const LAS float* tD = (const LAS float*)(lds + L_TD);
    const int j = lane >> 3;
    float alast = 0.f; if (MODE == 0 && cls == 0) alast = tA[j * 128 + 127];
    const bool transposed = (cls == 0) || (MODE == 0);
    const int tbase = cls == 0 ? L_X + (8 * lane) * PT * 2 : L_B + (8 * (lane - 32)) * PT * 2;
    const int nbase = cls == 1 ? L_B + 8 * (lane - 32) * 2 : L_C + 8 * (lane - 48) * 2;
    const u32x4 (&raw)[16] = ci.raw;
#pragma unroll
    for (int half = 0; half < 2; ++half) {
        unsigned tp[4][8];
#pragma unroll
        for (int rp = 0; rp < 4; ++rp) {
            const int sr = r0 + half * 8 + rp * 2;
            float c0[8], c1[8], o0[8], o1[8]; unpack8(raw[half * 8 + 2 * rp], c0); unpack8(raw[half * 8 + 2 * rp + 1], c1);
#pragma unroll
            for (int e = 0; e < 8; ++e) {
                o0[e] = fast_silu(cb[e] + cw[0][e] * win[0][e] + cw[1][e] * win[1][e] + cw[2][e] * win[2][e] + cw[3][e] * c0[e]);
                o1[e] = fast_silu(cb[e] + cw[0][e] * win[1][e] + cw[1][e] * win[2][e] + cw[2][e] * c0[e] + cw[3][e] * c1[e]);
                win[0][e] = win[2][e]; win[1][e] = c0[e]; win[2][e] = c1[e]; }
            if (MODE == 0 && cls == 0) { const float f0 = tD[j * 128 + sr] * __expf(alast - tA[j * 128 + sr]), f1 = tD[j * 128 + sr + 1] * __expf(alast - tA[j * 128 + sr + 1]);
#pragma unroll
                for (int e = 0; e < 8; ++e) { o0[e] *= f0; o1[e] *= f1; } }
            if (transposed) {
#pragma unroll
                for (int e = 0; e < 8; ++e) tp[rp][e] = pk_bf16(o0[e], o1[e]);
            } else {
                u32x4 v0, v1;
#pragma unroll
                for (int e = 0; e < 4; ++e) { v0[e] = pk_bf16(o0[2 * e], o0[2 * e + 1]); v1[e] = pk_bf16(o1[2 * e], o1[2 * e + 1]); }
                *(LAS u32x4*)(lds + nbase + sr * PT * 2) = v0; *(LAS u32x4*)(lds + nbase + (sr + 1) * PT * 2) = v1;
            }
        }
        if (transposed) {
#pragma unroll
            for (int e = 0; e < 8; ++e) *(LAS u32x4*)(lds + tbase + e * PT * 2 + (r0 + half * 8) * 2) = (u32x4){tp[0][e], tp[1][e], tp[2][e], tp[3][e]};
        }
    }
}
__device__ __forceinline__ void states_phase(const P& p, int G, int bx, LAS unsigned char* lds) {
    LAS float* tA = (LAS float*)(lds + L_TA); LAS float* tD = (LAS float*)(lds + L_TD);
    constexpr int NU = BATCH * NCHUNK * SSD_GROUPS;
    ConvIn ci; float tin[3];
    int u = bx;
    if (u < NU) { int t0 = threadIdx.x; asm volatile("" : "+v"(t0)); const int w0 = __builtin_amdgcn_readfirstlane(t0 >> 6), l0 = t0 & 63;
        const int bc = u / SSD_GROUPS, g = u % SSD_GROUPS; tables_issue(p, bc * CHUNK, g, w0, l0, tin); conv_issue<0>(p, bc * CHUNK, (bc % NCHUNK) == 0, g, w0, l0, ci); }
    for (; u < NU; u += G) {
    int tid = threadIdx.x; asm volatile("" : "+v"(tid));
    const int w = __builtin_amdgcn_readfirstlane(tid >> 6), lane = tid & 63, fr = lane & 15, fq = lane >> 4;
    const int bc = u / SSD_GROUPS, g = u % SSD_GROUPS;
    tables_finish(tin, tA, tD, w, lane);
    __syncthreads();
    if (tid < 4) p.CDEC[bc * SSD_HEADS + g * 4 + tid] = __expf(tA[tid * 128 + 127]);
    conv_compute<0>(lds, w, lane, ci);
    { const int un = u + G;
      if (un < NU) { int t1 = threadIdx.x; asm volatile("" : "+v"(t1)); const int w1 = __builtin_amdgcn_readfirstlane(t1 >> 6), l1 = t1 & 63;
          const int bcn = un / SSD_GROUPS, gn = un % SSD_GROUPS; tables_issue(p, bcn * CHUNK, gn, w1, l1, tin); conv_issue<0>(p, bcn * CHUNK, (bcn % NCHUNK) == 0, gn, w1, l1, ci); } }
    __syncthreads();
    bf16x8 af[4];
#pragma unroll
    for (int kk = 0; kk < 4; ++kk) af[kk] = *(const LAS bf16x8*)(lds + L_B + ((16 * w + fr) * PT + 32 * kk + 8 * fq) * 2);
#pragma unroll
    for (int j = 0; j < 4; ++j)
#pragma unroll
        for (int pt = 0; pt < 4; ++pt) { f32x4 acc = {0.f, 0.f, 0.f, 0.f};
#pragma unroll
            for (int kk = 0; kk < 4; ++kk) { const bf16x8 b = *(const LAS bf16x8*)(lds + L_X + ((j * 64 + 16 * pt + fr) * PT + 32 * kk + 8 * fq) * 2);
                acc = __builtin_amdgcn_mfma_f32_16x16x32_bf16(af[kk], b, acc, 0, 0, 0); }
            *(f32x4*)(p.STATES + (((size_t)bc * SSD_HEADS + g * 4 + j) * HEADDIM + 16 * pt + fr) * D_STATE + 16 * w + 4 * fq) = acc; }
    __syncthreads();
    }
}
constexpr long N_SCAN4 = (long)BATCH * SSD_HEADS * HEADDIM * D_STATE / 4;
__device__ __forceinline__ void scan4(const P& p, long i) {
    const int e4 = (int)(i % (HEADDIM * D_STATE / 4)); long r = i / (HEADDIM * D_STATE / 4); const int head = (int)(r % SSD_HEADS), b = (int)(r / SSD_HEADS);
    f32x4 h = {0.f, 0.f, 0.f, 0.f};
    static_assert(NCHUNK % 8 == 0, "scan batches");
#pragma unroll 1
    for (int c0 = 0; c0 < NCHUNK; c0 += 8) { f32x4 st[8]; float dec[8];
#pragma unroll
        for (int k = 0; k < 8; ++k) { const size_t idx = (((size_t)(b * NCHUNK + c0 + k)) * SSD_HEADS + head) * (HEADDIM * D_STATE) + e4 * 4;
            st[k] = *(const f32x4*)(p.STATES + idx); dec[k] = p.CDEC[(b * NCHUNK + c0 + k) * SSD_HEADS + head]; }
#pragma unroll
        for (int k = 0; k < 8; ++k) { const size_t idx = (((size_t)(b * NCHUNK + c0 + k)) * SSD_HEADS + head) * (HEADDIM * D_STATE) + e4 * 4;
            u32x2 o; o[0] = pk_bf16(h[0], h[1]); o[1] = pk_bf16(h[2], h[3]); *(u32x2*)(p.HPREV + idx) = o;
            h = h * dec[k] + st[k]; } }
    *(f32x4*)(p.ssm_prompt + (size_t)i * 4) = h;
}
__device__ __forceinline__ void y_unit(const P& p, int bc, int g, LAS unsigned char* lds) {
    int tid = threadIdx.x; asm volatile("" : "+v"(tid));
    const int w = __builtin_amdgcn_readfirstlane(tid >> 6), lane = tid & 63, fr = lane & 15, fq = lane >> 4;
    const int row0 = bc * CHUNK; LAS float* tA = (LAS float*)(lds + L_TA); LAS float* tD = (LAS float*)(lds + L_TD);
    { ConvIn ci; float tin[3];
      tables_issue(p, row0, g, w, lane, tin); conv_issue<1>(p, row0, (bc % NCHUNK) == 0, g, w, lane, ci);
      tables_finish(tin, tA, tD, w, lane);
      conv_compute<1>(lds, w, lane, ci); }
    __syncthreads();
    const int q = 16 * w + fr;
    bf16x8 cf[4];
#pragma unroll
    for (int kk = 0; kk < 4; ++kk) cf[kk] = *(const LAS bf16x8*)(lds + L_C + (q * PT + 32 * kk + 8 * fq) * 2);
    unsigned cbt[8][2];
#pragma unroll
    for (int st = 0; st < 8; ++st) { f32x4 t = {0.f, 0.f, 0.f, 0.f};
        if (st <= w) {
#pragma unroll
            for (int kk = 0; kk < 4; ++kk) { const bf16x8 a = *(const LAS bf16x8*)(lds + L_B + ((16 * st + fr) * PT + 32 * kk + 8 * fq) * 2);
                t = __builtin_amdgcn_mfma_f32_16x16x32_bf16(a, cf[kk], t, 0, 0, 0); } }
        cbt[st][0] = pk_bf16(t[0], t[1]); cbt[st][1] = pk_bf16(t[2], t[3]); }
    float ss = 0.f;
    bf16* gzrow = p.GZ + (size_t)(row0 + q) * D_INNER + g * GW + 4 * fq;
#pragma unroll 1
    for (int j = 0; j < 4; ++j) {
        const int head = g * 4 + j; const float aq = tA[j * 128 + q], dskip = p.ssm_d[head];
        const bf16* hp = p.HPREV + ((size_t)bc * SSD_HEADS + head) * (HEADDIM * D_STATE);
        bf16x8 hfa[4][4]; u32x2 zra[4];
#pragma unroll
        for (int pt = 0; pt < 4; ++pt) {
#pragma unroll
            for (int kk = 0; kk < 4; ++kk) hfa[pt][kk] = *(const bf16x8*)(hp + (16 * pt + fr) * D_STATE + 32 * kk + 8 * fq);
            zra[pt] = *(const u32x2*)(p.ZX + (size_t)(row0 + q) * ZXP + head * HEADDIM + 16 * pt + 4 * fq); }
        bf16x8 wf[4]; unsigned gvh[4][2];
#pragma unroll
        for (int kk = 0; kk < 4; ++kk) { unsigned pk[4];
            if (2 * kk <= w) {
                float v[8];
#pragma unroll
                for (int hh = 0; hh < 2; ++hh) { const int st = 2 * kk + hh; const int s0 = 16 * st + 4 * fq;
                    const f32x4 as = *(const LAS f32x4*)(tA + j * 128 + s0), ds = *(const LAS f32x4*)(tD + j * 128 + s0);
#pragma unroll
                    for (int i = 0; i < 4; ++i) { const int sidx = s0 + i; float x = 0.f; const unsigned cw2 = cbt[st][i >> 1]; const float cbv = __uint_as_float((i & 1) ? (cw2 & 0xffff0000u) : (cw2 << 16));
                        if (sidx <= q) x = cbv * __expf(aq - as[i]) * ds[i];
                        if (sidx == q) x += dskip;
                        v[hh * 4 + i] = x; } }
#pragma unroll
                for (int e = 0; e < 4; ++e) pk[e] = pk_bf16(v[2 * e], v[2 * e + 1]);
            } else { pk[0] = pk[1] = pk[2] = pk[3] = 0u; }
            wf[kk] = __builtin_bit_cast(bf16x8, (u32x4){pk[0], pk[1], pk[2], pk[3]}); }
        const float eaq = __expf(aq);
#pragma unroll
        for (int pt = 0; pt < 4; ++pt) {
            f32x4 yd = {0.f, 0.f, 0.f, 0.f}, yo = {0.f, 0.f, 0.f, 0.f};
#pragma unroll
            for (int kk = 0; kk < 4; ++kk) if (2 * kk <= w) {
                const LAS unsigned char* xr = lds + L_X + ((j * 64 + 16 * pt + fr) * PT + 32 * kk + 4 * fq) * 2;
                const u32x2 lo = *(const LAS u32x2*)xr, hi = *(const LAS u32x2*)(xr + 32);
                const bf16x8 a = __builtin_bit_cast(bf16x8, (u32x4){lo[0], lo[1], hi[0], hi[1]});
                yd = __builtin_amdgcn_mfma_f32_16x16x32_bf16(a, wf[kk], yd, 0, 0, 0); }
#pragma unroll
            for (int kk = 0; kk < 4; ++kk) { const bf16x8 c = *(const LAS bf16x8*)(lds + L_C + (q * PT + 32 * kk + 8 * fq) * 2); yo = __builtin_amdgcn_mfma_f32_16x16x32_bf16(hfa[pt][kk], c, yo, 0, 0, 0); }
            const u32x2 zr = zra[pt];
            const float z[4] = {__uint_as_float(zr[0] << 16), __uint_as_float(zr[0] & 0xffff0000u), __uint_as_float(zr[1] << 16), __uint_as_float(zr[1] & 0xffff0000u)};
            float vv[4];
#pragma unroll
            for (int i = 0; i < 4; ++i) { const float y = yd[i] + eaq * yo[i]; vv[i] = y * fast_silu(z[i]); ss += vv[i] * vv[i]; }
            gvh[pt][0] = pk_bf16(vv[0], vv[1]); gvh[pt][1] = pk_bf16(vv[2], vv[3]);
        }
        __syncthreads();
#pragma unroll
        for (int pt = 0; pt < 4; ++pt) *(LAS u32x2*)(lds + L_X + j * (HEADDIM * PT * 2) + w * 2048 + (pt * 64 + lane) * 8) = (u32x2){gvh[pt][0], gvh[pt][1]};
    }
    ss += lane_xor_f(ss, lane, 16); ss += lane_xor_f(ss, lane, 32);
    const float rn = 1.f / sqrtf(ss * (1.f / GW) + EPS);
#pragma unroll
    for (int j = 0; j < 4; ++j)
#pragma unroll
        for (int pt = 0; pt < 4; ++pt) { const f32x4 nw = *(const f32x4*)(p.ssm_norm_w + g * GW + 4 * fq + j * HEADDIM + 16 * pt);
            const u32x2 t = *(const LAS u32x2*)(lds + L_X + j * (HEADDIM * PT * 2) + w * 2048 + (pt * 64 + lane) * 8);
            const float v0 = __uint_as_float(t[0] << 16), v1 = __uint_as_float(t[0] & 0xffff0000u), v2 = __uint_as_float(t[1] << 16), v3 = __uint_as_float(t[1] & 0xffff0000u);
            u32x2 o; o[0] = pk_bf16(v0 * rn * nw[0], v1 * rn * nw[1]); o[1] = pk_bf16(v2 * rn * nw[2], v3 * rn * nw[3]);
            *(u32x2*)(gzrow + j * HEADDIM + 16 * pt) = o; }
    __syncthreads();
}
}

namespace att {
typedef short bf16x8 __attribute__((ext_vector_type(8)));
typedef short v4i16_t __attribute__((ext_vector_type(4)));
typedef float f32x4 __attribute__((ext_vector_type(4)));
typedef unsigned u32x4 __attribute__((ext_vector_type(4)));
typedef unsigned u32x2 __attribute__((ext_vector_type(2)));
constexpr int KP = 72;
constexpr int L_K = 0, L_V = 256 * KP * 2, L_END = 2 * 256 * KP * 2;
constexpr float LOG2E = 1.4426950408889634f;
constexpr int N_PUNITS = BATCH * 3 * ATTN_HPG * (SEQ / 128);
constexpr int N_SUNITS = DEC_BATCH * 13;
static_assert(L_END <= MISC_OFF_ && ATTN_HPG == 8 && AHD == 64 && DEC_SEQ == 8 && PAST_LEN >= 2048, "attention fast path geometry");
__device__ __forceinline__ unsigned pk_bf16(float lo, float hi) { return pk2bf(lo, hi); }
__device__ __forceinline__ v4i16_t tr_read(const LAS unsigned char* p) { return __builtin_amdgcn_ds_read_tr16_b64_v4i16((LAS v4i16_t*)p); }

struct PromptIn { u32x4 kv[4], vv[4]; bf16x8 qf[2]; };
__device__ __forceinline__ void prompt_issue(const P& p, int u, PromptIn& pi) {
    int tid = threadIdx.x; asm volatile("" : "+v"(tid));
    const int w = __builtin_amdgcn_readfirstlane(tid >> 6), lane = tid & 63, fr = lane & 15, fq = lane >> 4;
    const int blk = u & 31, h = (u >> 5) & 7, bg = u >> 8, g = bg % 3, b = bg / 3;
    const int dil = a_dil(g), nb = (SEQ / dil) / 128, r = blk / nb, m0 = 128 * (blk % nb);
    const size_t seqrow0 = (size_t)b * SEQ + r;
    const bf16* kbase = p.QKV + g * 3 * AW + AW + h * AHD;
#pragma unroll
    for (int i = 0; i < 4; ++i) { const int id = tid + NTHR_ * i, kr = id >> 3, ch = id & 7; int m = m0 - 128 + kr; m = m < 0 ? 0 : m;
        const bf16* src = kbase + (seqrow0 + (size_t)dil * m) * QKVW + ch * 8;
        pi.kv[i] = *(const u32x4*)src; pi.vv[i] = *(const u32x4*)(src + AW); }
    const size_t qrow = seqrow0 + (size_t)dil * (m0 + 16 * w + fr);
#pragma unroll
    for (int ks = 0; ks < 2; ++ks) pi.qf[ks] = *(const bf16x8*)(p.QKV + qrow * QKVW + g * 3 * AW + h * AHD + 32 * ks + 8 * fq);
}
__device__ __forceinline__ void prompt_phase(const P& p, int G, int bx, LAS unsigned char* lds) {
    PromptIn pi;
    int u = bx;
    if (u < N_PUNITS) prompt_issue(p, u, pi);
    for (; u < N_PUNITS; u += G) {
    int tid = threadIdx.x; asm volatile("" : "+v"(tid));
    const int w = __builtin_amdgcn_readfirstlane(tid >> 6), lane = tid & 63, fr = lane & 15, fq = lane >> 4;
    const int blk = u & 31, h = (u >> 5) & 7, bg = u >> 8, g = bg % 3, b = bg / 3;
    const int dil = a_dil(g), nb = (SEQ / dil) / 128, r = blk / nb, m0 = 128 * (blk % nb);
    const size_t seqrow0 = (size_t)b * SEQ + r;
#pragma unroll
    for (int i = 0; i < 4; ++i) { const int id = tid + NTHR_ * i, kr = id >> 3, ch = id & 7;
        *(LAS u32x4*)(lds + L_K + (kr * KP + ch * 8) * 2) = pi.kv[i]; *(LAS u32x4*)(lds + L_V + (kr * KP + ch * 8) * 2) = pi.vv[i]; }
    const size_t qrow = seqrow0 + (size_t)dil * (m0 + 16 * w + fr);
    bf16x8 qf[2]; qf[0] = pi.qf[0]; qf[1] = pi.qf[1];
    __syncthreads();
    if (u + G < N_PUNITS) prompt_issue(p, u + G, pi);
    f32x4 st[9];
#pragma unroll
    for (int kt = 0; kt < 9; ++kt) { st[kt] = (f32x4){0.f, 0.f, 0.f, 0.f};
#pragma unroll
        for (int ks = 0; ks < 2; ++ks) { const bf16x8 a = *(const LAS bf16x8*)(lds + L_K + ((16 * w + 16 * kt + fr) * KP + 32 * ks + 8 * fq) * 2);
            st[kt] = __builtin_amdgcn_mfma_f32_16x16x32_bf16(a, qf[ks], st[kt], 0, 0, 0); } }
    const float sl = exp2f(-8.f * (float)(g * ATTN_HPG + h + 1) / (float)NAH) * (float)dil * LOG2E;
    float mx = -1e30f;
#pragma unroll
    for (int kt = 0; kt < 9; ++kt)
#pragma unroll
        for (int i = 0; i < 4; ++i) { const int kr = 16 * w + 16 * kt + 4 * fq + i, j = 128 + 16 * w + fr - kr;
            const bool ok = j >= 0 && j <= 128 && (m0 - 128 + kr) >= 0;
            const float v = ok ? st[kt][i] * LOG2E - sl * (float)j : -1e30f; st[kt][i] = v; mx = fmaxf(mx, v); }
    mx = fmaxf(mx, lane_xor_f(mx, lane, 16)); mx = fmaxf(mx, lane_xor_f(mx, lane, 32));
    float l = 0.f;
#pragma unroll
    for (int kt = 0; kt < 9; ++kt)
#pragma unroll
        for (int i = 0; i < 4; ++i) { const float e = exp2f(st[kt][i] - mx); st[kt][i] = e; l += e; }
    l += lane_xor_f(l, lane, 16); l += lane_xor_f(l, lane, 32);
    bf16x8 pf[5];
#pragma unroll
    for (int kk = 0; kk < 5; ++kk) { u32x4 t; t[0] = pk_bf16(st[2 * kk][0], st[2 * kk][1]); t[1] = pk_bf16(st[2 * kk][2], st[2 * kk][3]);
        if (kk < 4) { t[2] = pk_bf16(st[2 * kk + 1][0], st[2 * kk + 1][1]); t[3] = pk_bf16(st[2 * kk + 1][2], st[2 * kk + 1][3]); } else { t[2] = 0u; t[3] = 0u; }
        pf[kk] = __builtin_bit_cast(bf16x8, t); }
    const float inv = 1.f / l;
    bf16* og = p.OG + ((size_t)g * M + qrow) * AW + h * AHD;
#pragma unroll
    for (int dt = 0; dt < 4; ++dt) { f32x4 acc = {0.f, 0.f, 0.f, 0.f};
#pragma unroll
        for (int kk = 0; kk < 5; ++kk) { const LAS unsigned char* vp = lds + L_V + ((16 * w + 32 * kk + 4 * fq + (fr >> 2)) * KP + 16 * dt + 4 * (fr & 3)) * 2;
            const v4i16_t lo = tr_read(vp); v4i16_t hi = {0, 0, 0, 0}; if (kk < 4) hi = tr_read(vp + 16 * KP * 2);
            const bf16x8 a = {lo[0], lo[1], lo[2], lo[3], hi[0], hi[1], hi[2], hi[3]};
            acc = __builtin_amdgcn_mfma_f32_16x16x32_bf16(a, pf[kk], acc, 0, 0, 0); }
        u32x2 o; o[0] = pk_bf16(acc[0] * inv, acc[1] * inv); o[1] = pk_bf16(acc[2] * inv, acc[3] * inv);
        *(u32x2*)(og + 16 * dt + 4 * fq) = o; }
    if (fq == 0) p.LSE[((size_t)g * M + qrow) * ATTN_HPG + h] = mx + log2f(l);
    __syncthreads();
    }
}
constexpr int L_P = 0;
__device__ __forceinline__ void sample_unit(const P& p, int u, LAS unsigned char* lds) {
    int tid = threadIdx.x; asm volatile("" : "+v"(tid));
    const int h = __builtin_amdgcn_readfirstlane(tid >> 6), lane = tid & 63, fr = lane & 15, fq = lane >> 4;
    const int b = u / 13, kind = u % 13;
    int g, NN, tok0, tstep, c0;
    if (kind == 0) { g = 0; NN = 8; tok0 = 0; tstep = 1; c0 = 0; } else if (kind < 5) { g = 1; NN = 2; tok0 = kind - 1; tstep = 4; c0 = kind - 1; } else { g = 2; NN = 1; tok0 = kind - 5; tstep = 1; c0 = kind - 5; }
    const int dil = a_dil(g), past = a_past(g);
    const float* cbase = cache_of(p, g) + ((size_t)b * past + c0) * 2 * AW + h * AHD;
    const bf16* nbase = p.QKV + ((size_t)MP + b * DEC_SEQ + tok0) * QKVW + g * 3 * AW + h * AHD;
    bf16x8 qf[2];
#pragma unroll
    for (int ks = 0; ks < 2; ++ks) { qf[ks] = (bf16x8){0, 0, 0, 0, 0, 0, 0, 0}; if (fr < NN) qf[ks] = *(const bf16x8*)(nbase + (size_t)tstep * fr * QKVW + 32 * ks + 8 * fq); }
    f32x4 st[9];
#pragma unroll
    for (int kt = 0; kt < 8; ++kt) { st[kt] = (f32x4){0.f, 0.f, 0.f, 0.f}; const float* kr = cbase + (size_t)dil * (16 * kt + fr) * 2 * AW + 8 * fq;
#pragma unroll
        for (int ks = 0; ks < 2; ++ks) { const f32x4 x0 = *(const f32x4*)(kr + 32 * ks), x1 = *(const f32x4*)(kr + 32 * ks + 4);
            u32x4 t; t[0] = pk_bf16(x0[0], x0[1]); t[1] = pk_bf16(x0[2], x0[3]); t[2] = pk_bf16(x1[0], x1[1]); t[3] = pk_bf16(x1[2], x1[3]);
            st[kt] = __builtin_amdgcn_mfma_f32_16x16x32_bf16(__builtin_bit_cast(bf16x8, t), qf[ks], st[kt], 0, 0, 0); } }
    { st[8] = (f32x4){0.f, 0.f, 0.f, 0.f};
#pragma unroll
      for (int ks = 0; ks < 2; ++ks) { bf16x8 a = {0, 0, 0, 0, 0, 0, 0, 0}; if (fr < NN) a = *(const bf16x8*)(nbase + (size_t)tstep * fr * QKVW + AW + 32 * ks + 8 * fq);
          st[8] = __builtin_amdgcn_mfma_f32_16x16x32_bf16(a, qf[ks], st[8], 0, 0, 0); } }
    const float sl = exp2f(-8.f * (float)(g * ATTN_HPG + h + 1) / (float)NAH) * (float)dil * LOG2E;
    float mx = -1e30f;
#pragma unroll
    for (int kt = 0; kt < 9; ++kt)
#pragma unroll
        for (int i = 0; i < 4; ++i) { const int n = 16 * kt + 4 * fq + i, j = 128 + fr - n; const bool ok = j >= 0 && j <= 128 && fr < NN;
            const float v = ok ? st[kt][i] * LOG2E - sl * (float)j : -1e30f; st[kt][i] = v; mx = fmaxf(mx, v); }
    mx = fmaxf(mx, lane_xor_f(mx, lane, 16)); mx = fmaxf(mx, lane_xor_f(mx, lane, 32));
    float l = 0.f;
#pragma unroll
    for (int kt = 0; kt < 9; ++kt)
#pragma unroll
        for (int i = 0; i < 4; ++i) { const float e = (fr < NN) ? exp2f(st[kt][i] - mx) : 0.f; st[kt][i] = e; l += e; }
    l += lane_xor_f(l, lane, 16); l += lane_xor_f(l, lane, 32);
    const float inv = (fr < NN) ? 1.f / l : 0.f;
    LAS float* Pl = (LAS float*)(lds + L_P) + h * (8 * 144);
    if (fr < 8) {
#pragma unroll
        for (int kt = 0; kt < 9; ++kt) *(LAS f32x4*)(Pl + fr * 144 + 16 * kt + 4 * fq) = st[kt] * inv; }
    if (fq == 0 && fr < NN) p.LSE[((size_t)g * M + MP + b * DEC_SEQ + tok0 + tstep * fr) * ATTN_HPG + h] = mx + log2f(l);
    asm volatile("s_waitcnt lgkmcnt(0)" ::: "memory");
    const int ks4 = lane >> 4, dq = lane & 15;
    f32x4 o[8];
#pragma unroll
    for (int iq = 0; iq < 8; ++iq) o[iq] = (f32x4){0.f, 0.f, 0.f, 0.f};
    const float* vb = cbase + AW + 4 * dq;
#pragma unroll 1
    for (int kb0 = 0; kb0 < 32; kb0 += 8) {
        f32x4 v[8];
#pragma unroll
        for (int x = 0; x < 8; ++x) v[x] = *(const f32x4*)(vb + (size_t)dil * (4 * (kb0 + x) + ks4) * 2 * AW);
#pragma unroll
        for (int x = 0; x < 8; ++x) { const int n = 4 * (kb0 + x) + ks4;
#pragma unroll
            for (int iq = 0; iq < 8; ++iq) if (iq < NN) o[iq] += v[x] * Pl[iq * 144 + n]; } }
#pragma unroll
    for (int kb = 32; kb < 34; ++kb) { const int n = 4 * kb + ks4, x = n - 128;
        if (x < NN) { const u32x2 r2 = *(const u32x2*)(nbase + (size_t)tstep * x * QKVW + 2 * AW + 4 * dq);
            const f32x4 v = {__uint_as_float(r2[0] << 16), __uint_as_float(r2[0] & 0xffff0000u), __uint_as_float(r2[1] << 16), __uint_as_float(r2[1] & 0xffff0000u)};
#pragma unroll
            for (int iq = 0; iq < 8; ++iq) if (iq < NN) o[iq] += v * Pl[iq * 144 + n]; } }
#pragma unroll
    for (int iq = 0; iq < 8; ++iq) if (iq < NN) {
#pragma unroll
        for (int e = 0; e < 4; ++e) { float t = o[iq][e]; t += lane_xor_f(t, lane, 16); t += lane_xor_f(t, lane, 32); o[iq][e] = t; }
        if (ks4 == 0) { u32x2 w2; w2[0] = pk_bf16(o[iq][0], o[iq][1]); w2[1] = pk_bf16(o[iq][2], o[iq][3]);
            *(u32x2*)(p.OG + ((size_t)g * M + MP + b * DEC_SEQ + tok0 + tstep * iq) * AW + h * AHD + 4 * dq) = w2; } }
    __syncthreads();
}
constexpr long N_MERGE = (long)M * ATTN_HPG * 8;
__device__ __forceinline__ void merge(const P& p, long i) {
    const int dc = (int)(i & 7), h = (int)((i >> 3) & 7); const size_t row = (size_t)(i >> 6);
    const float l0 = p.LSE[(0 * (size_t)M + row) * 8 + h], l1 = p.LSE[(1 * (size_t)M + row) * 8 + h], l2 = p.LSE[(2 * (size_t)M + row) * 8 + h];
    const float mx = fmaxf(l0, fmaxf(l1, l2)); float w0 = exp2f(l0 - mx), w1 = exp2f(l1 - mx), w2 = exp2f(l2 - mx); const float inv = 1.f / (w0 + w1 + w2); w0 *= inv; w1 *= inv; w2 *= inv;
    const size_t off = row * AW + h * AHD + dc * 8;
    const u32x4 a = *(const u32x4*)(p.OG + off), bq = *(const u32x4*)(p.OG + (size_t)M * AW + off), c = *(const u32x4*)(p.OG + 2 * (size_t)M * AW + off); u32x4 o;
#pragma unroll
    for (int e = 0; e < 4; ++e) { const float lo = w0 * __uint_as_float(a[e] << 16) + w1 * __uint_as_float(bq[e] << 16) + w2 * __uint_as_float(c[e] << 16);
        const float hi = w0 * __uint_as_float(a[e] & 0xffff0000u) + w1 * __uint_as_float(bq[e] & 0xffff0000u) + w2 * __uint_as_float(c[e] & 0xffff0000u); o[e] = pk_bf16(lo, hi); }
    *(u32x4*)(p.O + off) = o;
}
__device__ __forceinline__ void merge_phase(const P& p, int G, int bx) {
    int tid = threadIdx.x; asm volatile("" : "+v"(tid));
    const long stride = (long)G * 512;
    for (long i0 = (long)bx * 512 + tid; i0 < N_MERGE; i0 += 4 * stride) {
        float l[4][3]; u32x4 g[4][3]; size_t off[4]; bool ok[4];
#pragma unroll
        for (int q = 0; q < 4; ++q) { const long iq = i0 + q * stride; ok[q] = iq < N_MERGE; const long i = ok[q] ? iq : i0;
            const int dc = (int)(i & 7), h = (int)((i >> 3) & 7); const size_t row = (size_t)(i >> 6); off[q] = row * AW + h * AHD + dc * 8;
#pragma unroll
            for (int k = 0; k < 3; ++k) { l[q][k] = p.LSE[(k * (size_t)M + row) * 8 + h]; g[q][k] = *(const u32x4*)(p.OG + k * (size_t)M * AW + off[q]); } }
#pragma unroll
        for (int q = 0; q < 4; ++q) { const float mx = fmaxf(l[q][0], fmaxf(l[q][1], l[q][2])); float w0 = exp2f(l[q][0] - mx), w1 = exp2f(l[q][1] - mx), w2 = exp2f(l[q][2] - mx);
            const float inv = 1.f / (w0 + w1 + w2); w0 *= inv; w1 *= inv; w2 *= inv; u32x4 o;
#pragma unroll
            for (int e = 0; e < 4; ++e) { const float lo = w0 * __uint_as_float(g[q][0][e] << 16) + w1 * __uint_as_float(g[q][1][e] << 16) + w2 * __uint_as_float(g[q][2][e] << 16);
                const float hi = w0 * __uint_as_float(g[q][0][e] & 0xffff0000u) + w1 * __uint_as_float(g[q][1][e] & 0xffff0000u) + w2 * __uint_as_float(g[q][2][e] & 0xffff0000u); o[e] = pk_bf16(lo, hi); }
            if (ok[q]) *(u32x4*)(p.O + off[q]) = o; }
    }
}
}

namespace misc {
typedef float f32x4 __attribute__((ext_vector_type(4)));
typedef unsigned u32x4 __attribute__((ext_vector_type(4)));
typedef unsigned u32x2 __attribute__((ext_vector_type(2)));
__device__ __forceinline__ unsigned pk_bf16(float lo, float hi) { return pk2bf(lo, hi); }
template <int KIND> __device__ __forceinline__ void convert_w(const P& p, LAS unsigned char* lds, int ls, int wi, int nw) {
    constexpr int K = KIND == 1 ? D_FF : KIND == 3 ? D_INNER : KIND == 5 ? AW : D_MODEL;
    constexpr int N = KIND == 0 ? 2 * D_FF : KIND == 2 ? D_IN_PROJ : KIND == 4 ? QKVW : D_MODEL;
    constexpr int NBLK = N / 32, NIT = (K / 64) * NBLK; constexpr bool HAS_GAIN = KIND == 0 || KIND == 2 || KIND == 4;
    static_assert(N % 32 == 0 && K % 64 == 0, "item geometry");
    const float* W; bf16* WT; const float* gain = p.norm_w;
    if constexpr (KIND == 0) { W = p.w_ffn_in + (size_t)ls * D_MODEL * 2 * D_FF; WT = p.WFI + (size_t)ls * 2 * D_FF * D_MODEL; gain = p.norm_w + ((ls >> 1) * 3 + ((ls & 1) ? 2 : 0)) * D_MODEL; }
    else if constexpr (KIND == 1) { W = p.w_ffn_out + (size_t)ls * D_FF * D_MODEL; WT = p.WFO + (size_t)ls * D_MODEL * D_FF; }
    else if constexpr (KIND == 2) { W = p.ssm_w_in; WT = p.WSI; gain = p.norm_w + (0 * 3 + 1) * D_MODEL; }
    else if constexpr (KIND == 3) { W = p.ssm_w_out; WT = p.WSO; }
    else if constexpr (KIND == 4) { W = p.attn_w_qkv; WT = p.WQKV; gain = p.norm_w + (1 * 3 + 1) * D_MODEL; }
    else { W = p.attn_w_o; WT = p.WO; }
    int tid = threadIdx.x; asm volatile("" : "+v"(tid));
    const int w = __builtin_amdgcn_readfirstlane(tid >> 6), lane = tid & 63; LAS float* scr = (LAS float*)(lds + w * 16384);
    const int lh = lane >> 5, ln = lane & 31, c = lane & 7;
    float t[32];
    int it = wi;
    if (it < NIT) { const int kb = it / NBLK, nb = it % NBLK;
#pragma unroll
        for (int i = 0; i < 32; ++i) t[i] = W[(size_t)(64 * kb + 2 * i + lh) * N + 32 * nb + ln]; }
    while (it < NIT) {
        const int nx = it + nw; float tn[32];
        if (nx < NIT) { const int kb = nx / NBLK, nb = nx % NBLK;
#pragma unroll
            for (int i = 0; i < 32; ++i) tn[i] = W[(size_t)(64 * kb + 2 * i + lh) * N + 32 * nb + ln]; }
        const int kb = it / NBLK, nb = it % NBLK, k0 = 64 * kb, n0 = 32 * nb;
        int orow = n0; float cs = 1.f;
        if constexpr (KIND == 0) orow = n0 < D_FF ? 256 * (n0 / 128) + n0 % 128 : 256 * ((n0 - D_FF) / 128) + 128 + (n0 - D_FF) % 128;
        if constexpr (KIND == 1) cs = 0.5f;
        if constexpr (KIND == 4) cs = (n0 / AW) % 3 == 0 ? 0.125f : 1.f;
#pragma unroll
        for (int i = 0; i < 32; ++i) scr[(2 * i + lh) * 33 + ln] = t[i];
        asm volatile("s_waitcnt lgkmcnt(0)" ::: "memory");
        float gk[8];
#pragma unroll
        for (int e = 0; e < 8; ++e) gk[e] = (HAS_GAIN ? gain[k0 + 8 * c + e] : 1.f) * cs;
#pragma unroll
        for (int j = 0; j < 4; ++j) { const int n = (lane >> 3) + 8 * j; const LAS float* sp = scr + (8 * c) * 33 + n;
            u32x4 o; o[0] = pk_bf16(sp[0 * 33] * gk[0], sp[1 * 33] * gk[1]); o[1] = pk_bf16(sp[2 * 33] * gk[2], sp[3 * 33] * gk[3]); o[2] = pk_bf16(sp[4 * 33] * gk[4], sp[5 * 33] * gk[5]); o[3] = pk_bf16(sp[6 * 33] * gk[6], sp[7 * 33] * gk[7]);
            *(u32x4*)(WT + (size_t)(orow + n) * K + k0 + 8 * c) = o; }
        asm volatile("s_waitcnt lgkmcnt(0)" ::: "memory");
#pragma unroll
        for (int i = 0; i < 32; ++i) t[i] = tn[i];
        it = nx;
    }
}
template <int KIND> __device__ __forceinline__ void convert_in_tail(const P& p, LAS unsigned char* lds, int ls, int n_units, int G, int bx) {
    int tid = threadIdx.x; asm volatile("" : "+v"(tid)); const int w = __builtin_amdgcn_readfirstlane(tid >> 6);
    const int nb = n_units % G; if (nb && bx < nb) return;
    const int idx = nb ? bx - nb : bx, cnt = nb ? G - nb : G;
    convert_w<KIND>(p, lds, ls, idx * NWAVES_ + w, cnt * NWAVES_);
}
__device__ __forceinline__ void prologue(const P& p, LAS unsigned char* lds, int G, int bx) {
    int tid = threadIdx.x; asm volatile("" : "+v"(tid));
    const int w = __builtin_amdgcn_readfirstlane(tid >> 6), lane = tid & 63;
    const int gw = bx * NWAVES_ + w, NGW = G * NWAVES_;
    convert_w<0>(p, lds, 0, gw, NGW); convert_w<2>(p, lds, 0, gw, NGW);
    { const long nz = (long)(NSI - D_IN_PROJ) * D_MODEL / 8; u32x4* z = (u32x4*)(p.WSI + (size_t)D_IN_PROJ * D_MODEL);
        for (long i = (long)bx * NTHR_ + tid; i < nz; i += (long)G * NTHR_) z[i] = (u32x4){0u, 0u, 0u, 0u}; }
    for (int row = gw; row < M; row += NGW) {
        const float* src = row < MP ? p.x_prompt + (size_t)row * D_MODEL : p.x_sample + (size_t)(row - MP) * D_MODEL; float s = 0.f;
#pragma unroll
        for (int j = 0; j < 4; ++j) { const f32x4 v = *(const f32x4*)(src + 256 * j + 4 * lane); s += (v[0] * v[0] + v[1] * v[1]) + (v[2] * v[2] + v[3] * v[3]);
            u32x2 o; o[0] = pk_bf16(v[0], v[1]); o[1] = pk_bf16(v[2], v[3]); *(u32x2*)(p.XB + (size_t)row * D_MODEL + 256 * j + 4 * lane) = o; }
        s += lane_xor_f(s, lane, 1); s += lane_xor_f(s, lane, 2);
        if ((lane & 3) == 0) p.SS[(size_t)row * NSS + (lane >> 2)] = s; }
}
constexpr int S_LAST = 11;
__device__ __forceinline__ void final_norm(const P& p, LAS unsigned char* lds, int G, int bx) {
    int tid = threadIdx.x; asm volatile("" : "+v"(tid));
    const int w = __builtin_amdgcn_readfirstlane(tid >> 6), lane = tid & 63; const int gw = bx * NWAVES_ + w, NGW = G * NWAVES_;
    f32x4 nf[4];
#pragma unroll
    for (int j = 0; j < 4; ++j) nf[j] = *(const f32x4*)(p.norm_f + 256 * j + 4 * lane);
    LAS float* hs = (LAS float*)lds;
    for (int r4 = bx * 4; r4 < MS; r4 += G * 4) { const int r = r4 + (w >> 1), hf = w & 1; const size_t go = ((size_t)MP + r) * D_MODEL; f32x4 v[2]; float s = 0.f;
        u32x2 h[2], l[2]; f32x4 pv[2][S_LAST];
#pragma unroll
        for (int jj = 0; jj < 2; ++jj) { const size_t o = 256 * (2 * hf + jj) + 4 * lane; h[jj] = *(const u32x2*)(p.XB + go + o); l[jj] = *(const u32x2*)(p.XLO + go + o);
#pragma unroll
            for (int k = 0; k < S_LAST; ++k) pv[jj][k] = *(const f32x4*)(p.PART + ((size_t)k * MS + r) * D_MODEL + o); }
#pragma unroll
        for (int jj = 0; jj < 2; ++jj) { v[jj] = join4(h[jj][0], h[jj][1], l[jj][0], l[jj][1]);
#pragma unroll
            for (int k = 0; k < S_LAST; ++k) v[jj] += pv[jj][k];
            s += (v[jj][0] * v[jj][0] + v[jj][1] * v[jj][1]) + (v[jj][2] * v[jj][2] + v[jj][3] * v[jj][3]); }
#pragma unroll
        for (int o = 1; o < 64; o <<= 1) s += lane_xor_f(s, lane, o);
        if (lane == 0) hs[w] = s;
        __syncthreads();
        const float rr = 1.f / sqrtf((hs[w & ~1] + hs[w | 1]) * (1.f / D_MODEL) + EPS);
        __syncthreads();
#pragma unroll
        for (int jj = 0; jj < 2; ++jj) *(f32x4*)(p.y_sample + (size_t)r * D_MODEL + 256 * (2 * hf + jj) + 4 * lane) = v[jj] * rr * nf[2 * hf + jj]; }
    for (int row0 = gw; row0 < MP; row0 += 2 * NGW) {
        const bool two = row0 + NGW < MP; const int row1 = two ? row0 + NGW : row0;
        f32x4 q0[4], q1[4]; u32x2 h0[4], l0[4], h1[4], l1[4];
#pragma unroll
        for (int j = 0; j < 4; ++j) { q0[j] = *(const f32x4*)(p.SS + (size_t)row0 * NSS + 4 * j); q1[j] = *(const f32x4*)(p.SS + (size_t)row1 * NSS + 4 * j); }
#pragma unroll
        for (int j = 0; j < 4; ++j) { const size_t g0 = (size_t)row0 * D_MODEL + 256 * j + 4 * lane, g1 = (size_t)row1 * D_MODEL + 256 * j + 4 * lane;
            h0[j] = *(const u32x2*)(p.XB + g0); l0[j] = *(const u32x2*)(p.XLO + g0); h1[j] = *(const u32x2*)(p.XB + g1); l1[j] = *(const u32x2*)(p.XLO + g1); }
        float s0 = 0.f, s1 = 0.f;
#pragma unroll
        for (int j = 0; j < 4; ++j) { s0 += (q0[j][0] + q0[j][1]) + (q0[j][2] + q0[j][3]); s1 += (q1[j][0] + q1[j][1]) + (q1[j][2] + q1[j][3]); }
        const float r0 = 1.f / sqrtf(s0 * (1.f / D_MODEL) + EPS), r1 = 1.f / sqrtf(s1 * (1.f / D_MODEL) + EPS);
        float* out0 = p.y_prompt + (size_t)row0 * D_MODEL; float* out1 = p.y_prompt + (size_t)row1 * D_MODEL;
#pragma unroll
        for (int j = 0; j < 4; ++j) *(f32x4*)(out0 + 256 * j + 4 * lane) = join4(h0[j][0], h0[j][1], l0[j][0], l0[j][1]) * r0 * nf[j];
        if (two) {
#pragma unroll
            for (int j = 0; j < 4; ++j) *(f32x4*)(out1 + 256 * j + 4 * lane) = join4(h1[j][0], h1[j][1], l1[j][0], l1[j][1]) * r1 * nf[j]; } }
}
constexpr int LS_XS = 0, LS_Y = 16384, LS_DT = 24576, LS_DA = LS_DT + 128;
struct SampIn { float cw[4], bias, hs[3], dt, al; bf16 zx[8]; };
__device__ __forceinline__ void samp_issue(const P& p, int u, SampIn& si) {
    int tid = threadIdx.x; asm volatile("" : "+v"(tid));
    const int b = u / SSD_GROUPS, g = u % SSD_GROUPS; const int row0 = MP + b * DEC_SEQ;
    const int c = tid; const int chb = c < 256 ? g * GW + c : (c < 384 ? D_INNER + g * D_STATE + (c - 256) : D_INNER + SSD_GROUPS * D_STATE + g * D_STATE + (c - 384));
#pragma unroll
    for (int k = 0; k < 4; ++k) si.cw[k] = p.ssm_conv_w[k * CONV_DIM + chb];
    si.bias = p.ssm_conv_b[chb];
#pragma unroll
    for (int k = 0; k < 3; ++k) si.hs[k] = p.state_conv[((size_t)b * 3 + k) * CONV_DIM + chb];
#pragma unroll
    for (int t = 0; t < DEC_SEQ; ++t) si.zx[t] = p.ZX[(size_t)(row0 + t) * ZXP + D_INNER + chb];
    si.dt = 0.f; si.al = 0.f;
    if (tid < 32) { const int t = tid >> 2, j = tid & 3, head = g * 4 + j; si.dt = p.DT[(size_t)(row0 + t) * SSD_HEADS + head]; si.al = p.ssm_a_log[head]; }
}
__device__ __forceinline__ const float* samp_sbase(const P& p, int u) {
    int tid = threadIdx.x; asm volatile("" : "+v"(tid));
    const int w = __builtin_amdgcn_readfirstlane(tid >> 6), lane = tid & 63, nq = lane & 31, psel = lane >> 5; const int b = u / SSD_GROUPS, g = u % SSD_GROUPS;
    return p.state_ssm + (((size_t)b * SSD_HEADS + g * 4) * HEADDIM + 2 * w + psel) * D_STATE + 4 * nq;
}
__device__ __forceinline__ void ssd_sample_phase(const P& p, int G, int bx, LAS unsigned char* lds) {
    constexpr int NU = DEC_BATCH * SSD_GROUPS;
    LAS float* xs = (LAS float*)(lds + LS_XS); LAS float* Yl = (LAS float*)(lds + LS_Y); LAS float* tdt = (LAS float*)(lds + LS_DT); LAS float* tda = (LAS float*)(lds + LS_DA);
    SampIn si; f32x4 hn[4];
    int u = bx;
    if (u < NU) { samp_issue(p, u, si); const float* sb0 = samp_sbase(p, u);
#pragma unroll
        for (int ps = 0; ps < 4; ++ps) hn[ps] = *(const f32x4*)(sb0 + (size_t)(16 * ps) * D_STATE); }
    for (; u < NU; u += G) {
    int tid = threadIdx.x; asm volatile("" : "+v"(tid));
    const int w = __builtin_amdgcn_readfirstlane(tid >> 6), lane = tid & 63; const int b = u / SSD_GROUPS, g = u % SSD_GROUPS; const int row0 = MP + b * DEC_SEQ;
    const int un = u + G;
    { const int c = tid; float h0 = si.hs[0], h1 = si.hs[1], h2 = si.hs[2];
#pragma unroll
        for (int t = 0; t < DEC_SEQ; ++t) { const float cur = bf2f(si.zx[t]); const float a = si.bias + si.cw[0] * h0 + si.cw[1] * h1 + si.cw[2] * h2 + si.cw[3] * cur;
            xs[t * 512 + c] = a / (1.f + __expf(-a)); h0 = h1; h1 = h2; h2 = cur; } }
    if (tid < 32) { const int t = tid >> 2, j = tid & 3; tdt[t * 4 + j] = si.dt; tda[t * 4 + j] = __expf(-si.dt * expf(si.al)); }
    if (un < NU) samp_issue(p, un, si);
    __syncthreads();
    const int nq = lane & 31, psel = lane >> 5;
    f32x4 Bv[8], Cv[8];
#pragma unroll
    for (int t = 0; t < 8; ++t) { Bv[t] = *(const LAS f32x4*)(xs + t * 512 + 256 + 4 * nq); Cv[t] = *(const LAS f32x4*)(xs + t * 512 + 384 + 4 * nq); }
    const float* sbase = samp_sbase(p, u);
    f32x4 hv[4];
#pragma unroll 1
    for (int j = 0; j < 4; ++j) { const int head = g * 4 + j; const float dsk = p.ssm_d[head];
#pragma unroll
        for (int ps = 0; ps < 4; ++ps) hv[ps] = hn[ps];
        if (j < 3) {
#pragma unroll
            for (int ps = 0; ps < 4; ++ps) hn[ps] = *(const f32x4*)(sbase + (size_t)((j + 1) * HEADDIM + 16 * ps) * D_STATE);
        } else if (un < NU) { const float* sbn = samp_sbase(p, un);
#pragma unroll
            for (int ps = 0; ps < 4; ++ps) hn[ps] = *(const f32x4*)(sbn + (size_t)(16 * ps) * D_STATE); }
#pragma unroll
        for (int ps = 0; ps < 4; ++ps) { const int pidx = 16 * ps + 2 * w + psel; f32x4 h = hv[ps]; float y[8];
#pragma unroll
            for (int t = 0; t < 8; ++t) { const float coef = tdt[t * 4 + j] * xs[t * 512 + j * 64 + pidx]; h = h * tda[t * 4 + j] + Bv[t] * coef;
                y[t] = (Cv[t][0] * h[0] + Cv[t][1] * h[1]) + (Cv[t][2] * h[2] + Cv[t][3] * h[3]); }
            *(f32x4*)(p.ssm_sample + (((size_t)b * SSD_HEADS + head) * HEADDIM + pidx) * D_STATE + 4 * nq) = h;
            float r4[4], r2[2], r1;
            { const bool up = (lane & 16) != 0;
#pragma unroll
              for (int k = 0; k < 4; ++k) { const float keep = up ? y[4 + k] : y[k], give = up ? y[k] : y[4 + k]; r4[k] = keep + lane_xor_f(give, lane, 16); } }
            { const bool up = (lane & 8) != 0;
#pragma unroll
              for (int k = 0; k < 2; ++k) { const float keep = up ? r4[2 + k] : r4[k], give = up ? r4[k] : r4[2 + k]; r2[k] = keep + lane_xor_f(give, lane, 8); } }
            { const bool up = (lane & 4) != 0; const float keep = up ? r2[1] : r2[0], give = up ? r2[0] : r2[1]; r1 = keep + lane_xor_f(give, lane, 4); }
            r1 += lane_xor_f(r1, lane, 2); r1 += lane_xor_f(r1, lane, 1);
            if ((lane & 3) == 0) { const int t = ((lane >> 4) & 1) * 4 + ((lane >> 3) & 1) * 2 + ((lane >> 2) & 1); Yl[t * 256 + j * 64 + pidx] = r1 + dsk * xs[t * 512 + j * 64 + pidx]; } } }
    __syncthreads();
    { const int t = w, c = 4 * lane; const size_t row = (size_t)(row0 + t);
        const u32x2 zr = *(const u32x2*)(p.ZX + row * ZXP + g * GW + c);
        const float z[4] = {__uint_as_float(zr[0] << 16), __uint_as_float(zr[0] & 0xffff0000u), __uint_as_float(zr[1] << 16), __uint_as_float(zr[1] & 0xffff0000u)};
        const f32x4 yv = *(const LAS f32x4*)(Yl + t * 256 + c); float v[4], ss = 0.f;
#pragma unroll
        for (int e = 0; e < 4; ++e) { v[e] = yv[e] * (z[e] / (1.f + __expf(-z[e]))); ss += v[e] * v[e]; }
#pragma unroll
        for (int o = 1; o < 64; o <<= 1) ss += lane_xor_f(ss, lane, o);
        const float rn = 1.f / sqrtf(ss * (1.f / GW) + EPS); const f32x4 nw = *(const f32x4*)(p.ssm_norm_w + g * GW + c);
        u32x2 o2; o2[0] = pk_bf16(v[0] * rn * nw[0], v[1] * rn * nw[1]); o2[1] = pk_bf16(v[2] * rn * nw[2], v[3] * rn * nw[3]);
        *(u32x2*)(p.GZ + row * D_INNER + g * GW + c) = o2; }
    __syncthreads();
    }
}

template <int S> __device__ __forceinline__ void splitk_fixup_s(const P& p, int G, int bx, int first) {
    int tid = threadIdx.x; asm volatile("" : "+v"(tid));
    const int w = __builtin_amdgcn_readfirstlane(tid >> 6), lane = tid & 63; const int gw = bx * NWAVES_ + w, NGW = G * NWAVES_;
    for (int it0 = gw; it0 < MS * 4; it0 += 2 * NGW) {
        const bool two = it0 + NGW < MS * 4; const int it1 = two ? it0 + NGW : it0;
        const int r0 = it0 >> 2, j0 = it0 & 3, r1 = it1 >> 2, j1 = it1 & 3;
        const size_t go0 = ((size_t)MP + r0) * D_MODEL + 256 * j0 + 4 * lane, go1 = ((size_t)MP + r1) * D_MODEL + 256 * j1 + 4 * lane;
        f32x4 pa[S], pb[S], va, vb;
#pragma unroll
        for (int k = 0; k < S; ++k) { pa[k] = *(const f32x4*)(p.PART + ((size_t)k * MS + r0) * D_MODEL + 256 * j0 + 4 * lane); pb[k] = *(const f32x4*)(p.PART + ((size_t)k * MS + r1) * D_MODEL + 256 * j1 + 4 * lane); }
        if (first) { va = *(const f32x4*)(p.x_sample + (size_t)r0 * D_MODEL + 256 * j0 + 4 * lane); vb = *(const f32x4*)(p.x_sample + (size_t)r1 * D_MODEL + 256 * j1 + 4 * lane); }
        else { const u32x2 h0 = *(const u32x2*)(p.XB + go0), l0 = *(const u32x2*)(p.XLO + go0), h1 = *(const u32x2*)(p.XB + go1), l1 = *(const u32x2*)(p.XLO + go1);
               va = join4(h0[0], h0[1], l0[0], l0[1]); vb = join4(h1[0], h1[1], l1[0], l1[1]); }
#pragma unroll
        for (int k = 0; k < S; ++k) { va += pa[k]; vb += pb[k]; }
        float sa = (va[0] * va[0] + va[1] * va[1]) + (va[2] * va[2] + va[3] * va[3]), sb = (vb[0] * vb[0] + vb[1] * vb[1]) + (vb[2] * vb[2] + vb[3] * vb[3]);
        u32x2 oh, ol; SPLIT2(va[0], va[1], oh[0], ol[0]); SPLIT2(va[2], va[3], oh[1], ol[1]); *(u32x2*)(p.XB + go0) = oh; *(u32x2*)(p.XLO + go0) = ol;
        if (two) { SPLIT2(vb[0], vb[1], oh[0], ol[0]); SPLIT2(vb[2], vb[3], oh[1], ol[1]); *(u32x2*)(p.XB + go1) = oh; *(u32x2*)(p.XLO + go1) = ol; }
        sa += lane_xor_f(sa, lane, 1); sb += lane_xor_f(sb, lane, 1); sa += lane_xor_f(sa, lane, 2); sb += lane_xor_f(sb, lane, 2);
        sa += lane_xor_f(sa, lane, 4); sb += lane_xor_f(sb, lane, 4); sa += lane_xor_f(sa, lane, 8); sb += lane_xor_f(sb, lane, 8);
        if ((lane & 15) == 0) { p.SS[((size_t)MP + r0) * NSS + 4 * j0 + (lane >> 4)] = sa; if (two) p.SS[((size_t)MP + r1) * NSS + 4 * j1 + (lane >> 4)] = sb; } }
}
__device__ __forceinline__ void splitk_fixup(const P& p, int S, int G, int bx, int first) {
    if (S == 11) splitk_fixup_s<11>(p, G, bx, first); else if (S == 8) splitk_fixup_s<8>(p, G, bx, first); else splitk_fixup_s<4>(p, G, bx, first);
}
}

constexpr int NWAVES = 8, NTHR = NWAVES * 64;
constexpr int RING_BYTES = 131072, LDS_BYTES = 163840, MISC_OFF = MISC_OFF_;
#ifndef FAST_SSD
#define FAST_SSD 1
#endif
#ifndef FAST_ATTN
#define FAST_ATTN 1
#endif
#ifndef FAST_MISC
#define FAST_MISC 1
#endif
#ifndef MK_PER_PHASE
#define MK_PER_PHASE 0
#endif
constexpr int CW_BAR = 4096;

constexpr size_t al4k(size_t x) { return (x + 4095) & ~(size_t)4095; }
constexpr size_t CTL_BYTES = 1u << 15;
constexpr size_t OO_y_prompt = 0;
constexpr size_t OO_y_sample = OO_y_prompt + (size_t)MP * D_MODEL;
constexpr size_t OO_conv_prompt = OO_y_sample + (size_t)MS * D_MODEL;
constexpr size_t OO_conv_sample = OO_conv_prompt + (size_t)BATCH * (CONV_W - 1) * CONV_DIM;
constexpr size_t OO_ssm_prompt = OO_conv_sample + (size_t)DEC_BATCH * (CONV_W - 1) * CONV_DIM;
constexpr size_t OO_ssm_sample = OO_ssm_prompt + (size_t)BATCH * SSD_HEADS * HEADDIM * D_STATE;
constexpr size_t OO_kvp0 = OO_ssm_sample + (size_t)DEC_BATCH * SSD_HEADS * HEADDIM * D_STATE;
constexpr size_t OO_kvs0 = OO_kvp0 + (size_t)BATCH * 128 * 2 * AW;
constexpr size_t OO_kvp1 = OO_kvs0 + (size_t)MS * 2 * AW;
constexpr size_t OO_kvs1 = OO_kvp1 + (size_t)BATCH * 512 * 2 * AW;
constexpr size_t OO_kvp2 = OO_kvs1 + (size_t)MS * 2 * AW;
constexpr size_t OO_kvs2 = OO_kvp2 + (size_t)BATCH * 2048 * 2 * AW;
constexpr size_t OUT_ELEMS = OO_kvs2 + (size_t)MS * 2 * AW;
constexpr size_t WO_ctl = 0;
constexpr size_t WO_WFI = WO_ctl + al4k(CTL_BYTES);
constexpr size_t WO_WFO = WO_WFI + al4k((size_t)N_WFI * 2);
constexpr size_t WO_WSI = WO_WFO + al4k((size_t)N_WFO * 2);
constexpr size_t WO_WSO = WO_WSI + al4k((size_t)N_WSI * 2);
constexpr size_t WO_WQKV = WO_WSO + al4k((size_t)N_WSO * 2);
constexpr size_t WO_WO = WO_WQKV + al4k((size_t)N_WQKV * 2);
constexpr size_t WO_X = WO_WO + al4k((size_t)N_WO * 2);
constexpr size_t WO_XB = WO_X + al4k((size_t)M * D_MODEL * 4);
constexpr size_t WO_SS = WO_XB + al4k((size_t)M * D_MODEL * 2);
constexpr size_t WO_H = WO_SS + al4k((size_t)M * NSS * 4);
constexpr size_t WO_ZX = WO_H + al4k((size_t)M * D_FF * 2);
constexpr size_t WO_DT = WO_ZX + al4k((size_t)M * ZXP * 2);
constexpr size_t WO_STATES = WO_DT + al4k((size_t)M * SSD_HEADS * 4);
constexpr size_t WO_HPREV = WO_STATES + al4k((size_t)N_STATES * 4);
constexpr size_t WO_CDEC = WO_HPREV + al4k((size_t)N_STATES * 2);
constexpr size_t WO_GZ = WO_CDEC + al4k((size_t)BATCH * NCHUNK * SSD_HEADS * 4);
constexpr size_t WO_QKV = WO_GZ + al4k((size_t)M * D_INNER * 2);
constexpr size_t WO_O = WO_QKV + al4k((size_t)M * QKVW * 2);
constexpr size_t WO_OG = WO_O + al4k((size_t)M * AW * 2);
constexpr size_t WO_LSE = WO_OG + al4k((size_t)3 * M * AW * 2);
constexpr size_t WO_PART = WO_LSE + al4k((size_t)3 * M * ATTN_HPG * 4);
constexpr size_t WS_NEED = WO_PART + al4k((size_t)16 * MS * D_MODEL * 4);
struct KArgs { const float* x_prompt; const float* x_sample; const float* state_conv; const float* state_ssm; const float* cache0; const float* cache1; const float* cache2; const float* norm_w; const float* w_ffn_in; const float* w_ffn_out; const float* ssm_w_in; const float* ssm_conv_w; const float* ssm_conv_b; const float* ssm_dt_bias; const float* ssm_a_log; const float* ssm_d; const float* ssm_norm_w; const float* ssm_w_out; const float* attn_w_qkv; const float* attn_w_o; const float* norm_f; float* out; unsigned char* ws; int ph_lo, ph_hi; };
__device__ __forceinline__ P make_p(const KArgs& a) { P p;
    size_t z = 0; asm volatile("" : "+s"(z));
    p.x_prompt = a.x_prompt + z;
    p.x_sample = a.x_sample + z;
    p.state_conv = a.state_conv + z;
    p.state_ssm = a.state_ssm + z;
    p.cache0 = a.cache0 + z;
    p.cache1 = a.cache1 + z;
    p.cache2 = a.cache2 + z;
    p.norm_w = a.norm_w + z;
    p.w_ffn_in = a.w_ffn_in + z;
    p.w_ffn_out = a.w_ffn_out + z;
    p.ssm_w_in = a.ssm_w_in + z;
    p.ssm_conv_w = a.ssm_conv_w + z;
    p.ssm_conv_b = a.ssm_conv_b + z;
    p.ssm_dt_bias = a.ssm_dt_bias + z;
    p.ssm_a_log = a.ssm_a_log + z;
    p.ssm_d = a.ssm_d + z;
    p.ssm_norm_w = a.ssm_norm_w + z;
    p.ssm_w_out = a.ssm_w_out + z;
    p.attn_w_qkv = a.attn_w_qkv + z;
    p.attn_w_o = a.attn_w_o + z;
    p.norm_f = a.norm_f + z;
    float* out = a.out + z; unsigned char* ws = a.ws + z;
    p.y_prompt = out + OO_y_prompt;
    p.y_sample = out + OO_y_sample;
    p.conv_prompt = out + OO_conv_prompt;
    p.conv_sample = out + OO_conv_sample;
    p.ssm_prompt = out + OO_ssm_prompt;
    p.ssm_sample = out + OO_ssm_sample;
    p.kvp0 = out + OO_kvp0;
    p.kvs0 = out + OO_kvs0;
    p.kvp1 = out + OO_kvp1;
    p.kvs1 = out + OO_kvs1;
    p.kvp2 = out + OO_kvp2;
    p.kvs2 = out + OO_kvs2;
    p.ctl = (unsigned*)(ws + WO_ctl);
    p.WFI = (bf16*)(ws + WO_WFI);
    p.WFO = (bf16*)(ws + WO_WFO);
    p.WSI = (bf16*)(ws + WO_WSI);
    p.WSO = (bf16*)(ws + WO_WSO);
    p.WQKV = (bf16*)(ws + WO_WQKV);
    p.WO = (bf16*)(ws + WO_WO);
    p.X = nullptr; p.XLO = (bf16*)(ws + WO_X);
    p.XB = (bf16*)(ws + WO_XB);
    p.SS = (float*)(ws + WO_SS);
    p.H = (bf16*)(ws + WO_H);
    p.ZX = (bf16*)(ws + WO_ZX);
    p.DT = (float*)(ws + WO_DT);
    p.STATES = (float*)(ws + WO_STATES);
    p.HPREV = (bf16*)(ws + WO_HPREV);
    p.CDEC = (float*)(ws + WO_CDEC);
    p.GZ = (bf16*)(ws + WO_GZ);
    p.QKV = (bf16*)(ws + WO_QKV);
    p.O = (bf16*)(ws + WO_O);
    p.OG = (bf16*)(ws + WO_OG);
    p.LSE = (float*)(ws + WO_LSE);
    p.PART = (float*)(ws + WO_PART);
    p.ACUM = nullptr; p.XC = nullptr; p.Y = nullptr;
    p.cd1 = (const char*)a.cache1 - (const char*)a.cache0; p.cd2 = (const char*)a.cache2 - (const char*)a.cache0;
    return p; }

#define GRID_STRIDE(N, CALL) do { const long _n = (long)(N); int _t0 = threadIdx.x; asm volatile("" : "+v"(_t0));     \
    for (long i = (long)blockIdx.x * NTHR + _t0; i < _n; i += (long)gridDim.x * NTHR) { CALL; } } while (0)

__global__ void __launch_bounds__(NTHR, 2) mega_fwd(KArgs args) {
    extern __shared__ __attribute__((aligned(16))) unsigned char lds[];
    LAS unsigned char* ldsp = (LAS unsigned char*)lds;
    volatile LAS unsigned* MISC = (volatile LAS unsigned*)(ldsp + MISC_OFF + 512);
    { const int tid = threadIdx.x;
      for (int u = tid; u < (LDS_BYTES - MISC_OFF) / 4; u += NTHR) ((LAS unsigned*)(ldsp + MISC_OFF))[u] = 0u;
      __syncthreads();
      __syncthreads(); }
    XcdBarrier bar; bar.bar = (unsigned*)(args.ws + WO_ctl) + CW_BAR; bar.x = 0; bar.st = nullptr;
    if (!MK_PER_PHASE) bar = xcd_barrier_post((unsigned*)(args.ws + WO_ctl) + CW_BAR, MISC + 8);
    const int lo = args.ph_lo, hi = args.ph_hi;
    int ph = 0;
#define RUN() (lo <= ph && ph < hi)
#define SEAM() do { if (!MK_PER_PHASE && ph + 1 < hi) { xcd_barrier(bar); if ((PROBE_MASK >> 12) & 1) xcd_barrier(bar); } ++ph; } while (0)
#define PHASE_BEGIN() const P p = make_p(args); int bx = blockIdx.x, G = gridDim.x; asm volatile("" : "+s"(bx), "+s"(G))

    if (RUN()) { PHASE_BEGIN(); REP(0) misc::prologue(p, ldsp, G, bx); }
    SEAM();
    for (int slot = 0; slot < 4; ++slot) {
        if (RUN()) { PHASE_BEGIN();
            pg8::Gemm g{p.XB, p.WFI + (size_t)slot * 2 * D_FF * D_MODEL, M, 2 * D_FF, D_MODEL, D_MODEL}; pg8::StaticOrder S; S.init(M, 2 * D_FF, G, bx);
            if ((PROBE_MASK >> 17) & 1) { pg8::EpiNull E0; pg8::gemm_phase<pg8::EpiNull, pg8::StaticOrder, true, true>(ldsp, g, S, E0); }
            pg8::EpiSwiglu E{p}; REP(1) pg8::gemm_phase<pg8::EpiSwiglu, pg8::StaticOrder, true, true>(ldsp, g, S, E);
            __syncthreads(); misc::convert_in_tail<1>(p, ldsp, slot, (M / 256) * (2 * D_FF / 256), G, bx);
            if (slot == 1) misc::convert_in_tail<4>(p, ldsp, 0, (M / 256) * (2 * D_FF / 256), G, bx);
        }
        SEAM();
        for (int job = 0; job < 2; ++job) {
            if (job == 1) {
                if (slot == 0) {
                    if (RUN()) { PHASE_BEGIN();
                        pg8::Gemm g{p.XB, p.WSI, M, NSI, D_MODEL, D_MODEL}; pg8::StaticOrder S; S.init(M, NSI, G, bx);
                        pg8::EpiRow<EfSsmIn> E{p}; REP(2) pg8::gemm_phase<pg8::EpiRow<EfSsmIn>, pg8::StaticOrder, true, true>(ldsp, g, S, E);
                        __syncthreads(); misc::convert_in_tail<3>(p, ldsp, 0, (M / 256) * (NSI / 256), G, bx);
                        misc::convert_in_tail<0>(p, ldsp, 1, (M / 256) * (NSI / 256), G, bx);
                        misc::convert_in_tail<0>(p, ldsp, 2, (M / 256) * (NSI / 256), G, bx);
                    }
                    SEAM();
                    if (RUN()) { PHASE_BEGIN();
#pragma unroll 1
                        for (int part = 0; part < 2; ++part) {
                            if (((part ^ (bx >> 3)) & 1) == 0) { REP(3) ssd::states_phase(p, G, bx, ldsp); }
                            else { REP(14) misc::ssd_sample_phase(p, G, bx, ldsp); } } }
                    SEAM();
                    if (RUN()) { PHASE_BEGIN(); REP(4) GRID_STRIDE(ssd::N_SCAN4, ssd::scan4(p, i)); }
                    SEAM();
                    if (RUN()) { PHASE_BEGIN(); REP(5) for (int u = bx; u < BATCH * NCHUNK * SSD_GROUPS; u += G) ssd::y_unit(p, u / SSD_GROUPS, u % SSD_GROUPS, ldsp); }
                    SEAM();
                } else if (slot == 2) {
                    if (RUN()) { PHASE_BEGIN();
                        pg8::Gemm g{p.XB, p.WQKV, M, QKVW, D_MODEL, D_MODEL}; pg8::StaticOrder S; S.init(M, QKVW, G, bx);
                        pg8::EpiRow<EfQkv> E{p}; REP(6) pg8::gemm_phase<pg8::EpiRow<EfQkv>, pg8::StaticOrder, true, true>(ldsp, g, S, E);
                        __syncthreads(); misc::convert_in_tail<5>(p, ldsp, 0, (M / 256) * (QKVW / 256), G, bx);
                        misc::convert_in_tail<0>(p, ldsp, 3, (M / 256) * (QKVW / 256), G, bx);
                    }
                    SEAM();
                    if (RUN()) { PHASE_BEGIN();
#pragma unroll 1
                        for (int part = 0; part < 2; ++part) {
                            if (((part ^ (bx >> 3)) & 1) == 0) { REP(7) att::prompt_phase(p, G, bx, ldsp); }
                            else { REP(10) for (int u = bx; u < att::N_SUNITS; u += G) att::sample_unit(p, u, ldsp); } } }
                    SEAM();
                    if (RUN()) { PHASE_BEGIN(); REP(8) att::merge_phase(p, G, bx); }
                    SEAM();
                } else break;
            }
            const int rk = job == 0 ? D_FF : (slot == 0 ? D_INNER : AW), rs = job == 0 ? 11 : (slot == 0 ? 8 : 4);
            if (RUN()) { PHASE_BEGIN();
                const bf16* A = job == 0 ? p.H : (slot == 0 ? p.GZ : p.O); const bf16* Bt = job == 0 ? p.WFO + (size_t)slot * D_MODEL * D_FF : (slot == 0 ? p.WSO : p.WO);
                { pg8::Gemm g{A, Bt, MP, D_MODEL, rk, rk}; pg8::StaticOrder S; S.init(MP, D_MODEL, G, bx);
                  if ((PROBE_MASK >> 13) & 1) { pg8::EpiNull E0; pg8::gemm_phase<pg8::EpiNull, pg8::StaticOrder, true, true>(ldsp, g, S, E0); }
                  pg8::EpiResid E{p, slot + job == 0}; pg8::gemm_phase<pg8::EpiResid, pg8::StaticOrder, true, true>(ldsp, g, S, E); }
                { pg8::Gemm g{A, Bt, M, D_MODEL, rk / rs, rk}; pg8::SplitOrder S; S.init(MP / 256, MS / 256, D_MODEL / 256, rs, G, bx);
                  pg8::EpiPart E{p}; REP(11) pg8::gemm_phase<pg8::EpiPart, pg8::SplitOrder, true, true>(ldsp, g, S, E); }
            }
            SEAM();
            if (slot == 3 && job == 0) { static_assert(misc::S_LAST == 11, "the final norm sums the last GEMM's partials itself"); break; }
            if (RUN()) { PHASE_BEGIN(); misc::splitk_fixup(p, rs, G, bx, slot + job == 0); }
            SEAM();
        }
    }
    if (RUN()) { PHASE_BEGIN(); REP(9) misc::final_norm(p, ldsp, G, bx); }
#undef RUN
#undef SEAM
}
constexpr int N_PHASES = 1 + 4 * 3 + 6 + 5 + 1 - 1;

extern "C" void kernel_launch(void* const* d_in, const int* in_sizes, int n_in, void* d_out, int out_size, void* d_ws, size_t ws_size, hipStream_t stream) {
    static int grid = 0;
    if (grid == 0) {
        int dev = 0, cus = 0, per_cu = 0;
        if (hipGetDevice(&dev) != hipSuccess || hipDeviceGetAttribute(&cus, hipDeviceAttributeMultiprocessorCount, dev) != hipSuccess) { fprintf(stderr, "kernel_launch: device query failed\n"); grid = -1; return; }
        if (hipFuncSetAttribute((const void*)mega_fwd, hipFuncAttributeMaxDynamicSharedMemorySize, LDS_BYTES) != hipSuccess) { fprintf(stderr, "kernel_launch: hipFuncSetAttribute failed\n"); grid = -1; return; }
        if (hipOccupancyMaxActiveBlocksPerMultiprocessor(&per_cu, (const void*)mega_fwd, NTHR, LDS_BYTES) != hipSuccess || per_cu < 1) fprintf(stderr, "kernel_launch: occupancy query says %d\n", per_cu);
        (void)hipGetLastError();
        grid = cus;
    }
    if (grid < 0) return;
    KArgs a; memset(&a, 0, sizeof(a));
    const float* const* in = (const float* const*)d_in;
    a.x_prompt = in[0]; a.x_sample = in[1]; a.state_conv = in[2]; a.state_ssm = in[3]; a.cache0 = in[4]; a.cache1 = in[5]; a.cache2 = in[6]; a.norm_w = in[7]; a.w_ffn_in = in[8]; a.w_ffn_out = in[9]; a.ssm_w_in = in[10]; a.ssm_conv_w = in[11]; a.ssm_conv_b = in[12]; a.ssm_dt_bias = in[13]; a.ssm_a_log = in[14]; a.ssm_d = in[15]; a.ssm_norm_w = in[16]; a.ssm_w_out = in[17]; a.attn_w_qkv = in[18]; a.attn_w_o = in[19]; a.norm_f = in[20];
    a.out = (float*)d_out; a.ws = (unsigned char*)d_ws;
    if (OUT_ELEMS != (size_t)out_size) fprintf(stderr, "kernel_launch: output size mismatch: %zu vs %d\n", (size_t)OUT_ELEMS, out_size);
    if (WS_NEED > ws_size) { fprintf(stderr, "kernel_launch: workspace too small: need %zu have %zu\n", (size_t)WS_NEED, ws_size); return; }
    if (hipMemsetAsync((unsigned char*)d_ws + WO_ctl, 0, CTL_BYTES, stream) != hipSuccess) { fprintf(stderr, "kernel_launch: memset failed\n"); return; }
#if MK_PER_PHASE
    for (int k = 0; k < N_PHASES; ++k) { a.ph_lo = k; a.ph_hi = k + 1; hipLaunchKernelGGL(mega_fwd, dim3(grid), dim3(NTHR), LDS_BYTES, stream, a); }
#else
    a.ph_lo = 0; a.ph_hi = N_PHASES; hipLaunchKernelGGL(mega_fwd, dim3(grid), dim3(NTHR), LDS_BYTES, stream, a);
#endif
    const hipError_t le = hipPeekAtLastError();
    if (le != hipSuccess) fprintf(stderr, "kernel_launch: launch failed: %s\n", hipGetErrorName(le));
}
#endif
```
